# Optimizing an MI355X kernel written in HIP

```python
import math
import jax, jax.numpy as jnp
from jax import lax
import numpy as np

D_MODEL = 1024
BATCH = 8
SEQ = 2048
DEPTH = 4

N_MIXERS = 3
CHUNK = 64
Q_BLOCK = 128
RMS_EPS = 1e-6
LN_EPS = 1e-5
CONV_WIDTH = D_MODEL
CONV_K = 31
FOX_HEAD_DIM = 64
FOX_HEADS = D_MODEL // FOX_HEAD_DIM
FOX_WIDTH = FOX_HEADS * FOX_HEAD_DIM
SSM_WIDTH = D_MODEL
SSM_GROUP = 16
SSM_GROUPS = SSM_WIDTH // SSM_GROUP
SSM_STATE = 64
DT_MIN = 1e-3
DT_MAX = 1e-1

N_CONV_LAYERS = len(range(0, DEPTH, N_MIXERS))
N_FOX_LAYERS = len(range(1, DEPTH, N_MIXERS))
N_SSM_LAYERS = len(range(2, DEPTH, N_MIXERS))

kernel_name = "interleaved_conv_fox_s5_trunk"


def rms_norm(x, g):
    xf = x.astype(jnp.float32)
    y = xf * lax.rsqrt(jnp.mean(xf * xf, axis=-1, keepdims=True) + RMS_EPS)
    return (y * g.astype(jnp.float32)).astype(x.dtype)


def head_rms(x, g):
    xf = x.astype(jnp.float32)
    return xf * lax.rsqrt(jnp.mean(xf * xf, axis=-1, keepdims=True) + RMS_EPS) * g.astype(jnp.float32)


def conv_mixer(h, w_in, conv_w, conv_b, ln_g, ln_b, w_out):
    z = h @ w_in
    a, b, gate = jnp.split(z, 3, axis=-1)
    u = a * jax.nn.sigmoid(b)
    u = lax.conv_general_dilated(
        u, conv_w[:, None, :], window_strides=(1,), padding=[(CONV_K - 1, 0)],
        dimension_numbers=("NWC", "WIO", "NWC"), feature_group_count=CONV_WIDTH,
    ) + conv_b
    uf = u.astype(jnp.float32)
    mu = jnp.mean(uf, axis=-1, keepdims=True)
    var = jnp.mean(jnp.square(uf - mu), axis=-1, keepdims=True)
    uf = (uf - mu) * lax.rsqrt(var + LN_EPS) * ln_g.astype(jnp.float32) + ln_b.astype(jnp.float32)
    u = jax.nn.silu(uf).astype(h.dtype) * jax.nn.silu(gate)
    return u @ w_out


def fox_mixer(h, w_in, f_bias, q_g, k_g, w_out):
    bsz, seq, _ = h.shape
    z = h @ w_in
    q, k, v, gate, f_logit = jnp.split(
        z, [FOX_WIDTH, 2 * FOX_WIDTH, 3 * FOX_WIDTH, 4 * FOX_WIDTH], axis=-1)
    shp = (bsz, seq, FOX_HEADS, FOX_HEAD_DIM)
    q = head_rms(q.reshape(shp), q_g)
    k = head_rms(k.reshape(shp), k_g)
    v = v.reshape(shp).astype(jnp.float32)
    log_f = jax.nn.log_sigmoid(f_logit.astype(jnp.float32) + f_bias.astype(jnp.float32))
    cum = jnp.cumsum(log_f, axis=1).transpose(0, 2, 1)
    scale = 1.0 / math.sqrt(FOX_HEAD_DIM)
    outs = []
    for blk in range(seq // Q_BLOCK):
        q0 = blk * Q_BLOCK
        q1 = q0 + Q_BLOCK
        s = jnp.einsum("bqhd,bkhd->bhqk", q[:, q0:q1], k[:, :q1]) * scale
        decay = cum[:, :, q0:q1, None] - cum[:, :, None, :q1]
        causal = jnp.arange(q0, q1)[:, None] >= jnp.arange(q1)[None, :]
        s = jnp.where(causal, s + decay, -jnp.inf)
        p = jax.nn.softmax(s, axis=-1)
        outs.append(jnp.einsum("bhqk,bkhd->bqhd", p, v[:, :q1]))
    o = jnp.concatenate(outs, axis=1).reshape(bsz, seq, FOX_WIDTH).astype(h.dtype)
    o = o * jax.nn.silu(gate)
    return o @ w_out


def _complex_affine_combine(e1, e2):
    a1r, a1i, b1r, b1i = e1
    a2r, a2i, b2r, b2i = e2
    ar = a2r * a1r - a2i * a1i
    ai = a2r * a1i + a2i * a1r
    br = a2r * b1r - a2i * b1i + b2r
    bi = a2r * b1i + a2i * b1r + b2i
    return (ar, ai, br, bi)


def ssm_mixer(h, w_in, log_dt, a_re, a_im, b_re, b_im, c_re, c_im, d_skip, w_glu, b_glu, w_out):
    bsz, seq, _ = h.shape
    f32 = jnp.float32
    z = h @ w_in
    u, gate = jnp.split(z, 2, axis=-1)
    uf = u.astype(f32)
    a_re = a_re.astype(f32)
    a_im = a_im.astype(f32)
    dt = jnp.exp(log_dt.astype(f32))[:, None]
    mag = jnp.exp(a_re * dt)
    ang = a_im * dt
    abar_re = mag * jnp.cos(ang)
    abar_im = mag * jnp.sin(ang)
    den = a_re * a_re + a_im * a_im
    nr = abar_re - 1.0
    ni = abar_im
    zr = ((nr * a_re + ni * a_im) / den)[..., None]
    zi = ((ni * a_re - nr * a_im) / den)[..., None]
    b_re = b_re.astype(f32)
    b_im = b_im.astype(f32)
    bb_re = zr * b_re - zi * b_im
    bb_im = zr * b_im + zi * b_re
    ug = uf.reshape(bsz, seq, SSM_GROUPS, SSM_GROUP)
    bu_re = jnp.einsum("bsgc,gpc->sbgp", ug, bb_re)
    bu_im = jnp.einsum("bsgc,gpc->sbgp", ug, bb_im)
    ar_t = jnp.broadcast_to(abar_re, (seq, 1, SSM_GROUPS, SSM_STATE))
    ai_t = jnp.broadcast_to(abar_im, (seq, 1, SSM_GROUPS, SSM_STATE))
    _, _, xr, xi = lax.associative_scan(
        _complex_affine_combine, (ar_t, ai_t, bu_re, bu_im), axis=0)
    y = (jnp.einsum("sbgp,gcp->bsgc", xr, c_re.astype(f32))
         - jnp.einsum("sbgp,gcp->bsgc", xi, c_im.astype(f32)))
    y = y.reshape(bsz, seq, SSM_WIDTH) + d_skip.astype(f32) * uf
    g = jax.nn.gelu(y)
    y = g * jax.nn.sigmoid(g @ w_glu.astype(f32) + b_glu.astype(f32))
    y = y.astype(h.dtype) * jax.nn.silu(gate)
    return y @ w_out


def setup_inputs(seed: int = 0) -> dict:
    key = jax.random.key(seed)
    ks = jax.random.split(key, 32)
    nrm = jax.random.normal
    D = D_MODEL
    x = nrm(ks[0], (BATCH, SEQ, D), jnp.float32)
    norm_g = 1.0 + 0.02 * nrm(ks[1], (DEPTH, D), jnp.float32)
    a_w_in = nrm(ks[2], (N_CONV_LAYERS, D, 3 * CONV_WIDTH), jnp.float32) * D ** -0.5
    a_conv_w = nrm(ks[3], (N_CONV_LAYERS, CONV_K, CONV_WIDTH), jnp.float32) * CONV_K ** -0.5
    a_conv_b = 0.02 * nrm(ks[4], (N_CONV_LAYERS, CONV_WIDTH), jnp.float32)
    a_ln_g = 1.0 + 0.02 * nrm(ks[5], (N_CONV_LAYERS, CONV_WIDTH), jnp.float32)
    a_ln_b = 0.02 * nrm(ks[6], (N_CONV_LAYERS, CONV_WIDTH), jnp.float32)
    a_w_out = nrm(ks[7], (N_CONV_LAYERS, CONV_WIDTH, D), jnp.float32) * CONV_WIDTH ** -0.5
    b_w_in = nrm(ks[8], (N_FOX_LAYERS, D, 4 * FOX_WIDTH + FOX_HEADS), jnp.float32) * D ** -0.5
    b_f_bias = jax.random.uniform(ks[9], (N_FOX_LAYERS, FOX_HEADS), jnp.float32, 1.0, 5.0)
    b_q_norm = 1.0 + 0.02 * nrm(ks[10], (N_FOX_LAYERS, FOX_HEAD_DIM), jnp.float32)
    b_k_norm = 1.0 + 0.02 * nrm(ks[11], (N_FOX_LAYERS, FOX_HEAD_DIM), jnp.float32)
    b_w_out = nrm(ks[12], (N_FOX_LAYERS, FOX_WIDTH, D), jnp.float32) * FOX_WIDTH ** -0.5
    G, P, Cg = SSM_GROUPS, SSM_STATE, SSM_GROUP
    c_w_in = nrm(ks[13], (N_SSM_LAYERS, D, 2 * SSM_WIDTH), jnp.float32) * D ** -0.5
    c_log_dt = jax.random.uniform(ks[14], (N_SSM_LAYERS, G), jnp.float32,
                                  math.log(DT_MIN), math.log(DT_MAX))
    c_a_re = -0.5 + 0.01 * nrm(ks[15], (N_SSM_LAYERS, G, P), jnp.float32)
    c_a_im = (jnp.pi * jnp.arange(P, dtype=jnp.float32))[None, None, :] \
        + 0.01 * nrm(ks[16], (N_SSM_LAYERS, G, P), jnp.float32)
    c_b_re = nrm(ks[17], (N_SSM_LAYERS, G, P, Cg), jnp.float32) * (2 * Cg) ** -0.5
    c_b_im = nrm(ks[18], (N_SSM_LAYERS, G, P, Cg), jnp.float32) * (2 * Cg) ** -0.5
    c_c_re = nrm(ks[19], (N_SSM_LAYERS, G, Cg, P), jnp.float32) * 0.5
    c_c_im = nrm(ks[20], (N_SSM_LAYERS, G, Cg, P), jnp.float32) * 0.5
    c_d = nrm(ks[21], (N_SSM_LAYERS, SSM_WIDTH), jnp.float32)
    c_w_glu = nrm(ks[22], (N_SSM_LAYERS, SSM_WIDTH, SSM_WIDTH), jnp.float32) * SSM_WIDTH ** -0.5
    c_b_glu = 0.02 * nrm(ks[23], (N_SSM_LAYERS, SSM_WIDTH), jnp.float32)
    c_w_out = nrm(ks[24], (N_SSM_LAYERS, SSM_WIDTH, D), jnp.float32) * SSM_WIDTH ** -0.5
    return {
        "x": x, "norm_g": norm_g,
        "a_w_in": a_w_in, "a_conv_w": a_conv_w, "a_conv_b": a_conv_b,
        "a_ln_g": a_ln_g, "a_ln_b": a_ln_b, "a_w_out": a_w_out,
        "b_w_in": b_w_in, "b_f_bias": b_f_bias, "b_q_norm": b_q_norm,
        "b_k_norm": b_k_norm, "b_w_out": b_w_out,
        "c_w_in": c_w_in, "c_log_dt": c_log_dt, "c_a_re": c_a_re, "c_a_im": c_a_im,
        "c_b_re": c_b_re, "c_b_im": c_b_im, "c_c_re": c_c_re, "c_c_im": c_c_im,
        "c_d": c_d, "c_w_glu": c_w_glu, "c_b_glu": c_b_glu, "c_w_out": c_w_out,
    }


def reference(x, norm_g,
              a_w_in, a_conv_w, a_conv_b, a_ln_g, a_ln_b, a_w_out,
              b_w_in, b_f_bias, b_q_norm, b_k_norm, b_w_out,
              c_w_in, c_log_dt, c_a_re, c_a_im, c_b_re, c_b_im, c_c_re, c_c_im,
              c_d, c_w_glu, c_b_glu, c_w_out):
    h = x
    for layer in range(DEPTH):
        kind = layer % N_MIXERS
        j = layer // N_MIXERS
        hn = rms_norm(h, norm_g[layer])
        if kind == 0:
            y = conv_mixer(hn, a_w_in[j], a_conv_w[j], a_conv_b[j], a_ln_g[j], a_ln_b[j], a_w_out[j])
        elif kind == 1:
            y = fox_mixer(hn, b_w_in[j], b_f_bias[j], b_q_norm[j], b_k_norm[j], b_w_out[j])
        else:
            y = ssm_mixer(hn, c_w_in[j], c_log_dt[j], c_a_re[j], c_a_im[j], c_b_re[j], c_b_im[j],
                          c_c_re[j], c_c_im[j], c_d[j], c_w_glu[j], c_b_glu[j], c_w_out[j])
        h = h + y
    return h
```

```cpp
#include <hip/hip_runtime.h>
#include <hip/hip_cooperative_groups.h>
#include <cstdio>
#include <cstdint>
#include <cmath>
namespace cg = cooperative_groups;

constexpr int BATCH = 8, SEQ = 2048, DMODEL = 1024, MTOK = BATCH * SEQ;
constexpr int CONV_K = 31, NHEADS = 16, HDIM = 64, NGRP = 64, NST = 64, CGRP = 16;
constexpr float RMS_EPS = 1e-6f, LN_EPS = 1e-5f, LOG2E = 1.4426950408889634f;

namespace pg8 {
#define PG8_LAS __attribute__((address_space(3)))
typedef unsigned short bf16_t;
typedef short bf16x8 __attribute__((ext_vector_type(8)));
typedef float f32x4 __attribute__((ext_vector_type(4)));
typedef unsigned u32x4 __attribute__((ext_vector_type(4)));
constexpr int BM = 256, BK = 64, HALF = 128, HTB = HALF * BK * 2  , STAGE_BYTES = 8 * HTB, NXCD = 8, WGM = 8;

__host__ __device__ __forceinline__ int lds_byte(int r, int c) { const int st = (r >> 4) * 2 + (c >> 5), rr = r & 15, cc = c & 31, ob = rr * 64 + cc * 2; return st * 1024 + (ob ^ (((ob >> 9) & 1) << 5)); }
__host__ __device__ __forceinline__ void stage_rc(int b, int& R, int& C) { const int st = b / 1024, sb = b % 1024, swz = sb ^ (((sb >> 9) & 1) << 5); R = (st >> 1) * 16 + swz / 64; C = (st & 1) * 32 + (swz % 64) / 2; }
__host__ __device__ __forceinline__ int perm32(int rho) { const int n = rho >> 4, i = rho & 15; return 8 * (i >> 2) + 4 * n + (i & 3); }

struct Unit { int pm, pn; };
struct Gemm { const bf16_t* A; const bf16_t* Bt; int M, N, K; };

struct StaticOrder {
    int nM, nN, nwg, G, c;
    __host__ __device__ void init(int M, int N, int G_, int c_) { nM = M / BM; nN = N / BM; nwg = nM * nN; G = G_; c = c_; }
    __host__ __device__ bool next(int i, Unit& u) const {
        const long L = (long)i * G + c; if (L >= nwg) return false;
        int wgid = (int)L; { const int q = nwg / NXCD, r = nwg % NXCD, xcd = wgid % NXCD, off = wgid / NXCD; wgid = (xcd < r ? xcd * (q + 1) : r * (q + 1) + (xcd - r) * q) + off; }
        const int nig = WGM * nN, gid = wgid / nig, fm = gid * WGM, gsz = (nM - fm) < WGM ? (nM - fm) : WGM;
        u.pm = fm + ((wgid % nig) % gsz); u.pn = (wgid % nig) / gsz; return true;
    }
    __device__ __forceinline__ void a_ready(const Unit&) const {}
    __device__ __forceinline__ void done(const Unit&) const {}
};
__device__ __forceinline__ unsigned cvt_pk_bf16(float lo, float hi) { unsigned r; asm volatile("v_cvt_pk_bf16_f32 %0, %1, %2" : "=v"(r) : "v"(lo), "v"(hi)); return r; }
typedef float f32x2 __attribute__((ext_vector_type(2)));
typedef unsigned u32x2 __attribute__((ext_vector_type(2)));
__device__ __forceinline__ float sigm(float x) { return __builtin_amdgcn_rcpf(1.0f + __builtin_amdgcn_exp2f(-1.4426950408889634f * x)); }
__device__ __forceinline__ float silu(float x) { return x * sigm(x); }
__device__ __forceinline__ float bflo(unsigned w) { return __uint_as_float(w << 16); }
__device__ __forceinline__ float bfhi(unsigned w) { return __uint_as_float(w & 0xffff0000u); }
__device__ __forceinline__ void row_scales(float (&sc)[2][4], const float* P, int row0, int fq) {
#pragma unroll
    for (int ai = 0; ai < 2; ++ai)
#pragma unroll
        for (int m = 0; m < 4; ++m) { const f32x4 p = *(const f32x4*)(P + (size_t)(row0 + ai * HALF + m * 16) * 16 + 4 * fq);
            float s = (p[0] + p[1]) + (p[2] + p[3]); s += __shfl_xor(s, 16); s += __shfl_xor(s, 32);
            sc[ai][m] = rsqrtf(s * (1.0f / 1024.0f) + 1e-6f); }
}
struct EpiConvIn {
    static constexpr bool PERM = true, AFTER_DRAIN = false;
    const float* P; bf16_t* U; bf16_t* SG;
    __device__ __forceinline__ void operator()(const f32x4 (&acc)[2][2][4][2], const Unit& u, int wr, int wc, int fr, int fq) const {
        const int row0 = u.pm * BM + wr * 64 + fr; float sc[2][4]; row_scales(sc, P, row0, fq);
        if (u.pn < 8) {
            bf16_t* base = U + u.pn * 128 + wc * 32 + 8 * fq;
#pragma unroll
            for (int ai = 0; ai < 2; ++ai)
#pragma unroll
                for (int m = 0; m < 4; ++m) { const float s = sc[ai][m];
                    const f32x4 a0 = acc[ai][0][m][0] * s, a1 = acc[ai][0][m][1] * s, b0 = acc[ai][1][m][0] * s, b1 = acc[ai][1][m][1] * s; u32x4 w;
                    w.x = cvt_pk_bf16(a0[0] * sigm(b0[0]), a0[1] * sigm(b0[1])); w.y = cvt_pk_bf16(a0[2] * sigm(b0[2]), a0[3] * sigm(b0[3]));
                    w.z = cvt_pk_bf16(a1[0] * sigm(b1[0]), a1[1] * sigm(b1[1])); w.w = cvt_pk_bf16(a1[2] * sigm(b1[2]), a1[3] * sigm(b1[3]));
                    *(u32x4*)(base + (size_t)(row0 + ai * HALF + m * 16) * 1024) = w; }
        } else {
            bf16_t* base = SG + (u.pn - 8) * 256 + wc * 32 + 8 * fq;
#pragma unroll
            for (int ai = 0; ai < 2; ++ai)
#pragma unroll
                for (int m = 0; m < 4; ++m) { const float s = sc[ai][m];
#pragma unroll
                    for (int bj = 0; bj < 2; ++bj) { const f32x4 v0 = acc[ai][bj][m][0] * s, v1 = acc[ai][bj][m][1] * s; u32x4 w;
                        w.x = cvt_pk_bf16(silu(v0[0]), silu(v0[1])); w.y = cvt_pk_bf16(silu(v0[2]), silu(v0[3])); w.z = cvt_pk_bf16(silu(v1[0]), silu(v1[1])); w.w = cvt_pk_bf16(silu(v1[2]), silu(v1[3]));
                        *(u32x4*)(base + (size_t)(row0 + ai * HALF + m * 16) * 1024 + bj * HALF) = w; } }
        }
    }
};
struct EpiFoxIn {
    static constexpr bool PERM = true, AFTER_DRAIN = false;
    const float* P; bf16_t* Q; bf16_t* K; bf16_t* V; bf16_t* SG; const float* qg; const float* kg;
    __device__ __forceinline__ void operator()(const f32x4 (&acc)[2][2][4][2], const Unit& u, int wr, int wc, int fr, int fq) const {
        const int row0 = u.pm * BM + wr * 64 + fr; float sc[2][4]; row_scales(sc, P, row0, fq);
        const int sec = u.pn >> 2, colb = (4 * (u.pn & 3) + wc) * 64 + 8 * fq;
        if (sec < 2) {
            const float* g = sec == 0 ? qg : kg; bf16_t* dst = (sec == 0 ? Q : K) + colb; const float post = sec == 0 ? 0.125f * 1.4426950408889634f : 1.0f;
            f32x4 gv[2][2];
#pragma unroll
            for (int bj = 0; bj < 2; ++bj)
#pragma unroll
                for (int n = 0; n < 2; ++n) gv[bj][n] = *(const f32x4*)(g + 32 * bj + 8 * fq + 4 * n);
#pragma unroll
            for (int ai = 0; ai < 2; ++ai)
#pragma unroll
                for (int m = 0; m < 4; ++m) { const float s = sc[ai][m]; f32x4 x[2][2]; float ss = 0.f;
#pragma unroll
                    for (int bj = 0; bj < 2; ++bj)
#pragma unroll
                        for (int n = 0; n < 2; ++n) { x[bj][n] = acc[ai][bj][m][n] * s; ss += (x[bj][n][0] * x[bj][n][0] + x[bj][n][1] * x[bj][n][1]) + (x[bj][n][2] * x[bj][n][2] + x[bj][n][3] * x[bj][n][3]); }
                    ss += __shfl_xor(ss, 16); ss += __shfl_xor(ss, 32);
                    const float r = rsqrtf(ss * (1.0f / 64.0f) + 1e-6f) * post;
#pragma unroll
                    for (int bj = 0; bj < 2; ++bj) { const f32x4 y0 = x[bj][0] * gv[bj][0] * r, y1 = x[bj][1] * gv[bj][1] * r; u32x4 w;
                        w.x = cvt_pk_bf16(y0[0], y0[1]); w.y = cvt_pk_bf16(y0[2], y0[3]); w.z = cvt_pk_bf16(y1[0], y1[1]); w.w = cvt_pk_bf16(y1[2], y1[3]);
                        *(u32x4*)(dst + (size_t)(row0 + ai * HALF + m * 16) * 1024 + 32 * bj) = w; } }
        } else {
            bf16_t* dst = (sec == 2 ? V : SG) + colb;
#pragma unroll
            for (int ai = 0; ai < 2; ++ai)
#pragma unroll
                for (int m = 0; m < 4; ++m) { const float s = sc[ai][m];
#pragma unroll
                    for (int bj = 0; bj < 2; ++bj) { f32x4 v0 = acc[ai][bj][m][0] * s, v1 = acc[ai][bj][m][1] * s;
                        if (sec == 3) { v0 = (f32x4){silu(v0[0]), silu(v0[1]), silu(v0[2]), silu(v0[3])}; v1 = (f32x4){silu(v1[0]), silu(v1[1]), silu(v1[2]), silu(v1[3])}; }
                        u32x4 w; w.x = cvt_pk_bf16(v0[0], v0[1]); w.y = cvt_pk_bf16(v0[2], v0[3]); w.z = cvt_pk_bf16(v1[0], v1[1]); w.w = cvt_pk_bf16(v1[2], v1[3]);
                        *(u32x4*)(dst + (size_t)(row0 + ai * HALF + m * 16) * 1024 + 32 * bj) = w; } }
        }
    }
};
struct EpiSsmIn {
    static constexpr bool PERM = true, AFTER_DRAIN = false;
    const float* P; bf16_t* U; bf16_t* SG;
    __device__ __forceinline__ void operator()(const f32x4 (&acc)[2][2][4][2], const Unit& u, int wr, int wc, int fr, int fq) const {
        const int row0 = u.pm * BM + wr * 64 + fr; float sc[2][4]; row_scales(sc, P, row0, fq);
        const bool gate = u.pn >= 4; bf16_t* dst = (gate ? SG : U) + (u.pn & 3) * 256 + wc * 32 + 8 * fq;
#pragma unroll
        for (int ai = 0; ai < 2; ++ai)
#pragma unroll
            for (int m = 0; m < 4; ++m) { const float s = sc[ai][m];
#pragma unroll
                for (int bj = 0; bj < 2; ++bj) { f32x4 v0 = acc[ai][bj][m][0] * s, v1 = acc[ai][bj][m][1] * s;
                    if (gate) { v0 = (f32x4){silu(v0[0]), silu(v0[1]), silu(v0[2]), silu(v0[3])}; v1 = (f32x4){silu(v1[0]), silu(v1[1]), silu(v1[2]), silu(v1[3])}; }
                    u32x4 w; w.x = cvt_pk_bf16(v0[0], v0[1]); w.y = cvt_pk_bf16(v0[2], v0[3]); w.z = cvt_pk_bf16(v1[0], v1[1]); w.w = cvt_pk_bf16(v1[2], v1[3]);
                    *(u32x4*)(dst + (size_t)(row0 + ai * HALF + m * 16) * 1024 + bj * HALF) = w; } }
    }
};
struct EpiOut {
    static constexpr bool PERM = true, AFTER_DRAIN = false;
    bf16_t* hb; float* P; float* out; int last;
    __device__ __forceinline__ void operator()(const f32x4 (&acc)[2][2][4][2], const Unit& u, int wr, int wc, int fr, int fq) const {
        const int row0 = u.pm * BM + wr * 64 + fr, col0 = u.pn * BM + wc * 32 + 8 * fq;
#pragma unroll
        for (int ai = 0; ai < 2; ++ai)
#pragma unroll
            for (int m = 0; m < 4; ++m) { const int row = row0 + ai * HALF + m * 16; float ss = 0.f;
#pragma unroll
                for (int bj = 0; bj < 2; ++bj) { const size_t off = (size_t)row * 1024 + col0 + bj * HALF;
                    const u32x4 r = *(const u32x4*)(hb + off);
                    const f32x4 h0 = (f32x4){bflo(r.x), bfhi(r.x), bflo(r.y), bfhi(r.y)} + acc[ai][bj][m][0], h1 = (f32x4){bflo(r.z), bfhi(r.z), bflo(r.w), bfhi(r.w)} + acc[ai][bj][m][1];
                    if (last) { __builtin_nontemporal_store(h0, (f32x4*)(out + off)); __builtin_nontemporal_store(h1, (f32x4*)(out + off + 4)); }
                    else { ss += ((h0[0] * h0[0] + h0[1] * h0[1]) + (h0[2] * h0[2] + h0[3] * h0[3])) + ((h1[0] * h1[0] + h1[1] * h1[1]) + (h1[2] * h1[2] + h1[3] * h1[3]));
                        u32x4 w; w.x = cvt_pk_bf16(h0[0], h0[1]); w.y = cvt_pk_bf16(h0[2], h0[3]); w.z = cvt_pk_bf16(h1[0], h1[1]); w.w = cvt_pk_bf16(h1[2], h1[3]); *(u32x4*)(hb + off) = w; } }
                if (!last) { ss += __shfl_xor(ss, 16); ss += __shfl_xor(ss, 32); if (fq == 0) P[(size_t)row * 16 + 4 * u.pn + wc] = ss; } }
    }
};
struct EpiGlu {
    static constexpr bool PERM = true, AFTER_DRAIN = false;
    const bf16_t* G; const bf16_t* SG; const float* bias; bf16_t* Y;
    __device__ __forceinline__ void operator()(const f32x4 (&acc)[2][2][4][2], const Unit& u, int wr, int wc, int fr, int fq) const {
        const int row0 = u.pm * BM + wr * 64 + fr, col0 = u.pn * BM + wc * 32 + 8 * fq;
        f32x4 bv[2][2];
#pragma unroll
        for (int bj = 0; bj < 2; ++bj)
#pragma unroll
            for (int n = 0; n < 2; ++n) bv[bj][n] = *(const f32x4*)(bias + col0 + bj * HALF + 4 * n);
#pragma unroll
        for (int ai = 0; ai < 2; ++ai)
#pragma unroll
            for (int m = 0; m < 4; ++m)
#pragma unroll
                for (int bj = 0; bj < 2; ++bj) { const size_t off = (size_t)(row0 + ai * HALF + m * 16) * 1024 + col0 + bj * HALF;
                    const u32x4 gq = *(const u32x4*)(G + off), sq = *(const u32x4*)(SG + off);
                    const f32x4 t0 = acc[ai][bj][m][0] + bv[bj][0], t1 = acc[ai][bj][m][1] + bv[bj][1]; u32x4 w;
                    w.x = cvt_pk_bf16(bflo(gq.x) * sigm(t0[0]) * bflo(sq.x), bfhi(gq.x) * sigm(t0[1]) * bfhi(sq.x));
                    w.y = cvt_pk_bf16(bflo(gq.y) * sigm(t0[2]) * bflo(sq.y), bfhi(gq.y) * sigm(t0[3]) * bfhi(sq.y));
                    w.z = cvt_pk_bf16(bflo(gq.z) * sigm(t1[0]) * bflo(sq.z), bfhi(gq.z) * sigm(t1[1]) * bfhi(sq.z));
                    w.w = cvt_pk_bf16(bflo(gq.w) * sigm(t1[2]) * bflo(sq.w), bfhi(gq.w) * sigm(t1[3]) * bfhi(sq.w));
                    *(u32x4*)(Y + off) = w; }
    }
};

template <class Epi, class Sched, bool ALIGN_EPI = false, bool SP2 = false>
__device__ __forceinline__ void gemm_phase(PG8_LAS unsigned char* lds, const Gemm g, const Sched& S, const Epi& E, const int tid) {
    const int wid = __builtin_amdgcn_readfirstlane(tid >> 6), lane = tid & 63, wr = wid >> 2, wc = wid & 3, fr = lane & 15, fq = lane >> 4;
    const int K = g.K, nt = K / BK;
    unsigned voffA[2], voffB[2];
#pragma unroll
    for (int i = 0; i < 2; ++i) { int R, C; stage_rc(tid * 16 + i * 8192, R, C); const int Rb = Epi::PERM ? ((R & ~31) + perm32(R & 31)) : R;
        voffA[i] = (unsigned)(R * K + C) * 2u; voffB[i] = (unsigned)(Rb * K + C) * 2u; }
    const size_t kstep = (size_t)(BK * 2);
    const size_t hstep = (size_t)HALF * K * 2;
    const size_t tstep = 2 * hstep;
    const unsigned ldsw = (unsigned)wid * 1024u;
    const int aoff = lds_byte(wr * 64 + fr, fq * 8), boff = lds_byte(wc * 32 + fr, fq * 8);
#define PG8_SA(b, h) (((b) * 2 + (h)) * HTB)
#define PG8_SB(b, h) ((4 + (b) * 2 + (h)) * HTB)
#define PG8_STAGE(bufoff, gbase, voff) do { _Pragma("unroll") for (int _i = 0; _i < 2; ++_i) \
        __builtin_amdgcn_global_load_lds((const unsigned*)((const char*)(gbase) + (voff)[_i]), (PG8_LAS unsigned*)(lds + (bufoff) + ldsw + _i * 8192), 16, 0, 0); } while (0)
#define PG8_LDA(dst, b, h) do { _Pragma("unroll") for (int m = 0; m < 4; ++m) _Pragma("unroll") for (int k = 0; k < 2; ++k) dst[m][k] = *(const PG8_LAS bf16x8*)(lds + PG8_SA(b, h) + aoff + m * 2048 + k * 1024); } while (0)
#define PG8_LDB(dst, b, h) do { _Pragma("unroll") for (int n = 0; n < 2; ++n) _Pragma("unroll") for (int k = 0; k < 2; ++k) dst[n][k] = *(const PG8_LAS bf16x8*)(lds + PG8_SB(b, h) + boff + n * 2048 + k * 1024); } while (0)
#define PG8_MMA(ai, bj, At, Bt) do { __builtin_amdgcn_s_setprio(1); _Pragma("unroll") for (int m = 0; m < 4; ++m) _Pragma("unroll") for (int n = 0; n < 2; ++n) _Pragma("unroll") for (int k = 0; k < 2; ++k) \
        acc[ai][bj][m][n] = __builtin_amdgcn_mfma_f32_16x16x32_bf16(Bt[n][k], At[m][k], acc[ai][bj][m][n], 0, 0, 0); __builtin_amdgcn_s_setprio(0); } while (0)
#define PG8_WAIT_V(n) asm volatile("s_waitcnt vmcnt(" #n ")" ::: "memory")
#define PG8_WAIT_L(n) asm volatile("s_waitcnt lgkmcnt(" #n ")" ::: "memory")
#define PG8_BAR __builtin_amdgcn_s_barrier()
#define PG8_SCHED __builtin_amdgcn_sched_barrier(0)
    Unit cur, nxt; int ui = 0;
    if (!S.next(0, cur)) return;
    f32x4 acc[2][2][4][2];
#pragma unroll
    for (int a = 0; a < 2; ++a)
#pragma unroll
        for (int b = 0; b < 2; ++b)
#pragma unroll
            for (int m = 0; m < 4; ++m)
#pragma unroll
                for (int n = 0; n < 2; ++n) acc[a][b][m][n] = (f32x4){0.f, 0.f, 0.f, 0.f};
    bf16x8 At[4][2], B0[2][2], B1[2][2];
    const char* cA = (const char*)g.A + (size_t)cur.pm * tstep; const char* cB = (const char*)g.Bt + (size_t)cur.pn * tstep;
    S.a_ready(cur);
    if constexpr (SP2) {
        PG8_STAGE(PG8_SB(0, 0), cB, voffB); PG8_STAGE(PG8_SB(0, 1), cB + hstep, voffB); PG8_STAGE(PG8_SA(0, 0), cA, voffA); PG8_STAGE(PG8_SA(0, 1), cA + hstep, voffA);
        if (wr == 1) PG8_BAR;
        PG8_WAIT_V(2); PG8_BAR;
        PG8_STAGE(PG8_SB(1, 0), cB + kstep, voffB); PG8_STAGE(PG8_SA(1, 0), cA + kstep, voffA); PG8_STAGE(PG8_SB(1, 1), cB + hstep + kstep, voffB);
        PG8_WAIT_V(6); PG8_BAR;
    } else {
        PG8_STAGE(PG8_SB(0, 0), cB, voffB); PG8_STAGE(PG8_SA(0, 0), cA, voffA); PG8_STAGE(PG8_SB(0, 1), cB + hstep, voffB); PG8_STAGE(PG8_SA(0, 1), cA + hstep, voffA);
        if (wr == 1) PG8_BAR;
        PG8_WAIT_V(4); PG8_BAR;
        PG8_STAGE(PG8_SB(1, 0), cB + kstep, voffB); PG8_STAGE(PG8_SA(1, 0), cA + kstep, voffA); PG8_STAGE(PG8_SB(1, 1), cB + hstep + kstep, voffB);
        PG8_WAIT_V(6); PG8_BAR;
    }
    for (;;) {
        const bool has_next = S.next(ui + 1, nxt);
        const char* nA = has_next ? (const char*)g.A + (size_t)nxt.pm * tstep : cA; const char* nB = has_next ? (const char*)g.Bt + (size_t)nxt.pn * tstep : cB;
        for (int t = 0; t < nt; t += 2) {
            const bool last = (t == nt - 2);
            const char* a1 = cA + (size_t)(t + 1) * kstep;
            const char* a2 = last ? nA : cA + (size_t)(t + 2) * kstep; const char* b2 = last ? nB : cB + (size_t)(t + 2) * kstep;
            const char* a3 = a2 + kstep; const char* b3 = b2 + kstep;
            if (last && has_next) S.a_ready(nxt);
            if constexpr (SP2) {
            PG8_LDB(B0, 0, 0); PG8_LDB(B1, 0, 1); PG8_SCHED; PG8_LDA(At, 0, 0); PG8_STAGE(PG8_SA(1, 1), a1 + hstep, voffA);
            PG8_WAIT_V(8); PG8_WAIT_L(0); PG8_BAR; PG8_MMA(0, 0, At, B0); PG8_MMA(0, 1, At, B1); PG8_BAR; PG8_SCHED;
            PG8_LDA(At, 0, 1); PG8_STAGE(PG8_SB(0, 0), b2, voffB); PG8_STAGE(PG8_SB(0, 1), b2 + hstep, voffB); PG8_STAGE(PG8_SA(0, 0), a2, voffA);
            PG8_WAIT_V(8); PG8_WAIT_L(0); PG8_BAR; PG8_MMA(1, 0, At, B0); PG8_MMA(1, 1, At, B1); PG8_BAR; PG8_SCHED;
            PG8_LDB(B0, 1, 0); PG8_LDB(B1, 1, 1); PG8_SCHED; PG8_LDA(At, 1, 0); PG8_STAGE(PG8_SA(0, 1), a2 + hstep, voffA);
            PG8_WAIT_V(8); PG8_WAIT_L(0); PG8_BAR; PG8_MMA(0, 0, At, B0); PG8_MMA(0, 1, At, B1); PG8_BAR; PG8_SCHED;
            PG8_LDA(At, 1, 1); PG8_STAGE(PG8_SB(1, 0), b3, voffB); PG8_STAGE(PG8_SB(1, 1), b3 + hstep, voffB); PG8_STAGE(PG8_SA(1, 0), a3, voffA);
            PG8_WAIT_V(8); PG8_WAIT_L(0); PG8_BAR; PG8_MMA(1, 0, At, B0); PG8_MMA(1, 1, At, B1); PG8_BAR; PG8_SCHED;
            } else {
            PG8_LDB(B0, 0, 0); PG8_SCHED; PG8_LDA(At, 0, 0); PG8_STAGE(PG8_SA(1, 1), a1 + hstep, voffA);
            PG8_WAIT_L(8); PG8_BAR; PG8_WAIT_L(0); PG8_MMA(0, 0, At, B0); PG8_BAR; PG8_SCHED;
            PG8_LDB(B1, 0, 1); PG8_STAGE(PG8_SB(0, 0), b2, voffB);
            PG8_BAR; PG8_WAIT_L(0); PG8_MMA(0, 1, At, B1); PG8_BAR;
            PG8_LDA(At, 0, 1); PG8_STAGE(PG8_SA(0, 0), a2, voffA);
            PG8_BAR; PG8_WAIT_L(0); PG8_MMA(1, 0, At, B0); PG8_BAR; PG8_SCHED;
            PG8_STAGE(PG8_SB(0, 1), b2 + hstep, voffB);
            PG8_WAIT_V(6); PG8_BAR; PG8_MMA(1, 1, At, B1); PG8_BAR;
            PG8_LDB(B0, 1, 0); PG8_SCHED; PG8_LDA(At, 1, 0); PG8_STAGE(PG8_SA(0, 1), a2 + hstep, voffA);
            PG8_WAIT_L(8); PG8_BAR; PG8_WAIT_L(0); PG8_MMA(0, 0, At, B0); PG8_BAR; PG8_SCHED;
            PG8_LDB(B1, 1, 1); PG8_STAGE(PG8_SB(1, 0), b3, voffB);
            PG8_BAR; PG8_WAIT_L(0); PG8_MMA(0, 1, At, B1); PG8_BAR;
            PG8_LDA(At, 1, 1); PG8_STAGE(PG8_SA(1, 0), a3, voffA);
            PG8_BAR; PG8_WAIT_L(0); PG8_MMA(1, 0, At, B0); PG8_BAR; PG8_SCHED;
            PG8_STAGE(PG8_SB(1, 1), b3 + hstep, voffB);
            PG8_WAIT_V(6); PG8_BAR; PG8_MMA(1, 1, At, B1); PG8_BAR;
            }
        }
        if constexpr (ALIGN_EPI) { if (wr == 0) PG8_BAR; }
        if constexpr (!Epi::AFTER_DRAIN) { E(acc, cur, wr, wc, fr, fq); S.done(cur); }
        if (!has_next) break;
#pragma unroll
        for (int a = 0; a < 2; ++a)
#pragma unroll
            for (int b = 0; b < 2; ++b)
#pragma unroll
                for (int m = 0; m < 4; ++m)
#pragma unroll
                    for (int n = 0; n < 2; ++n) acc[a][b][m][n] = (f32x4){0.f, 0.f, 0.f, 0.f};
        cur = nxt; cA = nA; cB = nB; ++ui;
        if constexpr (ALIGN_EPI) { if (wr == 1) PG8_BAR; }
    }
    PG8_WAIT_V(0);
    if constexpr (!ALIGN_EPI) { if (wr == 0) PG8_BAR; }
    PG8_BAR;
    if constexpr (Epi::AFTER_DRAIN) { E.fused(acc, cur, wr, wc, fr, fq, lds, wid, lane); S.done(cur); }
#undef PG8_SA
#undef PG8_SB
#undef PG8_STAGE
#undef PG8_LDA
#undef PG8_LDB
#undef PG8_MMA
#undef PG8_WAIT_V
#undef PG8_WAIT_L
#undef PG8_BAR
#undef PG8_SCHED
}
}
#include <hip/hip_bf16.h>
#include <cmath>
namespace attn_body {
using bf16=__hip_bfloat16;
using bf16x8=__attribute__((ext_vector_type(8)))short;
using s16x4=__attribute__((ext_vector_type(4)))short;
using f32x16=__attribute__((ext_vector_type(16)))float;
using u32x4=__attribute__((ext_vector_type(4)))unsigned;
constexpr int BATCH=8,NHEAD=16,SEQ=2048,D=64,DM=NHEAD*D;
constexpr int NW=8,QBLK=32,QB=QBLK*NW,KVBLK=64,NQB=SEQ/QB;
constexpr int ATTN_PITCH=DM, ATTN_UNIT_ROWS=QB;
__device__ __forceinline__ int crow(int r,int hi){return (r&3)+8*(r>>2)+4*hi;}
#define SBAR() __builtin_amdgcn_sched_barrier(0)
__device__ __forceinline__ void cmask(f32x16&p0,f32x16&p1,int jb,int qrel,int hi){
  const float NEG=-INFINITY; int kb=64*jb+4*hi;
  #pragma unroll
  for(int r=0;r<16;++r){int kv=kb+(r&3)+8*(r>>2); if(kv>qrel)p0[r]=NEG; if(kv+32>qrel)p1[r]=NEG;}
}

constexpr int NSLOT=3, SLOTB=8192;
constexpr int LDS_K=0, LDS_V=NSLOT*SLOTB, LDS_WS=2*NSLOT*SLOTB, LDS_OST=LDS_WS+NW*64*4, LDS_CK=LDS_OST+NW*4096, LDS_BYTES=LDS_CK+SEQ*8;
constexpr float C2=0.125f*1.4426950408889634f;
__device__ __forceinline__ void glds16(const void*gsrc,unsigned lds_dst){unsigned keep;
  asm volatile("s_mov_b32 %0, m0\n\ts_mov_b32 m0, %2\n\ts_nop 0\n\tglobal_load_lds_dwordx4 %1, off\n\ts_mov_b32 m0, %0":"=&s"(keep):"v"(gsrc),"s"(lds_dst):"memory");}
__device__ __forceinline__ float max3f(float a,float b,float c){float r;asm("v_max3_f32 %0, %1, %2, %3":"=v"(r):"v"(a),"v"(b),"v"(c));return r;}
__device__ __forceinline__ float max2f(float a,float b){float r;asm("v_max_f32_e32 %0, %1, %2":"=v"(r):"v"(a),"v"(b));return r;}
__device__ __forceinline__ float fadd_s(float a,float b){float r;asm("v_add_f32_e32 %0, %1, %2":"=v"(r):"v"(a),"v"(b));return r;}
__device__ __forceinline__ float fsub_s(float a,float b){float r;asm("v_sub_f32_e32 %0, %1, %2":"=v"(r):"v"(a),"v"(b));return r;}
typedef float f32x2_t __attribute__((ext_vector_type(2))); typedef __bf16 bf16x2_t __attribute__((ext_vector_type(2)));
__device__ __forceinline__ unsigned cvtpk_s(float lo,float hi){f32x2_t v={lo,hi};bf16x2_t b=__builtin_convertvector(v,bf16x2_t);return __builtin_bit_cast(unsigned,b);}
#define WAIT_BAR(N) asm volatile("s_waitcnt vmcnt(" #N ") lgkmcnt(0)\n\ts_barrier":::"memory")

__device__ __forceinline__ void qkt(f32x16&p0,f32x16&p1,const char*Kslot,const bf16x8*qr,int r32,int hi){
  const char*kb=Kslot+hi*1024+r32*16;
  #pragma unroll
  for(int d0=0;d0<4;++d0){
    const bf16x8 b0=*reinterpret_cast<const bf16x8*>(kb+d0*2048);
    const bf16x8 b1=*reinterpret_cast<const bf16x8*>(kb+d0*2048+512);
    p0=__builtin_amdgcn_mfma_f32_32x32x16_bf16(b0,qr[d0],p0,0,0,0);p1=__builtin_amdgcn_mfma_f32_32x32x16_bf16(b1,qr[d0],p1,0,0,0);}
}
typedef __attribute__((address_space(3))) const char* lds_cptr;
typedef short v4i16_t __attribute__((ext_vector_type(4)));
__device__ __forceinline__ void kload8(bf16x8*kf,lds_cptr kp){
  kf[0]=*(const __attribute__((address_space(3))) bf16x8*)(kp);      kf[1]=*(const __attribute__((address_space(3))) bf16x8*)(kp+512);
  kf[2]=*(const __attribute__((address_space(3))) bf16x8*)(kp+2048); kf[3]=*(const __attribute__((address_space(3))) bf16x8*)(kp+2560);
  kf[4]=*(const __attribute__((address_space(3))) bf16x8*)(kp+4096); kf[5]=*(const __attribute__((address_space(3))) bf16x8*)(kp+4608);
  kf[6]=*(const __attribute__((address_space(3))) bf16x8*)(kp+6144); kf[7]=*(const __attribute__((address_space(3))) bf16x8*)(kp+6656);
}
__device__ __forceinline__ void kload2(bf16x8*kf,lds_cptr kp,int j){ kf[2*j]=*(const __attribute__((address_space(3))) bf16x8*)(kp+j*2048); kf[2*j+1]=*(const __attribute__((address_space(3))) bf16x8*)(kp+j*2048+512); }
__device__ __forceinline__ s16x4 vtr(lds_cptr p){ return __builtin_bit_cast(s16x4,__builtin_amdgcn_ds_read_tr16_b64_v4i16((__attribute__((address_space(3))) v4i16_t*)p)); }
__device__ __forceinline__ float rowmax(const f32x16&p0,const f32x16&p1){
  float a=max3f(p0[0],p0[1],p1[0]),b=max3f(p0[2],p0[3],p1[1]);a=max3f(a,p1[2],p1[3]);
  #pragma unroll
  for(int r=4;r<16;r+=4){a=max3f(a,p0[r],p0[r+1]);b=max3f(b,p0[r+2],p0[r+3]);a=max3f(a,p1[r],p1[r+1]);b=max3f(b,p1[r+2],p1[r+3]);}
  const float m=max2f(a,b);
  auto rr=__builtin_amdgcn_permlane32_swap(__float_as_uint(m),__float_as_uint(m),false,false);
  return max2f(__uint_as_float(rr[0]),__uint_as_float(rr[1]));
}
__device__ __forceinline__ void pv(f32x16*o,int vb,bf16x8 pa0,bf16x8 pa1,bf16x8 pa2,bf16x8 pa3){
  #pragma unroll
  for(int d0=0;d0<2;++d0){s16x4 lo[4],hi[4];
    #pragma unroll
    for(int ks=0;ks<4;++ks){
      asm volatile("ds_read_b64_tr_b16 %0,%1 offset:%c2":"=&v"(lo[ks]):"v"(vb),"i"(d0*4096+ks*1024):"memory");
      asm volatile("ds_read_b64_tr_b16 %0,%1 offset:%c2":"=&v"(hi[ks]):"v"(vb),"i"(d0*4096+ks*1024+512):"memory");}
    asm volatile("s_waitcnt lgkmcnt(0)":::"memory");SBAR();
    #define PK(k) (bf16x8){lo[k][0],lo[k][1],lo[k][2],lo[k][3],hi[k][0],hi[k][1],hi[k][2],hi[k][3]}
    o[d0]=__builtin_amdgcn_mfma_f32_32x32x16_bf16(pa0,PK(0),o[d0],0,0,0);
    o[d0]=__builtin_amdgcn_mfma_f32_32x32x16_bf16(pa1,PK(1),o[d0],0,0,0);
    o[d0]=__builtin_amdgcn_mfma_f32_32x32x16_bf16(pa2,PK(2),o[d0],0,0,0);
    o[d0]=__builtin_amdgcn_mfma_f32_32x32x16_bf16(pa3,PK(3),o[d0],0,0,0);
    #undef PK
  }
}

typedef __attribute__((address_space(3))) const float* lds_fptr;
typedef float f32x4_t __attribute__((ext_vector_type(4)));
typedef unsigned u32x2_t __attribute__((ext_vector_type(2)));
__device__ __forceinline__ unsigned bfr(float f){ const unsigned u=__float_as_uint(f); return (u+0x7fffu+((u>>16)&1u))>>16; }
__device__ __forceinline__ void split3(float v,unsigned&h,unsigned&m,unsigned&l){ h=bfr(v); const float r=v-__uint_as_float(h<<16); m=bfr(r); const float r2=r-__uint_as_float(m<<16); l=bfr(r2); }
__device__ __forceinline__ bf16x8 kxfrag(lds_cptr p){ const u32x2_t w=*(const __attribute__((address_space(3))) u32x2_t*)p; const u32x4 f={w[0],w[1],0xBF80BF80u,0u}; return __builtin_bit_cast(bf16x8,f); }
__device__ __forceinline__ bf16x8 mkqx(float mh,int hi){ unsigned h,m,l; split3(mh,h,m,l); u32x4 f={0x3F803F80u,0x3F80u|(h<<16),m|(l<<16),0u}; if(hi)f=u32x4{0u,0u,0u,0u}; return __builtin_bit_cast(bf16x8,f); }
#ifndef ATTN_STORE16
#define ATTN_STORE16(p,v) (*(u32x4*)(p)=(v))
#endif
template<int THRL> __device__ __forceinline__ void attn_unit(int b,int h,int qb,const bf16*Q,const bf16*__restrict__ K,const bf16*__restrict__ V,const bf16*__restrict__ SG,bf16*O,char*shm,const int tid_in,const bool pre,const bool nxt,const float bref){
  int tid=tid_in; asm volatile("":"+v"(tid));
  const int lane=tid&63,r32=lane&31,hi=lane>>5; const int wid=__builtin_amdgcn_readfirstlane(tid>>6);
  const long rowbase=(long)b*SEQ; const int q0=qb*QB;
  const bf16*Qw=Q+(rowbase+q0+wid*QBLK)*DM+h*D;
  const bf16*Kh=K+rowbase*DM+h*D,*Vh=V+rowbase*DM+h*D;
  const unsigned lds0=(unsigned)(uintptr_t)shm;
  float*wsf=(float*)(shm+LDS_WS)+wid*64;
  const bf16*ksrc=Kh+(long)lane*DM+wid*8;
  const bf16*vsrc=Vh+(long)(16*(wid&3)+(lane>>2))*DM+(wid>>2)*32+(lane&3)*8;
  const unsigned kdst=lds0+LDS_K+wid*1024, vdst=lds0+LDS_V+wid*1024;
  #define DMA_K(t,slot) glds16(ksrc+(long)(t)*KVBLK*DM,(unsigned)__builtin_amdgcn_readfirstlane(kdst+(slot)))
  #define DMA_V(t,slot) glds16(vsrc+(long)(t)*KVBLK*DM,(unsigned)__builtin_amdgcn_readfirstlane(vdst+(slot)))
  const int vb0=(int)(lds0+LDS_V)+((lane>>4)&1)*32+(lane&3)*8+(4*hi+((lane&15)>>2))*64;
  const char*Kbase=shm+LDS_K; bf16x8 kf[8];
  const lds_cptr shm3=(lds_cptr)shm; const lds_cptr kxp=shm3+LDS_CK+r32*8; const lds_cptr kp0=shm3+LDS_K+hi*1024+r32*16; const lds_cptr vp0=shm3+LDS_V+((lane>>4)&1)*32+(lane&3)*8+(4*hi+((lane&15)>>2))*64;
  const int NT=(q0+QB)/KVBLK;
  if(!pre){DMA_K(0,0);DMA_V(0,0);DMA_K(1,SLOTB);}
  bf16x8 qr[4];
  #pragma unroll
  for(int d0=0;d0<4;++d0)qr[d0]=*reinterpret_cast<const bf16x8*>(&Qw[(long)r32*DM+d0*16+hi*8]);
  float l_reg=0.f;f32x16 o[2];o[0]=f32x16{};o[1]=f32x16{};
  const int qrel=wid*QBLK+r32;
  #define CMASK(P0,P1,t) do{int jb_=(t)-(NT-4); if(jb_>=0)cmask(P0,P1,jb_,qrel,hi);}while(0)
  f32x16 pA0,pA1,pB0,pB1;
  int sl_prev=0,sl_cur=0,sl_next=SLOTB;
  #define ROT() do{sl_prev=sl_cur;sl_cur=sl_next;sl_next=(sl_next==(NSLOT-1)*SLOTB)?0:sl_next+SLOTB;}while(0)
  if(!pre){DMA_K(2,2*SLOTB);}
  WAIT_BAR(3);
  float mref; { const u32x2_t w=*(const __attribute__((address_space(3))) u32x2_t*)(shm3+LDS_CK+(q0+wid*QBLK+r32)*8); mref=(__uint_as_float(w[0]<<16)+__uint_as_float(w[0]&0xffff0000u))+__uint_as_float(w[1]<<16)+bref; }
  const bf16x8 qx=mkqx(mref,hi); const f32x16 zero16=f32x16{};
  pA0=__builtin_amdgcn_mfma_f32_32x32x16_bf16(kxfrag(kxp),qx,zero16,0,0,0); pA1=__builtin_amdgcn_mfma_f32_32x32x16_bf16(kxfrag(kxp+256),qx,zero16,0,0,0);
  qkt(pA0,pA1,Kbase,qr,r32,hi);asm volatile("s_nop 15\n\ts_nop 7":"+v"(pA0),"+v"(pA1));CMASK(pA0,pA1,0);
  _Pragma("unroll") for(int r=0;r<16;++r){pA0[r]=__builtin_amdgcn_exp2f(pA0[r]);pA1[r]=__builtin_amdgcn_exp2f(pA1[r]);}
  WAIT_BAR(0);
  DMA_K(3,0);DMA_V(1,SLOTB);
  ROT();
  kload8(kf,kp0+sl_cur);
  WAIT_BAR(2);
  s16x4 vlo[8],vhi[8]; u32x4 pw0,pw1,pw2,pw3;
  #define PKW(P,B) cvtpk_s(P[B],P[B+1])
  #define PAF(k) __builtin_bit_cast(bf16x8,pw##k)
  #define VFR(i) (bf16x8){vlo[i][0],vlo[i][1],vlo[i][2],vlo[i][3],vhi[i][0],vhi[i][1],vhi[i][2],vhi[i][3]}
  #define PIN(x) asm volatile("":"+v"(x))
  #define MX3(a,b,c) __builtin_fmaxf(__builtin_fmaxf((a),(b)),(c))
  #define GAPA(MF,A0,A1,A2,A3,W0,W1,PW) do{ MF; sacc+=A0; sacc+=A1; sacc+=A2; sacc+=A3; PIN(sacc); W0; W1; PIN(PW); SBAR(); }while(0)
  #define EX(v) __builtin_amdgcn_exp2f(v)
  #define GAPB(MF,X,B) do{ MF; X[B]=EX(X[B]); X[B+1]=EX(X[B+1]); X[B+2]=EX(X[B+2]); X[B+3]=EX(X[B+3]); PIN(X); SBAR(); }while(0)
  #define VRD(i) do{ vlo[i]=vtr(vp_+(((i)>>2)*4096+((i)&3)*1024)); vhi[i]=vtr(vp_+(((i)>>2)*4096+((i)&3)*1024+512)); }while(0)
  #define KRD(G,j) do{ if(G){ kload2(kf,kp0+sl_next,j); SBAR(); } }while(0)
  #define STEP(C0,C1,P0,P1,t,GK,GV,GL) do{ SBAR(); \
    const lds_cptr vp_=vp0+sl_prev; \
    C0=__builtin_amdgcn_mfma_f32_32x32x16_bf16(kxfrag(kxp+(t)*512),qx,zero16,0,0,0); C1=__builtin_amdgcn_mfma_f32_32x32x16_bf16(kxfrag(kxp+(t)*512+256),qx,zero16,0,0,0); SBAR(); \
    VRD(0); SBAR(); float sacc=(P0[0]+P0[1]); \
    GAPA(C0=__builtin_amdgcn_mfma_f32_32x32x16_bf16(kf[0],qr[0],C0,0,0,0), P0[2],P0[3],P0[4],P0[5],     pw0[0]=PKW(P0,0), pw0[1]=PKW(P0,2), pw0); \
    VRD(4); SBAR(); GAPA(C1=__builtin_amdgcn_mfma_f32_32x32x16_bf16(kf[1],qr[0],C1,0,0,0), P0[6],P0[7],P0[8],P0[9],     pw0[2]=PKW(P0,4), pw0[3]=PKW(P0,6), pw0); \
    VRD(1); SBAR(); GAPA(C0=__builtin_amdgcn_mfma_f32_32x32x16_bf16(kf[2],qr[1],C0,0,0,0),   P0[10],P0[11],P0[12],P0[13], pw1[0]=PKW(P0,8), pw1[1]=PKW(P0,10), pw1); \
    VRD(5); SBAR(); GAPA(C1=__builtin_amdgcn_mfma_f32_32x32x16_bf16(kf[3],qr[1],C1,0,0,0),   P0[14],P0[15],P1[0],P1[1],   pw1[2]=PKW(P0,12),pw1[3]=PKW(P0,14), pw1); \
    VRD(2); SBAR(); GAPA(C0=__builtin_amdgcn_mfma_f32_32x32x16_bf16(kf[4],qr[2],C0,0,0,0),   P1[2],P1[3],P1[4],P1[5],     pw2[0]=PKW(P1,0), pw2[1]=PKW(P1,2), pw2); \
    VRD(6); SBAR(); GAPA(C1=__builtin_amdgcn_mfma_f32_32x32x16_bf16(kf[5],qr[2],C1,0,0,0),   P1[6],P1[7],P1[8],P1[9],     pw2[2]=PKW(P1,4), pw2[3]=PKW(P1,6), pw2); \
    VRD(3); SBAR(); GAPA(C0=__builtin_amdgcn_mfma_f32_32x32x16_bf16(kf[6],qr[3],C0,0,0,0),   P1[10],P1[11],P1[12],P1[13], pw3[0]=PKW(P1,8), pw3[1]=PKW(P1,10), pw3); \
    VRD(7); SBAR(); GAPA(C1=__builtin_amdgcn_mfma_f32_32x32x16_bf16(kf[7],qr[3],C1,0,0,0),   P1[14],P1[15],0.f,0.f,       pw3[2]=PKW(P1,12),pw3[3]=PKW(P1,14), pw3); \
    l_reg+=sacc; \
    if(GK){DMA_K((t)+3,sl_cur);} if(GV){DMA_V((t)+1,sl_next);} \
    CMASK(C0,C1,t); \
    SBAR(); \
    GAPB(o[0]=__builtin_amdgcn_mfma_f32_32x32x16_bf16(PAF(0),VFR(0),o[0],0,0,0), C0,0); \
    GAPB(o[1]=__builtin_amdgcn_mfma_f32_32x32x16_bf16(PAF(0),VFR(4),o[1],0,0,0), C0,4); \
    KRD(GL,0); GAPB(o[0]=__builtin_amdgcn_mfma_f32_32x32x16_bf16(PAF(1),VFR(1),o[0],0,0,0), C0,8); \
    KRD(GL,1); GAPB(o[1]=__builtin_amdgcn_mfma_f32_32x32x16_bf16(PAF(1),VFR(5),o[1],0,0,0), C0,12); \
    KRD(GL,2); GAPB(o[0]=__builtin_amdgcn_mfma_f32_32x32x16_bf16(PAF(2),VFR(2),o[0],0,0,0), C1,0); \
    KRD(GL,3); GAPB(o[1]=__builtin_amdgcn_mfma_f32_32x32x16_bf16(PAF(2),VFR(6),o[1],0,0,0), C1,4); \
    GAPB(o[0]=__builtin_amdgcn_mfma_f32_32x32x16_bf16(PAF(3),VFR(3),o[0],0,0,0), C1,8); \
    GAPB(o[1]=__builtin_amdgcn_mfma_f32_32x32x16_bf16(PAF(3),VFR(7),o[1],0,0,0), C1,12); \
    }while(0)
  int t=1;
  #undef CMASK
  #define CMASK(P0,P1,t) do{}while(0)
  for(;t+5<NT;t+=2){
    STEP(pB0,pB1,pA0,pA1,t,true,true,true);     WAIT_BAR(2); ROT();
    STEP(pA0,pA1,pB0,pB1,t+1,true,true,true);   WAIT_BAR(2); ROT();
  }
  #undef CMASK
  #define CMASK(P0,P1,t) do{int jb_=(t)-(NT-4); if(jb_>=0)cmask(P0,P1,jb_,qrel,hi);}while(0)
  #define ENDW(tt) do{ if((tt)+3<NT){WAIT_BAR(2);} else if((tt)+2<NT){WAIT_BAR(1);} else {WAIT_BAR(0);} }while(0)
  for(;t+1<NT;t+=2){
    STEP(pB0,pB1,pA0,pA1,t,(t+3<NT),(t+1<NT),(t+1<NT));       ENDW(t);   ROT();
    STEP(pA0,pA1,pB0,pB1,t+1,(t+4<NT),(t+2<NT),(t+2<NT));     ENDW(t+1); ROT();
  }
  STEP(pB0,pB1,pA0,pA1,NT-1,false,false,false);
  u32x4 sgv[4]; { const bf16*SGw=SG+(rowbase+q0+wid*QBLK)*DM+h*D;
    #pragma unroll
    for(int i=0;i<4;++i) sgv[i]=*(const u32x4*)(SGw+(long)(i*8+(lane>>3))*DM+(lane&7)*8); }
  SBAR();
  { float sacc=pB0[0]+pB0[1]; _Pragma("unroll") for(int r=2;r<16;++r)sacc+=pB0[r]; _Pragma("unroll") for(int r=0;r<16;++r)sacc+=pB1[r]; l_reg+=sacc;
    pw0=(u32x4){PKW(pB0,0),PKW(pB0,2),PKW(pB0,4),PKW(pB0,6)};pw1=(u32x4){PKW(pB0,8),PKW(pB0,10),PKW(pB0,12),PKW(pB0,14)};pw2=(u32x4){PKW(pB1,0),PKW(pB1,2),PKW(pB1,4),PKW(pB1,6)};pw3=(u32x4){PKW(pB1,8),PKW(pB1,10),PKW(pB1,12),PKW(pB1,14)};
    SBAR(); pv(o,vb0+sl_cur,PAF(0),PAF(1),PAF(2),PAF(3)); }
  asm volatile("s_waitcnt lgkmcnt(0)\n\ts_barrier":::"memory");
  if(nxt){DMA_K(0,0);DMA_V(0,0);DMA_K(1,SLOTB);DMA_K(2,2*SLOTB);}
  #undef PKW
  #undef PAF
  #undef VFR
  #undef PIN
  #undef MX3
  #undef GAPA
  #undef GAPB
  #undef EX
  #undef VRD
  #undef KRD
  #undef STEP
  #undef ENDW
  {auto rr=__builtin_amdgcn_permlane32_swap(__float_as_uint(l_reg),__float_as_uint(l_reg),false,false);l_reg=__uint_as_float(rr[0])+__uint_as_float(rr[1]);}
  if(hi==0)wsf[32+r32]=l_reg;asm volatile("s_waitcnt lgkmcnt(0)":::"memory");
  float rli[16];
  #pragma unroll
  for(int r=0;r<16;++r)rli[r]=__builtin_amdgcn_rcpf(wsf[32+crow(r,hi)]);
  bf16*Ow=O+(rowbase+q0+wid*QBLK)*DM+h*D;
  { bf16*stg=(bf16*)(shm+LDS_OST)+wid*2048;
    #pragma unroll
    for(int r=0;r<16;++r){const int orow=crow(r,hi);
      #pragma unroll
      for(int d0=0;d0<2;++d0)stg[orow*64+d0*32+r32]=__float2bfloat16(o[d0][r]*rli[r]);}
    asm volatile("s_waitcnt lgkmcnt(0)":::"memory");
    #pragma unroll
    for(int i=0;i<4;++i){const int row=i*8+(lane>>3),ch=lane&7; u32x4 v=*(const u32x4*)(stg+row*64+ch*8); const u32x4 g=sgv[i];
      #pragma unroll
      for(int e=0;e<4;++e){ const float lo=__uint_as_float(v[e]<<16)*__uint_as_float(g[e]<<16), hh=__uint_as_float(v[e]&0xffff0000u)*__uint_as_float(g[e]&0xffff0000u); v[e]=cvtpk_s(lo,hh); }
      ATTN_STORE16(Ow+(long)row*DM+ch*8,v);} }
  asm volatile("s_waitcnt lgkmcnt(0)":::"memory");
  #undef DMA_K
  #undef DMA_V
  #undef CMASK
  #undef ROT
}
constexpr int ATTN_LDS_BYTES=LDS_BYTES;
struct AttnTensors { const bf16* Q; const bf16* K; const bf16* V; const bf16* SG; bf16* O; const float* cumloc; const float* ctot; const float* qg; const float* kg; };
struct AttnUnit { int bh; int qb; };
struct StaticOrder {
  int vcu, G;
  __device__ __forceinline__ explicit StaticOrder(int grid,int block):vcu((grid%8==0)?(block%8)*(grid/8)+block/8:block),G(grid){}
  __device__ __forceinline__ bool next(int i,AttnUnit&u)const{
    if(G==256){ if(i>=4)return false; const int s=vcu&1; u.bh=vcu>>1; u.qb=(i==0)?s:(i==1)?7-s:(i==2)?3-s:4+s; return true; }
    const int id=vcu+i*G; if(id>=BATCH*NHEAD*NQB)return false; u.bh=id/NQB; u.qb=id%NQB; return true; }
  __device__ __forceinline__ void a_ready(const AttnUnit&)const{}
  __device__ __forceinline__ void done(const AttnUnit&)const{}
};
template<class Sched,int THRL=8> __device__ __forceinline__ void attn_phase(char*lds,const AttnTensors&T,const Sched&S,const int tid){
  AttnUnit u,un; int cur_bh=-1; bool pre=false; bool has=S.next(0,u);
  float bref; { float gq=fabsf(T.qg[tid&63]),gk=fabsf(T.kg[tid&63]);
    #pragma unroll
    for(int o=1;o<64;o<<=1){ gq=fmaxf(gq,__shfl_xor(gq,o)); gk=fmaxf(gk,__shfl_xor(gk,o)); }
    bref=8.0f*1.4426950408889634f*gq*gk+1.0f; }
  for(int i=0;has;++i){ S.a_ready(u); const bool hasn=S.next(i+1,un); const bool nxt=hasn&&un.bh==u.bh;
    if(u.bh!=cur_bh){ cur_bh=u.bh;
      int tq=tid; asm volatile("":"+v"(tq));
      const int b_=u.bh/NHEAD,h_=u.bh%NHEAD,l_=tq&31,c_=tq>>4;
      float v=T.ctot[(size_t)(b_*(SEQ/64)+l_)*16+h_];
      #pragma unroll
      for(int o=1;o<32;o<<=1){ const float nn=__shfl_up(v,o,32); if(l_>=o)v+=nn; }
      const float pre=__shfl(v,(c_+31)&31,32); const float base=(c_==0)?0.f:pre;
      const f32x4_t cl=*(const f32x4_t*)(T.cumloc+((size_t)u.bh)*SEQ+4*tq);
      { u32x4 w0,w1; unsigned h_,m_,l_;
        split3(-(cl[0]+base),h_,m_,l_); w0[0]=h_|(m_<<16); w0[1]=l_|0xBF800000u; split3(-(cl[1]+base),h_,m_,l_); w0[2]=h_|(m_<<16); w0[3]=l_|0xBF800000u;
        split3(-(cl[2]+base),h_,m_,l_); w1[0]=h_|(m_<<16); w1[1]=l_|0xBF800000u; split3(-(cl[3]+base),h_,m_,l_); w1[2]=h_|(m_<<16); w1[3]=l_|0xBF800000u;
        *(u32x4*)(lds+LDS_CK+32*tq)=w0; *(u32x4*)(lds+LDS_CK+32*tq+16)=w1; }
      asm volatile("s_waitcnt vmcnt(0) lgkmcnt(0)\n\ts_barrier":::"memory"); }
    attn_unit<THRL>(u.bh/NHEAD,u.bh%NHEAD,u.qb,T.Q,T.K,T.V,T.SG,T.O,lds,tid,pre,nxt,bref); S.done(u); pre=nxt; u=un; has=hasn; }
}
#undef SBAR
#undef WAIT_BAR
}
#define LAS __attribute__((address_space(3)))
typedef unsigned short bf16_t;
typedef short bf16x8_t __attribute__((ext_vector_type(8)));
typedef float f32x4 __attribute__((ext_vector_type(4)));
typedef float f32x2 __attribute__((ext_vector_type(2)));
typedef unsigned u32x4 __attribute__((ext_vector_type(4)));
constexpr int NWAVES = 8;
constexpr int RING_BYTES = 131072, LDS_BYTES = 147456, MISC_OFF = LDS_BYTES - 256;
static_assert(attn_body::LDS_BYTES <= RING_BYTES, "attention scratch must fit the ring region");
constexpr size_t MiB = 1u << 20;
constexpr size_t WS_P = 1 * MiB, WS_CUMLOC = 2 * MiB, WS_CTOT = 3 * MiB, WS_SSM = 4 * MiB, WS_W = 16 * MiB, WS_HB = 52 * MiB;
constexpr size_t WS_B1 = 84 * MiB, WS_B2 = 116 * MiB, WS_B3 = 148 * MiB, WS_B4 = 180 * MiB, WS_Y = 212 * MiB, WS_END = 244 * MiB;
constexpr int W_C0IN = 0, W_C0OUT = 3072, W_FIN = 4096, W_FF = 8192, W_FOUT = 8448, W_SIN = 9472, W_SGLU = 11520, W_SOUT = 12544, W_C1IN = 13568, W_C1OUT = 16640, W_ROWS = 17664;
static_assert(WS_W + (size_t)W_ROWS * 2048 <= WS_HB, "weights fit");

__device__ __forceinline__ unsigned f2bf_(float f) { unsigned u = __builtin_bit_cast(unsigned, f); return (u + 0x7fffu + ((u >> 16) & 1u)) >> 16; }
__device__ __forceinline__ unsigned pk2(float lo, float hi) { return f2bf_(lo) | (f2bf_(hi) << 16); }
__device__ __forceinline__ float wave_sum(float v) {
#pragma unroll
    for (int o = 1; o < 64; o <<= 1) v += __shfl_xor(v, o);
    return v;
}
#define GAS __attribute__((address_space(1)))
#define RLX_AGENT __ATOMIC_RELAXED, __HIP_MEMORY_SCOPE_AGENT
#define LDS_WAIT() asm volatile("s_waitcnt lgkmcnt(0)" ::: "memory")
#define VM_WAIT() asm volatile("s_waitcnt vmcnt(0)" ::: "memory")
#define XB_TMO      128
#define XB_XCNT(j)  (256  + 64 * (j))
#define XB_XSUB(j)  (1280 + 64 * (j))
#define XB_XGEN(j)  (2304 + 64 * (j))
#define XB_TOP      3328
#define XB_TOPGEN   3392
#define XCD_BAR_WORDS 3456
#define XB_SPIN_CAP (1u << 18)

__device__ __forceinline__ unsigned xb_ld(unsigned* p)              { return __hip_atomic_load(p, __ATOMIC_RELAXED, __HIP_MEMORY_SCOPE_AGENT); }
__device__ __forceinline__ unsigned xb_add(unsigned* p, unsigned v) { return __hip_atomic_fetch_add(p, v, __ATOMIC_RELAXED, __HIP_MEMORY_SCOPE_AGENT); }
__device__ __forceinline__ unsigned xb_xcc_id() { return (unsigned)__builtin_amdgcn_s_getreg((3 << 11) | 20) & 0xFu; }
#define XB_SPIN(cond, bar) do { unsigned _sp = 0; while (cond) { __builtin_amdgcn_s_sleep(1); \
    if ((++_sp & 255u) == 0u) { if (xb_ld(&(bar)[XB_TMO])) break; if (_sp > XB_SPIN_CAP) { atomicAdd(&(bar)[XB_TMO], 1u); break; } } } } while (0)

struct XcdBarrier {
    unsigned* bar; unsigned x;
    volatile LAS unsigned* st;
};

__device__ __forceinline__ XcdBarrier xcd_barrier_post(unsigned* bar, volatile LAS unsigned* st, const int tid) {
    XcdBarrier b; b.bar = bar; b.x = xb_xcc_id(); b.st = st;
    if (tid == 0) (void)xb_add(&bar[XB_XCNT(b.x)], 1u);
    return b;
}
__device__ __forceinline__ void xcd_barrier_complete(unsigned* bar, unsigned x, unsigned& nloc, unsigned& nx) {
    const unsigned G = gridDim.x * gridDim.y * gridDim.z;
    unsigned sum, cnt, mine, sp = 0u;
    for (;;) {
        sum = 0u; cnt = 0u; mine = 0u;
#pragma unroll
        for (unsigned j = 0; j < 16; ++j) { const unsigned c = xb_ld(&bar[XB_XCNT(j)]); sum += c; cnt += (c > 0u) ? 1u : 0u; mine = (j == x) ? c : mine; }
        if (sum == G) break;
        __builtin_amdgcn_s_sleep(1);
        if ((++sp & 255u) == 0u) { if (xb_ld(&bar[XB_TMO])) break; if (sp > XB_SPIN_CAP) { atomicAdd(&bar[XB_TMO], 1u); break; } }
    }
    nloc = mine > 0u ? mine : 1u; nx = cnt > 0u ? cnt : 1u;
}

__device__ __forceinline__ void xcd_barrier(const XcdBarrier& b, const int tid) {
    asm volatile("s_waitcnt vmcnt(0)" ::: "memory");
    __syncthreads();
    if (tid == 0) {
        unsigned* bar = b.bar;
        __builtin_amdgcn_s_waitcnt(0);
        unsigned nloc = b.st[0], nx = b.st[1];
        if (nloc == 0u) { xcd_barrier_complete(bar, b.x, nloc, nx); b.st[0] = nloc; b.st[1] = nx; }
        const unsigned old = xb_add(&bar[XB_XSUB(b.x)], 1u);
        const unsigned gen = old / nloc;
        if (old + 1u == (gen + 1u) * nloc) {
            __builtin_amdgcn_fence(__ATOMIC_RELEASE, "agent");
            asm volatile("s_waitcnt vmcnt(0)" ::: "memory");
            const unsigned og = xb_add(&bar[XB_TOP], 1u);
            const unsigned tg = og / nx;
            if (og + 1u == (tg + 1u) * nx) xb_add(&bar[XB_TOPGEN], 1u);
            else XB_SPIN(xb_ld(&bar[XB_TOPGEN]) == tg, bar);
            __builtin_amdgcn_fence(__ATOMIC_ACQUIRE, "agent");
            xb_add(&bar[XB_XGEN(b.x)], 1u);
            asm volatile("s_waitcnt vmcnt(0)" ::: "memory");
        } else {
            XB_SPIN(xb_ld(&bar[XB_XGEN(b.x)]) == gen, bar);
            __builtin_amdgcn_fence(__ATOMIC_ACQUIRE, "agent");
            asm volatile("s_waitcnt vmcnt(0)" ::: "memory");
        }
    }
    __syncthreads();
}

__device__ __forceinline__ int lane_id_fresh() { int r; asm volatile("v_mbcnt_lo_u32_b32 %0, -1, 0\n\tv_mbcnt_hi_u32_b32 %0, -1, %0" : "=v"(r)); return r; }
struct Args { const float* in[25]; float* out; unsigned char* ws; int ph_lo, ph_hi; };

__device__ __forceinline__ int dst_row32(int s, int mode) {
    if (mode == 1) { if (s < 1024) return 256 * (s >> 7) + (s & 127); if (s < 2048) { const int t = s - 1024; return 256 * (t >> 7) + 128 + (t & 127); } return s; }
    if (mode == 2) { const int sec = s >> 10, hd = (s & 1023) >> 6, bj = (s & 63) >> 5, e = s & 31; return 1024 * sec + 256 * (hd >> 2) + 128 * bj + 32 * (hd & 3) + e; }
    return s;
}
__device__ __forceinline__ void p0_transpose_item(const float* W, int ldw, int N, const float* gain, bf16_t* WT, int mode, int item, int lane) {
    const int nblk = N / 64, kb = item / nblk, nb = item % nblk, k0 = 64 * kb, n0 = 64 * nb, q = lane >> 4, nn = lane & 15;
    f32x4 v[16]; f32x4 gk[4];
    const float* src = W + (size_t)(k0 + 16 * q) * ldw + n0 + 4 * nn;
#pragma unroll
    for (int i = 0; i < 16; ++i) v[i] = __builtin_nontemporal_load((const f32x4*)(src + (size_t)i * ldw));
#pragma unroll
    for (int i = 0; i < 4; ++i) gk[i] = (f32x4){1.f, 1.f, 1.f, 1.f};
    if (gain) {
#pragma unroll
        for (int i = 0; i < 4; ++i) gk[i] = *(const f32x4*)(gain + k0 + 16 * q + 4 * i);
    }
#pragma unroll
    for (int i = 0; i < 16; ++i) v[i] = v[i] * gk[i >> 2][i & 3];
#pragma unroll
    for (int e = 0; e < 4; ++e) { const int n = 4 * nn + e, r = dst_row32(n0 + (n & 32), mode) + (n & 31); bf16_t* d = WT + (size_t)r * 1024 + k0 + 16 * q;
#pragma unroll
        for (int h = 0; h < 2; ++h) { u32x4 o; o.x = pk2(v[8 * h][e], v[8 * h + 1][e]); o.y = pk2(v[8 * h + 2][e], v[8 * h + 3][e]); o.z = pk2(v[8 * h + 4][e], v[8 * h + 5][e]); o.w = pk2(v[8 * h + 6][e], v[8 * h + 7][e]);
            *(u32x4*)(d + 8 * h) = o; } }
}
__device__ __forceinline__ void p0_prologue(const Args& a, LAS unsigned char* lds, int vcu, int G, const int tid) {
    const int lane = tid & 63, wave = __builtin_amdgcn_readfirstlane(tid >> 6);
    const int gw = vcu * NWAVES + wave, NGW = G * NWAVES;
    bf16_t* WB = (bf16_t*)(a.ws + WS_W);
    const float* ng = a.in[1];
    constexpr int I3072 = 16 * 3072 / 64, I1024 = 16 * 1024 / 64, I4096 = 16 * 4096 / 64, I2048 = 16 * 2048 / 64;
    constexpr int NITEMS = 2 * I3072 + 5 * I1024 + I4096 + I2048;
    for (int it = gw; it < NITEMS; it += NGW) {
        int r = it;
        if (r < I3072) { p0_transpose_item(a.in[2], 3072, 3072, ng, WB + (size_t)W_C0IN * 1024, 1, r, lane); continue; } r -= I3072;
        if (r < I1024) { p0_transpose_item(a.in[7], 1024, 1024, nullptr, WB + (size_t)W_C0OUT * 1024, 0, r, lane); continue; } r -= I1024;
        if (r < I4096) { p0_transpose_item(a.in[8], 4112, 4096, ng + 1024, WB + (size_t)W_FIN * 1024, 2, r, lane); continue; } r -= I4096;
        if (r < I1024) { p0_transpose_item(a.in[12], 1024, 1024, nullptr, WB + (size_t)W_FOUT * 1024, 0, r, lane); continue; } r -= I1024;
        if (r < I2048) { p0_transpose_item(a.in[13], 2048, 2048, ng + 2048, WB + (size_t)W_SIN * 1024, 0, r, lane); continue; } r -= I2048;
        if (r < I1024) { p0_transpose_item(a.in[22], 1024, 1024, nullptr, WB + (size_t)W_SGLU * 1024, 0, r, lane); continue; } r -= I1024;
        if (r < I1024) { p0_transpose_item(a.in[24], 1024, 1024, nullptr, WB + (size_t)W_SOUT * 1024, 0, r, lane); continue; } r -= I1024;
        if (r < I3072) { p0_transpose_item(a.in[2] + (size_t)1024 * 3072, 3072, 3072, ng + 3072, WB + (size_t)W_C1IN * 1024, 1, r, lane); continue; } r -= I3072;
        p0_transpose_item(a.in[7] + (size_t)1024 * 1024, 1024, 1024, nullptr, WB + (size_t)W_C1OUT * 1024, 0, r, lane);
    }
    for (int e = vcu * 512 + tid; e < 16 * 1024; e += G * 512) { const int n = e >> 10, k = e & 1023; WB[(size_t)(W_FF + n) * 1024 + k] = (bf16_t)f2bf_(a.in[8][(size_t)k * 4112 + 4096 + n] * ng[1024 + k]); }
    bf16_t* hb = (bf16_t*)(a.ws + WS_HB); float* P = (float*)(a.ws + WS_P);
    for (int m0 = 4 * gw; m0 < MTOK; m0 += 4 * NGW) {
        f32x4 v[4][4];
#pragma unroll
        for (int r = 0; r < 4; ++r)
#pragma unroll
            for (int j = 0; j < 4; ++j) v[r][j] = __builtin_nontemporal_load(((const f32x4*)(a.in[0] + (size_t)(m0 + r) * 1024)) + lane + 64 * j);
#pragma unroll
        for (int r = 0; r < 4; ++r) { float s = 0.f; unsigned long long* o8 = (unsigned long long*)(hb + (size_t)(m0 + r) * 1024) + lane;
#pragma unroll
            for (int j = 0; j < 4; ++j) { const f32x4 x = v[r][j]; s += (x[0] * x[0] + x[1] * x[1]) + (x[2] * x[2] + x[3] * x[3]);
                o8[64 * j] = (unsigned long long)pk2(x[0], x[1]) | ((unsigned long long)pk2(x[2], x[3]) << 32); }
            s = wave_sum(s);
            if (lane < 4) ((f32x4*)(P + (size_t)(m0 + r) * 16))[lane] = (f32x4){lane == 0 ? s : 0.f, 0.f, 0.f, 0.f}; }
    }
}
__device__ __forceinline__ void conv_phase(LAS unsigned char* lds, const bf16_t* U, const bf16_t* SG, const float* cw, const float* cb, const float* lg, const float* lb, bf16_t* Y, int vcu, int G, const int tid) {
    const int lane = tid & 63, wave = __builtin_amdgcn_readfirstlane(tid >> 6);
    f32x2 w[CONV_K];
#pragma unroll
    for (int j = 0; j < CONV_K; ++j) w[j] = *(const f32x2*)(cw + (size_t)j * 1024 + 2 * tid);
    const f32x2 bias = *(const f32x2*)(cb + 2 * tid);
    LAS float* tile = (LAS float*)lds;
    for (int unit = vcu; unit < MTOK / 32; unit += G) {
        const int t0 = unit * 32, seq0 = t0 & ~(SEQ - 1);

        f32x2 out[32];
#pragma unroll
        for (int tt = 0; tt < 32; ++tt) out[tt] = bias;
#pragma unroll
        for (int i = 0; i < 62; ++i) {
            const int row = t0 - 30 + i, rowc = row < seq0 ? seq0 : row;
            const unsigned raw = *(const unsigned*)(U + (size_t)rowc * 1024 + 2 * tid);
            f32x2 uv; uv.x = __uint_as_float(raw << 16); uv.y = __uint_as_float(raw & 0xffff0000u);
            if (row < seq0) uv = (f32x2){0.f, 0.f};
#pragma unroll
            for (int tt = (i > 30 ? i - 30 : 0); tt <= (i < 31 ? i : 31); ++tt) out[tt] += w[i - tt] * uv;
        }
#pragma unroll
        for (int tt = 0; tt < 32; ++tt) *(LAS f32x2*)(tile + tt * 1024 + 2 * tid) = out[tt];
        __syncthreads();
        {
            u32x4 sgv[4][2]; f32x4 gg[4], bbv[4];
#pragma unroll
            for (int q = 0; q < 4; ++q)
#pragma unroll
                for (int hf = 0; hf < 2; ++hf) sgv[q][hf] = __builtin_nontemporal_load((const u32x4*)(SG + (size_t)(t0 + wave * 4 + q) * 1024 + 8 * lane + 512 * hf));
#pragma unroll
            for (int hf = 0; hf < 2; ++hf) { gg[2 * hf] = *(const f32x4*)(lg + 8 * lane + 512 * hf); gg[2 * hf + 1] = *(const f32x4*)(lg + 8 * lane + 512 * hf + 4);
                bbv[2 * hf] = *(const f32x4*)(lb + 8 * lane + 512 * hf); bbv[2 * hf + 1] = *(const f32x4*)(lb + 8 * lane + 512 * hf + 4); }
            f32x4 v[4][4]; float s1[4], s2[4];
#pragma unroll
            for (int q = 0; q < 4; ++q) { const LAS float* tr = tile + (wave * 4 + q) * 1024 + 8 * lane;
                v[q][0] = *(const LAS f32x4*)(tr); v[q][1] = *(const LAS f32x4*)(tr + 4); v[q][2] = *(const LAS f32x4*)(tr + 512); v[q][3] = *(const LAS f32x4*)(tr + 516);
                s1[q] = 0.f; s2[q] = 0.f;
#pragma unroll
                for (int j = 0; j < 4; ++j) { s1[q] += (v[q][j][0] + v[q][j][1]) + (v[q][j][2] + v[q][j][3]); s2[q] += (v[q][j][0] * v[q][j][0] + v[q][j][1] * v[q][j][1]) + (v[q][j][2] * v[q][j][2] + v[q][j][3] * v[q][j][3]); } }
#pragma unroll
            for (int o = 1; o < 64; o <<= 1)
#pragma unroll
                for (int q = 0; q < 4; ++q) { s1[q] += __shfl_xor(s1[q], o); s2[q] += __shfl_xor(s2[q], o); }
#pragma unroll
            for (int q = 0; q < 4; ++q) {
                const float mu = s1[q] * (1.0f / 1024.0f), var = fmaxf(s2[q] * (1.0f / 1024.0f) - mu * mu, 0.f), rstd = rsqrtf(var + LN_EPS);
                const size_t off = (size_t)(t0 + wave * 4 + q) * 1024 + 8 * lane;
#pragma unroll
                for (int hf = 0; hf < 2; ++hf) { const u32x4 sg = sgv[q][hf];
                    const f32x4 y0 = (v[q][2 * hf] - mu) * rstd * gg[2 * hf] + bbv[2 * hf], y1 = (v[q][2 * hf + 1] - mu) * rstd * gg[2 * hf + 1] + bbv[2 * hf + 1]; u32x4 o;
                    o.x = pg8::cvt_pk_bf16(pg8::silu(y0[0]) * pg8::bflo(sg.x), pg8::silu(y0[1]) * pg8::bfhi(sg.x));
                    o.y = pg8::cvt_pk_bf16(pg8::silu(y0[2]) * pg8::bflo(sg.y), pg8::silu(y0[3]) * pg8::bfhi(sg.y));
                    o.z = pg8::cvt_pk_bf16(pg8::silu(y1[0]) * pg8::bflo(sg.z), pg8::silu(y1[1]) * pg8::bfhi(sg.z));
                    o.w = pg8::cvt_pk_bf16(pg8::silu(y1[2]) * pg8::bflo(sg.w), pg8::silu(y1[3]) * pg8::bfhi(sg.w));
                    *(u32x4*)(Y + off + 512 * hf) = o; }
            }
        }
        __syncthreads();
    }
}
__device__ __forceinline__ void fcum_phase(LAS unsigned char* lds, const bf16_t* hb, const bf16_t* Wf, const float* P, const float* fbias, float* cumloc, float* ctot, int vcu, int G, const int tid) {
    const int lane = tid & 63, wave = __builtin_amdgcn_readfirstlane(tid >> 6);
    LAS float* part = (LAS float*)lds;
    LAS float* lf = part + 2 * 64 * 17;
    for (int ch = vcu; ch < MTOK / 64; ch += G) {
        f32x4 pq[2][4];
#pragma unroll
        for (int e = 0; e < 2; ++e) { const f32x4* pp = (const f32x4*)(P + (size_t)(ch * 64 + ((tid + 512 * e) >> 4)) * 16); pq[e][0] = pp[0]; pq[e][1] = pp[1]; pq[e][2] = pp[2]; pq[e][3] = pp[3]; }
        {
            const int tg = wave & 3, kh = wave >> 2, tok0 = ch * 64 + tg * 16;
            const bf16_t* ap = hb + (size_t)(tok0 + (lane & 15)) * 1024 + kh * 512 + 8 * (lane >> 4);
            const bf16_t* bp = Wf + (size_t)(lane & 15) * 1024 + kh * 512 + 8 * (lane >> 4);
            bf16x8_t av[16], bv[16];
#pragma unroll
            for (int ks = 0; ks < 16; ++ks) { av[ks] = *(const bf16x8_t*)(ap + ks * 32); bv[ks] = *(const bf16x8_t*)(bp + ks * 32); }
            f32x4 acc = (f32x4){0.f, 0.f, 0.f, 0.f};
#pragma unroll
            for (int ks = 0; ks < 16; ++ks) acc = __builtin_amdgcn_mfma_f32_16x16x32_bf16(av[ks], bv[ks], acc, 0, 0, 0);
#pragma unroll
            for (int r = 0; r < 4; ++r) part[(kh * 64 + tg * 16 + 4 * (lane >> 4) + r) * 17 + (lane & 15)] = acc[r];
        }
        __syncthreads();
#pragma unroll
        for (int e = 0; e < 2; ++e) {
            const int idx = tid + 512 * e, tl = idx >> 4, h = idx & 15;
            const f32x4 p0 = pq[e][0], p1 = pq[e][1], p2 = pq[e][2], p3 = pq[e][3];
            const float ss = ((p0[0] + p0[1]) + (p0[2] + p0[3])) + ((p1[0] + p1[1]) + (p1[2] + p1[3])) + ((p2[0] + p2[1]) + (p2[2] + p2[3])) + ((p3[0] + p3[1]) + (p3[2] + p3[3]));
            const float x = (part[tl * 17 + h] + part[(64 + tl) * 17 + h]) * rsqrtf(ss * (1.0f / 1024.0f) + RMS_EPS) + fbias[h];
            lf[tl * 17 + h] = (fminf(x, 0.f) - log1pf(__expf(-fabsf(x)))) * LOG2E; }
        __syncthreads();
#pragma unroll
        for (int e = 0; e < 2; ++e) {
            const int h = 2 * wave + e; float c = lf[lane * 17 + h];
#pragma unroll
            for (int o = 1; o < 64; o <<= 1) { const float nn = __shfl_up(c, o); if (lane >= o) c += nn; }
            const int b = ch / (SEQ / 64), cc = ch % (SEQ / 64);
            cumloc[((size_t)(b * NHEADS + h)) * SEQ + cc * 64 + lane] = c;
            if (lane == 63) ctot[(size_t)ch * 16 + h] = c; }
        __syncthreads();
    }
}
constexpr int SSM_OFF_BM = 0, SSM_OFF_PW = 65536, SSM_OFF_KT = SSM_OFF_PW + 2560, SSM_OFF_CM = SSM_OFF_KT + 8704, SSM_GS = SSM_OFF_CM + 65536;
constexpr size_t WS_SSM_PN = 13 * MiB;
static_assert(WS_SSM + (size_t)NGRP * SSM_GS <= WS_SSM_PN && SSM_GS <= MISC_OFF, "ssm tables");

__device__ __forceinline__ f32x4 cmul2(const f32x4 a, const f32x4 x) { return (f32x4){a[0] * x[0] - a[1] * x[1], a[0] * x[1] + a[1] * x[0], a[2] * x[2] - a[3] * x[3], a[2] * x[3] + a[3] * x[2]}; }
template <int CTRL> __device__ __forceinline__ float dpp_f(float v) { return __builtin_bit_cast(float, __builtin_amdgcn_update_dpp(0, __builtin_bit_cast(int, v), CTRL, 0xf, 0xf, true)); }
template <int CTRL> __device__ __forceinline__ f32x4 dpp4(const f32x4 v) { return (f32x4){dpp_f<CTRL>(v[0]), dpp_f<CTRL>(v[1]), dpp_f<CTRL>(v[2]), dpp_f<CTRL>(v[3])}; }

__device__ __forceinline__ void ssm_tables(const Args& a, LAS unsigned char* lds, int vcu, int G, const int tid) {
    const float* log_dt = a.in[14]; const float* a_re = a.in[15]; const float* a_im = a.in[16]; const float* b_re = a.in[17]; const float* b_im = a.in[18];
    const float* c_re = a.in[19]; const float* c_im = a.in[20];
    LAS float* pw = (LAS float*)lds;
    LAS float* bb = pw + 17 * 64 * 2;
    LAS float* big = bb + 64 * 16 * 2;
    LAS float* cc = big + 21 * 64 * 2;
    for (int unit = vcu; unit < 4 * NGRP; unit += G) {
        const int g = unit >> 2, sub = unit & 3;
        __syncthreads();
        const double dt = exp((double)log_dt[g]);
        for (int job = tid; job < 38 * 64; job += 512) { const int li = job >> 6, p = job & 63;
            const int l = li < 17 ? li : (li < 22 ? (16 << (li - 17)) : 16 * (li - 22));
            const double are = a_re[g * 64 + p], aim = a_im[g * 64 + p];
            double ang = aim * dt * (double)l; ang -= 6.283185307179586 * rint(ang * 0.15915494309189535);
            const float mag = expf((float)(are * dt * (double)l)); float sn, cs; sincosf((float)ang, &sn, &cs);
            LAS float* d = li < 17 ? pw + (li * 64 + p) * 2 : big + ((li - 17) * 64 + p) * 2; d[0] = mag * cs; d[1] = mag * sn; }
        for (int job = tid; job < 1024; job += 512) { cc[job * 2] = c_re[(size_t)g * 1024 + job]; cc[job * 2 + 1] = c_im[(size_t)g * 1024 + job]; }
        for (int job = tid; job < 1024; job += 512) { const int p = job >> 4, c = job & 15;
            const float are = a_re[g * 64 + p], aim = a_im[g * 64 + p], x = are * (float)dt;
            double ang = (double)aim * dt; ang -= 6.283185307179586 * rint(ang * 0.15915494309189535);
            float sn, cs, sh, ch; sincosf((float)ang, &sn, &cs); sincosf(0.5f * (float)ang, &sh, &ch);
            const float em1 = expm1f(x), nr = em1 * cs - 2.0f * sh * sh, ni = (em1 + 1.0f) * sn, den = are * are + aim * aim;
            const float zr = (nr * are + ni * aim) / den, zi = (ni * are - nr * aim) / den;
            const float br = b_re[(size_t)(g * 64 + p) * 16 + c], bi = b_im[(size_t)(g * 64 + p) * 16 + c];
            bb[(p * 16 + c) * 2] = zr * br - zi * bi; bb[(p * 16 + c) * 2 + 1] = zr * bi + zi * br; }
        __syncthreads();
        unsigned char* gb = a.ws + WS_SSM + (size_t)g * SSM_GS;
        for (int job = tid; job < 1024; job += 512) {
            const int fl = job >> 6, l = job & 63, rt = 2 * sub + (fl >> 3), s = fl & 7, R = 16 * rt + (l & 15), p = R >> 1, part = R & 1, j = 2 * s + (l >> 5), c0 = 8 * ((l >> 4) & 1);
            const float pr = pw[((15 - j) * 64 + p) * 2], pi = pw[((15 - j) * 64 + p) * 2 + 1]; float v[8];
#pragma unroll
            for (int e = 0; e < 8; ++e) { const float xr = bb[(p * 16 + c0 + e) * 2], xi = bb[(p * 16 + c0 + e) * 2 + 1]; v[e] = part ? (pr * xi + pi * xr) : (pr * xr - pi * xi); }
            *(u32x4*)(gb + SSM_OFF_BM + ((rt * 8 + s) * 64 + l) * 16) = (u32x4){pk2(v[0], v[1]), pk2(v[2], v[3]), pk2(v[4], v[5]), pk2(v[6], v[7])}; }
        for (int job = tid; job < 1024; job += 512) {
            const int fl = job >> 6, l = job & 63, i = 4 * sub + (fl >> 2), s = fl & 3, c = l & 15, q = l >> 4; float v[8];
#pragma unroll
            for (int e = 0; e < 8; ++e) { const int R = 16 * (2 * s + (e >> 2)) + 4 * q + (e & 3), p = R >> 1, part = R & 1;
                const float cr = cc[(c * 64 + p) * 2], ci = cc[(c * 64 + p) * 2 + 1], pr = pw[((i + 1) * 64 + p) * 2], pi = pw[((i + 1) * 64 + p) * 2 + 1];
                v[e] = part ? -(cr * pi + ci * pr) : (cr * pr - ci * pi); }
            *(u32x4*)(gb + SSM_OFF_CM + ((i * 4 + s) * 64 + l) * 16) = (u32x4){pk2(v[0], v[1]), pk2(v[2], v[3]), pk2(v[4], v[5]), pk2(v[6], v[7])}; }
        for (int idx = sub + 4 * tid; idx < 17 * 256; idx += 2048) {
            const int lagi = idx >> 8, c = (idx >> 4) & 15, c2 = idx & 15; float acc = 0.f;
            if (lagi > 0)
#pragma unroll 16
            for (int p = 0; p < 64; ++p) { const float cr = cc[(c * 64 + p) * 2], ci = cc[(c * 64 + p) * 2 + 1], pr = pw[((lagi - 1) * 64 + p) * 2], pi = pw[((lagi - 1) * 64 + p) * 2 + 1];
                const float tr = cr * pr - ci * pi, ti = cr * pi + ci * pr; acc += tr * bb[(p * 16 + c2) * 2] - ti * bb[(p * 16 + c2) * 2 + 1]; }
            *(bf16_t*)(gb + SSM_OFF_KT + idx * 2) = (bf16_t)f2bf_(acc); }
        if (sub == 0) for (int job = tid; job < 21 * 32; job += 512) {
            const int d = job >> 5, rt = (job >> 2) & 7, q = job & 3, p0 = 8 * rt + 2 * q;
            const f32x4 v = (f32x4){big[(d * 64 + p0) * 2], big[(d * 64 + p0) * 2 + 1], big[(d * 64 + p0 + 1) * 2], big[(d * 64 + p0 + 1) * 2 + 1]};
            if (d < 5) *(f32x4*)(gb + SSM_OFF_PW + ((d * 8 + rt) * 4 + q) * 16) = v;
            else *(f32x4*)(a.ws + WS_SSM_PN + ((((size_t)g * 8 + rt) * 16 + (d - 5)) * 4 + q) * 16) = v; }
    }
}
constexpr int SSM_OFF_EX = SSM_GS;
static_assert(SSM_OFF_EX + 8 * 128 * 4 <= MISC_OFF, "ssm exchange area");
__device__ __forceinline__ void ssm_phase(LAS unsigned char* lds, unsigned char* ws, const bf16_t* U, const float* dsk, bf16_t* GO, int vcu, int G, const int tid) {
    const int lane = tid & 63, wave = __builtin_amdgcn_readfirstlane(tid >> 6), n = lane & 15, q = lane >> 4;
    for (int unit = vcu; unit < 4 * NGRP; unit += G) {
        const int g = unit >> 2, sub = unit & 3;
        __syncthreads();
        { const unsigned char* gb = ws + WS_SSM + (size_t)g * SSM_GS;
          constexpr int NFULL = SSM_GS / 8192, TAIL = SSM_GS - NFULL * 8192; u32x4 tv[NFULL + 1];
#pragma unroll
          for (int it = 0; it < NFULL; ++it) tv[it] = ((const u32x4*)(gb + it * 8192))[tid];
          tv[NFULL] = ((const u32x4*)(gb + NFULL * 8192))[tid < TAIL / 16 ? tid : 0];
#pragma unroll
          for (int it = 0; it < NFULL; ++it) ((LAS u32x4*)(lds + it * 8192))[tid] = tv[it];
          if (tid < TAIL / 16) ((LAS u32x4*)(lds + NFULL * 8192))[tid] = tv[NFULL]; }
        __syncthreads();
        const int pair = sub * 8 + wave, b = pair >> 2, seg = pair & 3;
        const LAS f32x4* PW = (const LAS f32x4*)(lds + SSM_OFF_PW);
        const f32x4* PN = (const f32x4*)(ws + WS_SSM_PN) + (size_t)g * 8 * 16 * 4;
#define A16(rt) (PW[(4 * 8 + (rt)) * 4 + QQ])
#define QQ q
        const int tokb = b * SEQ + seg * 512;
        const bf16_t* Ub = U + (size_t)tokb * 1024 + g * 16; bf16_t* Gb = GO + (size_t)tokb * 1024 + g * 16;
        unsigned uoff = (unsigned)((16 * n + (lane >> 5)) * 1024 + 8 * ((lane >> 4) & 1)), eoff = (unsigned)(16 * n * 1024 + 4 * q);
        f32x4 I0[8], I1[8];
        {
            bf16x8_t uf[8];
#pragma unroll
            for (int s = 0; s < 8; ++s) uf[s] = *(const bf16x8_t*)((Ub + (2 * s) * 1024) + uoff);
            bf16x8_t fa[2][8];
#pragma unroll
            for (int s = 0; s < 8; ++s) fa[0][s] = *(const LAS bf16x8_t*)(lds + SSM_OFF_BM + ((0 * 8 + s) * 64 + lane) * 16);
#pragma unroll
            for (int rt = 0; rt < 8; ++rt) { I0[rt] = (f32x4){0.f, 0.f, 0.f, 0.f};
                if (rt < 7) {
#pragma unroll
                    for (int s = 0; s < 8; ++s) fa[(rt + 1) & 1][s] = *(const LAS bf16x8_t*)(lds + SSM_OFF_BM + (((rt + 1) * 8 + s) * 64 + lane) * 16);
                }
                __builtin_amdgcn_sched_barrier(0);
#pragma unroll
                for (int s = 0; s < 8; ++s) I0[rt] = __builtin_amdgcn_mfma_f32_16x16x32_bf16(fa[rt & 1][s], uf[s], I0[rt], 0, 0, 0);
                __builtin_amdgcn_sched_barrier(0); }
#pragma unroll
            for (int s = 0; s < 8; ++s) uf[s] = *(const bf16x8_t*)((Ub + (256 + 2 * s) * 1024) + uoff);
#pragma unroll
            for (int s = 0; s < 8; ++s) fa[0][s] = *(const LAS bf16x8_t*)(lds + SSM_OFF_BM + ((0 * 8 + s) * 64 + lane) * 16);
#pragma unroll
            for (int rt = 0; rt < 8; ++rt) { I1[rt] = (f32x4){0.f, 0.f, 0.f, 0.f};
                if (rt < 7) {
#pragma unroll
                    for (int s = 0; s < 8; ++s) fa[(rt + 1) & 1][s] = *(const LAS bf16x8_t*)(lds + SSM_OFF_BM + (((rt + 1) * 8 + s) * 64 + lane) * 16);
                }
                __builtin_amdgcn_sched_barrier(0);
#pragma unroll
                for (int s = 0; s < 8; ++s) I1[rt] = __builtin_amdgcn_mfma_f32_16x16x32_bf16(fa[rt & 1][s], uf[s], I1[rt], 0, 0, 0);
                __builtin_amdgcn_sched_barrier(0); }
        }
#pragma unroll
        for (int rt = 0; rt < 8; ++rt) { const f32x4 an = PN[(rt * 16 + (15 - n)) * 4 + q];
            f32x4 t0 = cmul2(an, I0[rt]), t1 = cmul2(an, I1[rt]);
            t0 = t0 + dpp4<0x128>(t0); t0 = t0 + dpp4<0x124>(t0); t0 = t0 + dpp4<0x122>(t0); t0 = t0 + dpp4<0x121>(t0);
            t1 = t1 + dpp4<0x128>(t1); t1 = t1 + dpp4<0x124>(t1); t1 = t1 + dpp4<0x122>(t1); t1 = t1 + dpp4<0x121>(t1);
            const f32x4 e = cmul2(A16(rt), t0) + t1;
            if (n == 0) *(LAS f32x4*)(lds + SSM_OFF_EX + wave * 512 + (rt * 4 + q) * 16) = e; }
        __syncthreads();
#undef QQ
#define QQ qb_
        int tqb = tid; asm volatile("" : "+v"(tqb));
        const int laneb = tqb & 63, nb_ = laneb & 15, qb_ = laneb >> 4;
        unsigned uoffb = (unsigned)((16 * nb_ + (laneb >> 5)) * 1024 + 8 * ((laneb >> 4) & 1)), eoffb = (unsigned)(16 * nb_ * 1024 + 4 * qb_);
        f32x4 carry[8];
#pragma unroll
        for (int rt = 0; rt < 8; ++rt) carry[rt] = (f32x4){0.f, 0.f, 0.f, 0.f};
        for (int m = 0; m < seg; ++m) {
#pragma unroll
            for (int rt = 0; rt < 8; ++rt) { const f32x4 a16 = A16(rt); const f32x4 a32 = cmul2(a16, a16); const f32x4 e = *(const LAS f32x4*)(lds + SSM_OFF_EX + (wave - seg + m) * 512 + (rt * 4 + qb_) * 16);
                carry[rt] = cmul2(a32, carry[rt]) + e; }
        }
        __syncthreads();
        const f32x4 dv = *(const f32x4*)(dsk + g * 16 + 4 * qb_);
#pragma unroll
        for (int rt = 0; rt < 8; ++rt) *(LAS f32x4*)(lds + SSM_OFF_BM + wave * 8192 + (rt * 64 + laneb) * 16) = I1[rt];
#pragma unroll
        for (int batch = 0; batch < 2; ++batch) {
            f32x4 (&I)[8] = I0;
            asm volatile("" : "+v"(uoffb), "+v"(eoffb));
            if (batch == 1) {
#pragma unroll
                for (int rt = 0; rt < 8; ++rt) { I0[rt] = *(const LAS f32x4*)(lds + SSM_OFF_BM + wave * 8192 + (rt * 64 + laneb) * 16); carry[rt] = *(const LAS f32x4*)(lds + SSM_OFF_EX + wave * 512 + (rt * 4 + qb_) * 16); }
            }
#pragma unroll
            for (int rt = 0; rt < 8; ++rt) I[rt] = I[rt] + cmul2(PW[(0 * 8 + rt) * 4 + qb_], dpp4<0x111>(I[rt]));
#pragma unroll
            for (int rt = 0; rt < 8; ++rt) I[rt] = I[rt] + cmul2(PW[(1 * 8 + rt) * 4 + qb_], dpp4<0x112>(I[rt]));
#pragma unroll
            for (int rt = 0; rt < 8; ++rt) I[rt] = I[rt] + cmul2(PW[(2 * 8 + rt) * 4 + qb_], dpp4<0x114>(I[rt]));
#pragma unroll
            for (int rt = 0; rt < 8; ++rt) I[rt] = I[rt] + cmul2(PW[(3 * 8 + rt) * 4 + qb_], dpp4<0x118>(I[rt]));
            bf16x8_t sf[4];
#pragma unroll
            for (int s = 0; s < 4; ++s) {
                const f32x4 p0 = dpp4<0x111>(I[2 * s]) + cmul2(PN[((2 * s) * 16 + nb_) * 4 + qb_], carry[2 * s]);
                const f32x4 p1 = dpp4<0x111>(I[2 * s + 1]) + cmul2(PN[((2 * s + 1) * 16 + nb_) * 4 + qb_], carry[2 * s + 1]);
                const u32x4 w = (u32x4){pg8::cvt_pk_bf16(p0[0], p0[1]), pg8::cvt_pk_bf16(p0[2], p0[3]), pg8::cvt_pk_bf16(p1[0], p1[1]), pg8::cvt_pk_bf16(p1[2], p1[3])};
                sf[s] = __builtin_bit_cast(bf16x8_t, w);
            }
            if (batch == 0) {
#pragma unroll
                for (int rt = 0; rt < 8; ++rt) { const f32x4 last = (f32x4){__shfl(I[rt][0], 15, 16), __shfl(I[rt][1], 15, 16), __shfl(I[rt][2], 15, 16), __shfl(I[rt][3], 15, 16)};
                    const f32x4 cn = cmul2(A16(rt), carry[rt]) + last; if (nb_ == 0) *(LAS f32x4*)(lds + SSM_OFF_EX + wave * 512 + (rt * 4 + qb_) * 16) = cn; }
            }
            bf16x8_t uf[8];
#pragma unroll
            for (int s = 0; s < 8; ++s) uf[s] = *(const bf16x8_t*)((Ub + (batch * 256 + 2 * s) * 1024) + uoffb);
            uint2 uwv[16]; bf16x8_t fc[4], kt[16];
#define SSM_LDC(ii) do { _Pragma("unroll") for (int s = 0; s < 4; ++s) fc[s] = *(const LAS bf16x8_t*)(lds + SSM_OFF_CM + (((ii) * 4 + s) * 64 + laneb) * 16); } while (0)
#define SSM_LDK(f) (*(const LAS bf16x8_t*)(lds + SSM_OFF_KT + (((f) + 1 - (laneb >> 5)) * 256 + (laneb & 15) * 16 + 8 * ((laneb >> 4) & 1)) * 2))
#pragma unroll
            for (int i = 0; i < 4; ++i) uwv[i] = *(const uint2*)((Ub + (batch * 256 + i) * 1024) + eoffb);
            SSM_LDC(0); kt[0] = SSM_LDK(0);
#pragma unroll
            for (int i = 0; i < 16; ++i) {
                __builtin_amdgcn_sched_barrier(0);
                f32x4 acc = (f32x4){0.f, 0.f, 0.f, 0.f};
#pragma unroll
                for (int s = 0; s < 4; ++s) acc = __builtin_amdgcn_mfma_f32_16x16x32_bf16(fc[s], sf[s], acc, 0, 0, 0);
                __builtin_amdgcn_sched_barrier(0);
                if (i + 1 < 16) { SSM_LDC(i + 1); kt[i + 1] = SSM_LDK(i + 1); }
                if (i + 4 < 16) uwv[i + 4] = *(const uint2*)((Ub + (batch * 256 + i + 4) * 1024) + eoffb);
                __builtin_amdgcn_sched_barrier(0);
#pragma unroll
                for (int s = 0; s <= i / 2; ++s) acc = __builtin_amdgcn_mfma_f32_16x16x32_bf16(kt[i - 2 * s], uf[s], acc, 0, 0, 0);
                const uint2 uw = uwv[i];
                const float y[4] = {acc[0] + dv[0] * pg8::bflo(uw.x), acc[1] + dv[1] * pg8::bfhi(uw.x), acc[2] + dv[2] * pg8::bflo(uw.y), acc[3] + dv[3] * pg8::bfhi(uw.y)};
                float ge[4];
#pragma unroll
                for (int r = 0; r < 4; ++r) ge[r] = y[r] * pg8::sigm(1.5957691216057308f * (y[r] + 0.044715f * y[r] * y[r] * y[r]));
                *(uint2*)((Gb + (batch * 256 + i) * 1024) + eoffb) = make_uint2(pg8::cvt_pk_bf16(ge[0], ge[1]), pg8::cvt_pk_bf16(ge[2], ge[3]));
                __builtin_amdgcn_sched_barrier(0);
            }
#undef SSM_LDC
#undef SSM_LDK
        }
#undef A16
#undef QQ
    }
}

template <class Epi> __device__ __forceinline__ void run_gemm(LAS unsigned char* lds, const bf16_t* A, const bf16_t* Bt, int N, const Epi& E, int G, const int tid) {
    pg8::Gemm g{A, Bt, MTOK, N, 1024}; pg8::StaticOrder S; S.init(MTOK, N, G, (int)blockIdx.x);
    pg8::gemm_phase<Epi, pg8::StaticOrder, true, true>(lds, g, S, E, tid);
}
__global__ void __launch_bounds__(NWAVES * 64, 2) mega_fwd(Args args) {
    extern __shared__ __attribute__((aligned(16))) unsigned char lds_raw[];
    LAS unsigned char* lds = (LAS unsigned char*)lds_raw;
    const int G = gridDim.x, bx = blockIdx.x, vcu = (G % 8 == 0) ? (bx % 8) * (G / 8) + bx / 8 : bx;
    const int wave = __builtin_amdgcn_readfirstlane((int)threadIdx.x >> 6);
#define TID() (wave * 64 + lane_id_fresh())
    unsigned char* ws = args.ws;
    bf16_t* WB = (bf16_t*)(ws + WS_W); bf16_t* HB = (bf16_t*)(ws + WS_HB);
    bf16_t* B1 = (bf16_t*)(ws + WS_B1); bf16_t* B2 = (bf16_t*)(ws + WS_B2); bf16_t* B3 = (bf16_t*)(ws + WS_B3); bf16_t* B4 = (bf16_t*)(ws + WS_B4); bf16_t* YB = (bf16_t*)(ws + WS_Y);
    float* P = (float*)(ws + WS_P); float* cumloc = (float*)(ws + WS_CUMLOC); float* ctot = (float*)(ws + WS_CTOT);
    const int lo = args.ph_lo, hi = args.ph_hi;
#define IN(k) (lo <= (k) && (k) < hi)
    { const int t_ = TID(); if (t_ < 64) ((LAS unsigned*)(lds + MISC_OFF))[t_] = 0u; __syncthreads(); }
    XcdBarrier bar; bar.bar = (unsigned*)ws; bar.x = 0; bar.st = nullptr;
    if (hi - lo > 1) bar = xcd_barrier_post((unsigned*)ws, (volatile LAS unsigned*)(lds + MISC_OFF + 32), TID());
    if (lo < 0) cg::this_grid().sync();
#define SEAM(k) do { if (IN(k) && IN((k) + 1)) xcd_barrier(bar, TID()); } while (0)
    if (IN(0)) { p0_prologue(args, lds, vcu, G, TID()); ssm_tables(args, lds, vcu, G, TID()); } SEAM(0);
    if (IN(1)) { pg8::EpiConvIn E{P, B1, B2}; run_gemm(lds, HB, WB + (size_t)W_C0IN * 1024, 3072, E, G, TID()); } SEAM(1);
    if (IN(2)) { conv_phase(lds, B1, B2, args.in[3], args.in[4], args.in[5], args.in[6], YB, vcu, G, TID()); } SEAM(2);
    if (IN(3)) { pg8::EpiOut E{HB, P, args.out, 0}; run_gemm(lds, YB, WB + (size_t)W_C0OUT * 1024, 1024, E, G, TID()); } SEAM(3);
    if (IN(4)) { pg8::EpiFoxIn E{P, B1, B3, B4, B2, args.in[10], args.in[11]}; run_gemm(lds, HB, WB + (size_t)W_FIN * 1024, 4096, E, G, TID());
                 fcum_phase(lds, HB, WB + (size_t)W_FF * 1024, P, args.in[9], cumloc, ctot, vcu, G, TID()); } SEAM(4);
    if (IN(5)) { const attn_body::AttnTensors AT{(const attn_body::bf16*)B1, (const attn_body::bf16*)B3, (const attn_body::bf16*)B4, (const attn_body::bf16*)B2, (attn_body::bf16*)YB, cumloc, ctot, args.in[10], args.in[11]};
                 const attn_body::StaticOrder S(G, bx); attn_body::attn_phase<attn_body::StaticOrder>((char*)lds_raw, AT, S, TID()); } SEAM(5);
    if (IN(6)) { pg8::EpiOut E{HB, P, args.out, 0}; run_gemm(lds, YB, WB + (size_t)W_FOUT * 1024, 1024, E, G, TID()); } SEAM(6);
    if (IN(7)) { pg8::EpiSsmIn E{P, B1, B2}; run_gemm(lds, HB, WB + (size_t)W_SIN * 1024, 2048, E, G, TID()); } SEAM(7);
    if (IN(8)) { ssm_phase(lds, ws, B1, args.in[21], B3, vcu, G, TID()); } SEAM(8);
    if (IN(10)) { pg8::EpiGlu E{B3, B2, args.in[23], YB}; run_gemm(lds, B3, WB + (size_t)W_SGLU * 1024, 1024, E, G, TID()); } SEAM(10);
    if (IN(11)) { pg8::EpiOut E{HB, P, args.out, 0}; run_gemm(lds, YB, WB + (size_t)W_SOUT * 1024, 1024, E, G, TID()); } SEAM(11);
    if (IN(12)) { pg8::EpiConvIn E{P, B1, B2}; run_gemm(lds, HB, WB + (size_t)W_C1IN * 1024, 3072, E, G, TID()); } SEAM(12);
    if (IN(13)) { conv_phase(lds, B1, B2, args.in[3] + (size_t)CONV_K * 1024, args.in[4] + 1024, args.in[5] + 1024, args.in[6] + 1024, YB, vcu, G, TID()); } SEAM(13);
    if (IN(14)) { pg8::EpiOut E{HB, P, args.out, 1}; run_gemm(lds, YB, WB + (size_t)W_C1OUT * 1024, 1024, E, G, TID()); }
#undef IN
#undef SEAM
}

#ifndef MK_ONE_LAUNCH
#define MK_ONE_LAUNCH 1
#endif
constexpr int N_PHASES = 15;
extern "C" void kernel_launch(void* const* d_in, const int* in_sizes, int n_in, void* d_out, int out_size, void* d_ws, size_t ws_size, hipStream_t stream) {
    static int grid = 0;
    if (grid == 0) {
        if (n_in != 25 || out_size != MTOK * DMODEL || ws_size < WS_END) { fprintf(stderr, "kernel_launch: unexpected shapes (n_in %d, out %d, ws %zu)\n", n_in, out_size, ws_size); grid = -1; return; }
        int dev = 0, cus = 0, per_cu = 0;
        if (hipGetDevice(&dev) != hipSuccess || hipDeviceGetAttribute(&cus, hipDeviceAttributeMultiprocessorCount, dev) != hipSuccess) { grid = -1; return; }
        if (hipFuncSetAttribute((const void*)mega_fwd, hipFuncAttributeMaxDynamicSharedMemorySize, LDS_BYTES) != hipSuccess) { fprintf(stderr, "kernel_launch: hipFuncSetAttribute failed\n"); grid = -1; return; }
        if (hipOccupancyMaxActiveBlocksPerMultiprocessor(&per_cu, (const void*)mega_fwd, NWAVES * 64, LDS_BYTES) != hipSuccess || per_cu < 1) { fprintf(stderr, "kernel_launch: occupancy query says %d blocks per CU\n", per_cu); grid = -1; (void)hipGetLastError(); return; }
        grid = cus;
    }
    if (grid < 0) return;
    if (hipMemsetAsync(d_ws, 0, 16384, stream) != hipSuccess) { fprintf(stderr, "kernel_launch: memset failed\n"); return; }
    Args a{};
    for (int i = 0; i < 25; ++i) a.in[i] = (const float*)d_in[i];
    a.out = (float*)d_out; a.ws = (unsigned char*)d_ws;
#if MK_ONE_LAUNCH
    a.ph_lo = 0; a.ph_hi = N_PHASES;
    void* kargs[] = {&a};
    const hipError_t e = hipLaunchCooperativeKernel((const void*)mega_fwd, dim3(grid), dim3(NWAVES * 64), kargs, LDS_BYTES, stream);
    if (e != hipSuccess) fprintf(stderr, "kernel_launch: cooperative launch failed: %s (grid %d)\n", hipGetErrorString(e), grid);
#else
    for (int p = 0; p < N_PHASES; ++p) { a.ph_lo = p; a.ph_hi = p + 1; hipLaunchKernelGGL(mega_fwd, dim3(grid), dim3(NWAVES * 64), LDS_BYTES, stream, a); }
#endif
}
```

```cpp
#include <hip/hip_runtime.h>
#include <hip/hip_cooperative_groups.h>
#include <cstdio>
#include <cstdint>
#include <cmath>
namespace cg = cooperative_groups;

constexpr int BATCH = 8, SEQ = 2048, DMODEL = 1024, MTOK = BATCH * SEQ;
constexpr int CONV_K = 31, NHEADS = 16, HDIM = 64, NGRP = 64, NST = 64, CGRP = 16;
constexpr float RMS_EPS = 1e-6f, LN_EPS = 1e-5f, LOG2E = 1.4426950408889634f;

namespace pg8 {
#define PG8_LAS __attribute__((address_space(3)))
typedef unsigned short bf16_t;
typedef short bf16x8 __attribute__((ext_vector_type(8)));
typedef float f32x4 __attribute__((ext_vector_type(4)));
typedef unsigned u32x4 __attribute__((ext_vector_type(4)));
constexpr int BM = 256, BK = 64, HALF = 128, HTB = HALF * BK * 2  , STAGE_BYTES = 8 * HTB, NXCD = 8, WGM = 8;

__host__ __device__ __forceinline__ int lds_byte(int r, int c) { const int st = (r >> 4) * 2 + (c >> 5), rr = r & 15, cc = c & 31, ob = rr * 64 + cc * 2; return st * 1024 + (ob ^ (((ob >> 9) & 1) << 5)); }
__host__ __device__ __forceinline__ void stage_rc(int b, int& R, int& C) { const int st = b / 1024, sb = b % 1024, swz = sb ^ (((sb >> 9) & 1) << 5); R = (st >> 1) * 16 + swz / 64; C = (st & 1) * 32 + (swz % 64) / 2; }
__host__ __device__ __forceinline__ int perm32(int rho) { const int n = rho >> 4, i = rho & 15; return 8 * (i >> 2) + 4 * n + (i & 3); }

struct Unit { int pm, pn; };
struct Gemm { const bf16_t* A; const bf16_t* Bt; int M, N, K; };

struct StaticOrder {
    int nM, nN, nwg, G, c;
    __host__ __device__ void init(int M, int N, int G_, int c_) { nM = M / BM; nN = N / BM; nwg = nM * nN; G = G_; c = c_; }
    __host__ __device__ bool next(int i, Unit& u) const {
        const long L = (long)i * G + c; if (L >= nwg) return false;
        int wgid = (int)L; { const int q = nwg / NXCD, r = nwg % NXCD, xcd = wgid % NXCD, off = wgid / NXCD; wgid = (xcd < r ? xcd * (q + 1) : r * (q + 1) + (xcd - r) * q) + off; }
        const int nig = WGM * nN, gid = wgid / nig, fm = gid * WGM, gsz = (nM - fm) < WGM ? (nM - fm) : WGM;
        u.pm = fm + ((wgid % nig) % gsz); u.pn = (wgid % nig) / gsz; return true;
    }
    __device__ __forceinline__ void a_ready(const Unit&) const {}
    __device__ __forceinline__ void done(const Unit&) const {}
};
__device__ __forceinline__ unsigned cvt_pk_bf16(float lo, float hi) { unsigned r; asm volatile("v_cvt_pk_bf16_f32 %0, %1, %2" : "=v"(r) : "v"(lo), "v"(hi)); return r; }
typedef float f32x2 __attribute__((ext_vector_type(2)));
typedef unsigned u32x2 __attribute__((ext_vector_type(2)));
__device__ __forceinline__ float sigm(float x) { return __builtin_amdgcn_rcpf(1.0f + __builtin_amdgcn_exp2f(-1.4426950408889634f * x)); }
__device__ __forceinline__ float silu(float x) { return x * sigm(x); }
__device__ __forceinline__ float bflo(unsigned w) { return __uint_as_float(w << 16); }
__device__ __forceinline__ float bfhi(unsigned w) { return __uint_as_float(w & 0xffff0000u); }
__device__ __forceinline__ void row_scales(float (&sc)[2][4], const float* P, int row0, int fq) {
#pragma unroll
    for (int ai = 0; ai < 2; ++ai)
#pragma unroll
        for (int m = 0; m < 4; ++m) { const f32x4 p = *(const f32x4*)(P + (size_t)(row0 + ai * HALF + m * 16) * 16 + 4 * fq);
            float s = (p[0] + p[1]) + (p[2] + p[3]); s += __shfl_xor(s, 16); s += __shfl_xor(s, 32);
            sc[ai][m] = rsqrtf(s * (1.0f / 1024.0f) + 1e-6f); }
}
struct EpiConvIn {
    static constexpr bool PERM = true, AFTER_DRAIN = false;
    const float* P; bf16_t* U; bf16_t* SG;
    __device__ __forceinline__ void operator()(const f32x4 (&acc)[2][2][4][2], const Unit& u, int wr, int wc, int fr, int fq) const {
        const int row0 = u.pm * BM + wr * 64 + fr; float sc[2][4]; row_scales(sc, P, row0, fq);
        if (u.pn < 8) {
            bf16_t* base = U + u.pn * 128 + wc * 32 + 8 * fq;
#pragma unroll
            for (int ai = 0; ai < 2; ++ai)
#pragma unroll
                for (int m = 0; m < 4; ++m) { const float s = sc[ai][m];
                    const f32x4 a0 = acc[ai][0][m][0] * s, a1 = acc[ai][0][m][1] * s, b0 = acc[ai][1][m][0] * s, b1 = acc[ai][1][m][1] * s; u32x4 w;
                    w.x = cvt_pk_bf16(a0[0] * sigm(b0[0]), a0[1] * sigm(b0[1])); w.y = cvt_pk_bf16(a0[2] * sigm(b0[2]), a0[3] * sigm(b0[3]));
                    w.z = cvt_pk_bf16(a1[0] * sigm(b1[0]), a1[1] * sigm(b1[1])); w.w = cvt_pk_bf16(a1[2] * sigm(b1[2]), a1[3] * sigm(b1[3]));
                    *(u32x4*)(base + (size_t)(row0 + ai * HALF + m * 16) * 1024) = w; }
        } else {
            bf16_t* base = SG + (u.pn - 8) * 256 + wc * 32 + 8 * fq;
#pragma unroll
            for (int ai = 0; ai < 2; ++ai)
#pragma unroll
                for (int m = 0; m < 4; ++m) { const float s = sc[ai][m];
#pragma unroll
                    for (int bj = 0; bj < 2; ++bj) { const f32x4 v0 = acc[ai][bj][m][0] * s, v1 = acc[ai][bj][m][1] * s; u32x4 w;
                        w.x = cvt_pk_bf16(silu(v0[0]), silu(v0[1])); w.y = cvt_pk_bf16(silu(v0[2]), silu(v0[3])); w.z = cvt_pk_bf16(silu(v1[0]), silu(v1[1])); w.w = cvt_pk_bf16(silu(v1[2]), silu(v1[3]));
                        *(u32x4*)(base + (size_t)(row0 + ai * HALF + m * 16) * 1024 + bj * HALF) = w; } }
        }
    }
};
struct EpiFoxIn {
    static constexpr bool PERM = true, AFTER_DRAIN = false;
    const float* P; bf16_t* Q; bf16_t* K; bf16_t* V; bf16_t* SG; const float* qg; const float* kg;
    __device__ __forceinline__ void operator()(const f32x4 (&acc)[2][2][4][2], const Unit& u, int wr, int wc, int fr, int fq) const {
        const int row0 = u.pm * BM + wr * 64 + fr; float sc[2][4]; row_scales(sc, P, row0, fq);
        const int sec = u.pn >> 2, colb = (4 * (u.pn & 3) + wc) * 64 + 8 * fq;
        if (sec < 2) {
            const float* g = sec == 0 ? qg : kg; bf16_t* dst = (sec == 0 ? Q : K) + colb; const float post = sec == 0 ? 0.125f * 1.4426950408889634f : 1.0f;
            f32x4 gv[2][2];
#pragma unroll
            for (int bj = 0; bj < 2; ++bj)
#pragma unroll
                for (int n = 0; n < 2; ++n) gv[bj][n] = *(const f32x4*)(g + 32 * bj + 8 * fq + 4 * n);
#pragma unroll
            for (int ai = 0; ai < 2; ++ai)
#pragma unroll
                for (int m = 0; m < 4; ++m) { const float s = sc[ai][m]; f32x4 x[2][2]; float ss = 0.f;
#pragma unroll
                    for (int bj = 0; bj < 2; ++bj)
#pragma unroll
                        for (int n = 0; n < 2; ++n) { x[bj][n] = acc[ai][bj][m][n] * s; ss += (x[bj][n][0] * x[bj][n][0] + x[bj][n][1] * x[bj][n][1]) + (x[bj][n][2] * x[bj][n][2] + x[bj][n][3] * x[bj][n][3]); }
                    ss += __shfl_xor(ss, 16); ss += __shfl_xor(ss, 32);
                    const float r = rsqrtf(ss * (1.0f / 64.0f) + 1e-6f) * post;
#pragma unroll
                    for (int bj = 0; bj < 2; ++bj) { const f32x4 y0 = x[bj][0] * gv[bj][0] * r, y1 = x[bj][1] * gv[bj][1] * r; u32x4 w;
                        w.x = cvt_pk_bf16(y0[0], y0[1]); w.y = cvt_pk_bf16(y0[2], y0[3]); w.z = cvt_pk_bf16(y1[0], y1[1]); w.w = cvt_pk_bf16(y1[2], y1[3]);
                        *(u32x4*)(dst + (size_t)(row0 + ai * HALF + m * 16) * 1024 + 32 * bj) = w; } }
        } else {
            bf16_t* dst = (sec == 2 ? V : SG) + colb;
#pragma unroll
            for (int ai = 0; ai < 2; ++ai)
#pragma unroll
                for (int m = 0; m < 4; ++m) { const float s = sc[ai][m];
#pragma unroll
                    for (int bj = 0; bj < 2; ++bj) { f32x4 v0 = acc[ai][bj][m][0] * s, v1 = acc[ai][bj][m][1] * s;
                        if (sec == 3) { v0 = (f32x4){silu(v0[0]), silu(v0[1]), silu(v0[2]), silu(v0[3])}; v1 = (f32x4){silu(v1[0]), silu(v1[1]), silu(v1[2]), silu(v1[3])}; }
                        u32x4 w; w.x = cvt_pk_bf16(v0[0], v0[1]); w.y = cvt_pk_bf16(v0[2], v0[3]); w.z = cvt_pk_bf16(v1[0], v1[1]); w.w = cvt_pk_bf16(v1[2], v1[3]);
                        *(u32x4*)(dst + (size_t)(row0 + ai * HALF + m * 16) * 1024 + 32 * bj) = w; } }
        }
    }
};
struct EpiSsmIn {
    static constexpr bool PERM = true, AFTER_DRAIN = false;
    const float* P; bf16_t* U; bf16_t* SG;
    __device__ __forceinline__ void operator()(const f32x4 (&acc)[2][2][4][2], const Unit& u, int wr, int wc, int fr, int fq) const {
        const int row0 = u.pm * BM + wr * 64 + fr; float sc[2][4]; row_scales(sc, P, row0, fq);
        const bool gate = u.pn >= 4; bf16_t* dst = (gate ? SG : U) + (u.pn & 3) * 256 + wc * 32 + 8 * fq;
#pragma unroll
        for (int ai = 0; ai < 2; ++ai)
#pragma unroll
            for (int m = 0; m < 4; ++m) { const float s = sc[ai][m];
#pragma unroll
                for (int bj = 0; bj < 2; ++bj) { f32x4 v0 = acc[ai][bj][m][0] * s, v1 = acc[ai][bj][m][1] * s;
                    if (gate) { v0 = (f32x4){silu(v0[0]), silu(v0[1]), silu(v0[2]), silu(v0[3])}; v1 = (f32x4){silu(v1[0]), silu(v1[1]), silu(v1[2]), silu(v1[3])}; }
                    u32x4 w; w.x = cvt_pk_bf16(v0[0], v0[1]); w.y = cvt_pk_bf16(v0[2], v0[3]); w.z = cvt_pk_bf16(v1[0], v1[1]); w.w = cvt_pk_bf16(v1[2], v1[3]);
                    *(u32x4*)(dst + (size_t)(row0 + ai * HALF + m * 16) * 1024 + bj * HALF) = w; } }
    }
};
struct EpiOut {
    static constexpr bool PERM = true, AFTER_DRAIN = false;
    bf16_t* hb; float* P; float* out; int last;
    __device__ __forceinline__ void operator()(const f32x4 (&acc)[2][2][4][2], const Unit& u, int wr, int wc, int fr, int fq) const {
        const int row0 = u.pm * BM + wr * 64 + fr, col0 = u.pn * BM + wc * 32 + 8 * fq;
#pragma unroll
        for (int ai = 0; ai < 2; ++ai)
#pragma unroll
            for (int m = 0; m < 4; ++m) { const int row = row0 + ai * HALF + m * 16; float ss = 0.f;
#pragma unroll
                for (int bj = 0; bj < 2; ++bj) { const size_t off = (size_t)row * 1024 + col0 + bj * HALF;
                    const u32x4 r = *(const u32x4*)(hb + off);
                    const f32x4 h0 = (f32x4){bflo(r.x), bfhi(r.x), bflo(r.y), bfhi(r.y)} + acc[ai][bj][m][0], h1 = (f32x4){bflo(r.z), bfhi(r.z), bflo(r.w), bfhi(r.w)} + acc[ai][bj][m][1];
                    if (last) { __builtin_nontemporal_store(h0, (f32x4*)(out + off)); __builtin_nontemporal_store(h1, (f32x4*)(out + off + 4)); }
                    else { ss += ((h0[0] * h0[0] + h0[1] * h0[1]) + (h0[2] * h0[2] + h0[3] * h0[3])) + ((h1[0] * h1[0] + h1[1] * h1[1]) + (h1[2] * h1[2] + h1[3] * h1[3]));
                        u32x4 w; w.x = cvt_pk_bf16(h0[0], h0[1]); w.y = cvt_pk_bf16(h0[2], h0[3]); w.z = cvt_pk_bf16(h1[0], h1[1]); w.w = cvt_pk_bf16(h1[2], h1[3]); *(u32x4*)(hb + off) = w; } }
                if (!last) { ss += __shfl_xor(ss, 16); ss += __shfl_xor(ss, 32); if (fq == 0) P[(size_t)row * 16 + 4 * u.pn + wc] = ss; } }
    }
};
struct EpiGlu {
    static constexpr bool PERM = true, AFTER_DRAIN = false;
    const bf16_t* G; const bf16_t* SG; const float* bias; bf16_t* Y;
    __device__ __forceinline__ void operator()(const f32x4 (&acc)[2][2][4][2], const Unit& u, int wr, int wc, int fr, int fq) const {
        const int row0 = u.pm * BM + wr * 64 + fr, col0 = u.pn * BM + wc * 32 + 8 * fq;
        f32x4 bv[2][2];
#pragma unroll
        for (int bj = 0; bj < 2; ++bj)
#pragma unroll
            for (int n = 0; n < 2; ++n) bv[bj][n] = *(const f32x4*)(bias + col0 + bj * HALF + 4 * n);
#pragma unroll
        for (int ai = 0; ai < 2; ++ai)
#pragma unroll
            for (int m = 0; m < 4; ++m)
#pragma unroll
                for (int bj = 0; bj < 2; ++bj) { const size_t off = (size_t)(row0 + ai * HALF + m * 16) * 1024 + col0 + bj * HALF;
                    const u32x4 gq = *(const u32x4*)(G + off), sq = *(const u32x4*)(SG + off);
                    const f32x4 t0 = acc[ai][bj][m][0] + bv[bj][0], t1 = acc[ai][bj][m][1] + bv[bj][1]; u32x4 w;
                    w.x = cvt_pk_bf16(bflo(gq.x) * sigm(t0[0]) * bflo(sq.x), bfhi(gq.x) * sigm(t0[1]) * bfhi(sq.x));
                    w.y = cvt_pk_bf16(bflo(gq.y) * sigm(t0[2]) * bflo(sq.y), bfhi(gq.y) * sigm(t0[3]) * bfhi(sq.y));
                    w.z = cvt_pk_bf16(bflo(gq.z) * sigm(t1[0]) * bflo(sq.z), bfhi(gq.z) * sigm(t1[1]) * bfhi(sq.z));
                    w.w = cvt_pk_bf16(bflo(gq.w) * sigm(t1[2]) * bflo(sq.w), bfhi(gq.w) * sigm(t1[3]) * bfhi(sq.w));
                    *(u32x4*)(Y + off) = w; }
    }
};

template <class Epi, class Sched, bool ALIGN_EPI = false, bool SP2 = false>
__device__ __forceinline__ void gemm_phase(PG8_LAS unsigned char* lds, const Gemm g, const Sched& S, const Epi& E, const int tid) {
    const int wid = __builtin_amdgcn_readfirstlane(tid >> 6), lane = tid & 63, wr = wid >> 2, wc = wid & 3, fr = lane & 15, fq = lane >> 4;
    const int K = g.K, nt = K / BK;
    unsigned voffA[2], voffB[2];
#pragma unroll
    for (int i = 0; i < 2; ++i) { int R, C; stage_rc(tid * 16 + i * 8192, R, C); const int Rb = Epi::PERM ? ((R & ~31) + perm32(R & 31)) : R;
        voffA[i] = (unsigned)(R * K + C) * 2u; voffB[i] = (unsigned)(Rb * K + C) * 2u; }
    const size_t kstep = (size_t)(BK * 2);
    const size_t hstep = (size_t)HALF * K * 2;
    const size_t tstep = 2 * hstep;
    const unsigned ldsw = (unsigned)wid * 1024u;
    const int aoff = lds_byte(wr * 64 + fr, fq * 8), boff = lds_byte(wc * 32 + fr, fq * 8);
#define PG8_SA(b, h) (((b) * 2 + (h)) * HTB)
#define PG8_SB(b, h) ((4 + (b) * 2 + (h)) * HTB)
#define PG8_STAGE(bufoff, gbase, voff) do { _Pragma("unroll") for (int _i = 0; _i < 2; ++_i) \
        __builtin_amdgcn_global_load_lds((const unsigned*)((const char*)(gbase) + (voff)[_i]), (PG8_LAS unsigned*)(lds + (bufoff) + ldsw + _i * 8192), 16, 0, 0); } while (0)
#define PG8_LDA(dst, b, h) do { _Pragma("unroll") for (int m = 0; m < 4; ++m) _Pragma("unroll") for (int k = 0; k < 2; ++k) dst[m][k] = *(const PG8_LAS bf16x8*)(lds + PG8_SA(b, h) + aoff + m * 2048 + k * 1024); } while (0)
#define PG8_LDB(dst, b, h) do { _Pragma("unroll") for (int n = 0; n < 2; ++n) _Pragma("unroll") for (int k = 0; k < 2; ++k) dst[n][k] = *(const PG8_LAS bf16x8*)(lds + PG8_SB(b, h) + boff + n * 2048 + k * 1024); } while (0)
#define PG8_MMA(ai, bj, At, Bt) do { __builtin_amdgcn_s_setprio(1); _Pragma("unroll") for (int m = 0; m < 4; ++m) _Pragma("unroll") for (int n = 0; n < 2; ++n) _Pragma("unroll") for (int k = 0; k < 2; ++k) \
        acc[ai][bj][m][n] = __builtin_amdgcn_mfma_f32_16x16x32_bf16(Bt[n][k], At[m][k], acc[ai][bj][m][n], 0, 0, 0); __builtin_amdgcn_s_setprio(0); } while (0)
#define PG8_WAIT_V(n) asm volatile("s_waitcnt vmcnt(" #n ")" ::: "memory")
#define PG8_WAIT_L(n) asm volatile("s_waitcnt lgkmcnt(" #n ")" ::: "memory")
#define PG8_BAR __builtin_amdgcn_s_barrier()
#define PG8_SCHED __builtin_amdgcn_sched_barrier(0)
    Unit cur, nxt; int ui = 0;
    if (!S.next(0, cur)) return;
    f32x4 acc[2][2][4][2];
#pragma unroll
    for (int a = 0; a < 2; ++a)
#pragma unroll
        for (int b = 0; b < 2; ++b)
#pragma unroll
            for (int m = 0; m < 4; ++m)
#pragma unroll
                for (int n = 0; n < 2; ++n) acc[a][b][m][n] = (f32x4){0.f, 0.f, 0.f, 0.f};
    bf16x8 At[4][2], B0[2][2], B1[2][2];
    const char* cA = (const char*)g.A + (size_t)cur.pm * tstep; const char* cB = (const char*)g.Bt + (size_t)cur.pn * tstep;
    S.a_ready(cur);
    if constexpr (SP2) {
        PG8_STAGE(PG8_SB(0, 0), cB, voffB); PG8_STAGE(PG8_SB(0, 1), cB + hstep, voffB); PG8_STAGE(PG8_SA(0, 0), cA, voffA); PG8_STAGE(PG8_SA(0, 1), cA + hstep, voffA);
        if (wr == 1) PG8_BAR;
        PG8_WAIT_V(2); PG8_BAR;
        PG8_STAGE(PG8_SB(1, 0), cB + kstep, voffB); PG8_STAGE(PG8_SA(1, 0), cA + kstep, voffA); PG8_STAGE(PG8_SB(1, 1), cB + hstep + kstep, voffB);
        PG8_WAIT_V(6); PG8_BAR;
    } else {
        PG8_STAGE(PG8_SB(0, 0), cB, voffB); PG8_STAGE(PG8_SA(0, 0), cA, voffA); PG8_STAGE(PG8_SB(0, 1), cB + hstep, voffB); PG8_STAGE(PG8_SA(0, 1), cA + hstep, voffA);
        if (wr == 1) PG8_BAR;
        PG8_WAIT_V(4); PG8_BAR;
        PG8_STAGE(PG8_SB(1, 0), cB + kstep, voffB); PG8_STAGE(PG8_SA(1, 0), cA + kstep, voffA); PG8_STAGE(PG8_SB(1, 1), cB + hstep + kstep, voffB);
        PG8_WAIT_V(6); PG8_BAR;
    }
    for (;;) {
        const bool has_next = S.next(ui + 1, nxt);
        const char* nA = has_next ? (const char*)g.A + (size_t)nxt.pm * tstep : cA; const char* nB = has_next ? (const char*)g.Bt + (size_t)nxt.pn * tstep : cB;
        for (int t = 0; t < nt; t += 2) {
            const bool last = (t == nt - 2);
            const char* a1 = cA + (size_t)(t + 1) * kstep;
            const char* a2 = last ? nA : cA + (size_t)(t + 2) * kstep; const char* b2 = last ? nB : cB + (size_t)(t + 2) * kstep;
            const char* a3 = a2 + kstep; const char* b3 = b2 + kstep;
            if (last && has_next) S.a_ready(nxt);
            if constexpr (SP2) {
            PG8_LDB(B0, 0, 0); PG8_LDB(B1, 0, 1); PG8_SCHED; PG8_LDA(At, 0, 0); PG8_STAGE(PG8_SA(1, 1), a1 + hstep, voffA);
            PG8_WAIT_V(8); PG8_WAIT_L(0); PG8_BAR; PG8_MMA(0, 0, At, B0); PG8_MMA(0, 1, At, B1); PG8_BAR; PG8_SCHED;
            PG8_LDA(At, 0, 1); PG8_STAGE(PG8_SB(0, 0), b2, voffB); PG8_STAGE(PG8_SB(0, 1), b2 + hstep, voffB); PG8_STAGE(PG8_SA(0, 0), a2, voffA);
            PG8_WAIT_V(8); PG8_WAIT_L(0); PG8_BAR; PG8_MMA(1, 0, At, B0); PG8_MMA(1, 1, At, B1); PG8_BAR; PG8_SCHED;
            PG8_LDB(B0, 1, 0); PG8_LDB(B1, 1, 1); PG8_SCHED; PG8_LDA(At, 1, 0); PG8_STAGE(PG8_SA(0, 1), a2 + hstep, voffA);
            PG8_WAIT_V(8); PG8_WAIT_L(0); PG8_BAR; PG8_MMA(0, 0, At, B0); PG8_MMA(0, 1, At, B1); PG8_BAR; PG8_SCHED;
            PG8_LDA(At, 1, 1); PG8_STAGE(PG8_SB(1, 0), b3, voffB); PG8_STAGE(PG8_SB(1, 1), b3 + hstep, voffB); PG8_STAGE(PG8_SA(1, 0), a3, voffA);
            PG8_WAIT_V(8); PG8_WAIT_L(0); PG8_BAR; PG8_MMA(1, 0, At, B0); PG8_MMA(1, 1, At, B1); PG8_BAR; PG8_SCHED;
            } else {
            PG8_LDB(B0, 0, 0); PG8_SCHED; PG8_LDA(At, 0, 0); PG8_STAGE(PG8_SA(1, 1), a1 + hstep, voffA);
            PG8_WAIT_L(8); PG8_BAR; PG8_WAIT_L(0); PG8_MMA(0, 0, At, B0); PG8_BAR; PG8_SCHED;
            PG8_LDB(B1, 0, 1); PG8_STAGE(PG8_SB(0, 0), b2, voffB);
            PG8_BAR; PG8_WAIT_L(0); PG8_MMA(0, 1, At, B1); PG8_BAR;
            PG8_LDA(At, 0, 1); PG8_STAGE(PG8_SA(0, 0), a2, voffA);
            PG8_BAR; PG8_WAIT_L(0); PG8_MMA(1, 0, At, B0); PG8_BAR; PG8_SCHED;
            PG8_STAGE(PG8_SB(0, 1), b2 + hstep, voffB);
            PG8_WAIT_V(6); PG8_BAR; PG8_MMA(1, 1, At, B1); PG8_BAR;
            PG8_LDB(B0, 1, 0); PG8_SCHED; PG8_LDA(At, 1, 0); PG8_STAGE(PG8_SA(0, 1), a2 + hstep, voffA);
            PG8_WAIT_L(8); PG8_BAR; PG8_WAIT_L(0); PG8_MMA(0, 0, At, B0); PG8_BAR; PG8_SCHED;
            PG8_LDB(B1, 1, 1); PG8_STAGE(PG8_SB(1, 0), b3, voffB);
            PG8_BAR; PG8_WAIT_L(0); PG8_MMA(0, 1, At, B1); PG8_BAR;
            PG8_LDA(At, 1, 1); PG8_STAGE(PG8_SA(1, 0), a3, voffA);
            PG8_BAR; PG8_WAIT_L(0); PG8_MMA(1, 0, At, B0); PG8_BAR; PG8_SCHED;
            PG8_STAGE(PG8_SB(1, 1), b3 + hstep, voffB);
            PG8_WAIT_V(6); PG8_BAR; PG8_MMA(1, 1, At, B1); PG8_BAR;
            }
        }
        if constexpr (ALIGN_EPI) { if (wr == 0) PG8_BAR; }
        if constexpr (!Epi::AFTER_DRAIN) { E(acc, cur, wr, wc, fr, fq); S.done(cur); }
        if (!has_next) break;
#pragma unroll
        for (int a = 0; a < 2; ++a)
#pragma unroll
            for (int b = 0; b < 2; ++b)
#pragma unroll
                for (int m = 0; m < 4; ++m)
#pragma unroll
                    for (int n = 0; n < 2; ++n) acc[a][b][m][n] = (f32x4){0.f, 0.f, 0.f, 0.f};
        cur = nxt; cA = nA; cB = nB; ++ui;
        if constexpr (ALIGN_EPI) { if (wr == 1) PG8_BAR; }
    }
    PG8_WAIT_V(0);
    if constexpr (!ALIGN_EPI) { if (wr == 0) PG8_BAR; }
    PG8_BAR;
    if constexpr (Epi::AFTER_DRAIN) { E.fused(acc, cur, wr, wc, fr, fq, lds, wid, lane); S.done(cur); }
#undef PG8_SA
#undef PG8_SB
#undef PG8_STAGE
#undef PG8_LDA
#undef PG8_LDB
#undef PG8_MMA
#undef PG8_WAIT_V
#undef PG8_WAIT_L
#undef PG8_BAR
#undef PG8_SCHED
}
}
#include <hip/hip_bf16.h>
#include <cmath>
namespace attn_body {
using bf16=__hip_bfloat16;
using bf16x8=__attribute__((ext_vector_type(8)))short;
using s16x4=__attribute__((ext_vector_type(4)))short;
using f32x16=__attribute__((ext_vector_type(16)))float;
using u32x4=__attribute__((ext_vector_type(4)))unsigned;
constexpr int BATCH=8,NHEAD=16,SEQ=2048,D=64,DM=NHEAD*D;
constexpr int NW=8,QBLK=32,QB=QBLK*NW,KVBLK=64,NQB=SEQ/QB;
constexpr int ATTN_PITCH=DM, ATTN_UNIT_ROWS=QB;
__device__ __forceinline__ int crow(int r,int hi){return (r&3)+8*(r>>2)+4*hi;}
#define SBAR() __builtin_amdgcn_sched_barrier(0)
__device__ __forceinline__ void cmask(f32x16&p0,f32x16&p1,int jb,int qrel,int hi){
  const float NEG=-INFINITY; int kb=64*jb+4*hi;
  #pragma unroll
  for(int r=0;r<16;++r){int kv=kb+(r&3)+8*(r>>2); if(kv>qrel)p0[r]=NEG; if(kv+32>qrel)p1[r]=NEG;}
}

constexpr int NSLOT=3, SLOTB=8192;
constexpr int LDS_K=0, LDS_V=NSLOT*SLOTB, LDS_WS=2*NSLOT*SLOTB, LDS_OST=LDS_WS+NW*64*4, LDS_CK=LDS_OST+NW*4096, LDS_BYTES=LDS_CK+SEQ*8;
constexpr float C2=0.125f*1.4426950408889634f;
__device__ __forceinline__ void glds16(const void*gsrc,unsigned lds_dst){unsigned keep;
  asm volatile("s_mov_b32 %0, m0\n\ts_mov_b32 m0, %2\n\ts_nop 0\n\tglobal_load_lds_dwordx4 %1, off\n\ts_mov_b32 m0, %0":"=&s"(keep):"v"(gsrc),"s"(lds_dst):"memory");}
__device__ __forceinline__ float max3f(float a,float b,float c){float r;asm("v_max3_f32 %0, %1, %2, %3":"=v"(r):"v"(a),"v"(b),"v"(c));return r;}
__device__ __forceinline__ float max2f(float a,float b){float r;asm("v_max_f32_e32 %0, %1, %2":"=v"(r):"v"(a),"v"(b));return r;}
__device__ __forceinline__ float fadd_s(float a,float b){float r;asm("v_add_f32_e32 %0, %1, %2":"=v"(r):"v"(a),"v"(b));return r;}
__device__ __forceinline__ float fsub_s(float a,float b){float r;asm("v_sub_f32_e32 %0, %1, %2":"=v"(r):"v"(a),"v"(b));return r;}
typedef float f32x2_t __attribute__((ext_vector_type(2))); typedef __bf16 bf16x2_t __attribute__((ext_vector_type(2)));
__device__ __forceinline__ unsigned cvtpk_s(float lo,float hi){f32x2_t v={lo,hi};bf16x2_t b=__builtin_convertvector(v,bf16x2_t);return __builtin_bit_cast(unsigned,b);}
#define WAIT_BAR(N) asm volatile("s_waitcnt vmcnt(" #N ") lgkmcnt(0)\n\ts_barrier":::"memory")

__device__ __forceinline__ void qkt(f32x16&p0,f32x16&p1,const char*Kslot,const bf16x8*qr,int r32,int hi){
  const char*kb=Kslot+hi*1024+r32*16;
  #pragma unroll
  for(int d0=0;d0<4;++d0){
    const bf16x8 b0=*reinterpret_cast<const bf16x8*>(kb+d0*2048);
    const bf16x8 b1=*reinterpret_cast<const bf16x8*>(kb+d0*2048+512);
    p0=__builtin_amdgcn_mfma_f32_32x32x16_bf16(b0,qr[d0],p0,0,0,0);p1=__builtin_amdgcn_mfma_f32_32x32x16_bf16(b1,qr[d0],p1,0,0,0);}
}
typedef __attribute__((address_space(3))) const char* lds_cptr;
typedef short v4i16_t __attribute__((ext_vector_type(4)));
__device__ __forceinline__ void kload8(bf16x8*kf,lds_cptr kp){
  kf[0]=*(const __attribute__((address_space(3))) bf16x8*)(kp);      kf[1]=*(const __attribute__((address_space(3))) bf16x8*)(kp+512);
  kf[2]=*(const __attribute__((address_space(3))) bf16x8*)(kp+2048); kf[3]=*(const __attribute__((address_space(3))) bf16x8*)(kp+2560);
  kf[4]=*(const __attribute__((address_space(3))) bf16x8*)(kp+4096); kf[5]=*(const __attribute__((address_space(3))) bf16x8*)(kp+4608);
  kf[6]=*(const __attribute__((address_space(3))) bf16x8*)(kp+6144); kf[7]=*(const __attribute__((address_space(3))) bf16x8*)(kp+6656);
}
__device__ __forceinline__ void kload2(bf16x8*kf,lds_cptr kp,int j){ kf[2*j]=*(const __attribute__((address_space(3))) bf16x8*)(kp+j*2048); kf[2*j+1]=*(const __attribute__((address_space(3))) bf16x8*)(kp+j*2048+512); }
__device__ __forceinline__ s16x4 vtr(lds_cptr p){ return __builtin_bit_cast(s16x4,__builtin_amdgcn_ds_read_tr16_b64_v4i16((__attribute__((address_space(3))) v4i16_t*)p)); }
__device__ __forceinline__ float rowmax(const f32x16&p0,const f32x16&p1){
  float a=max3f(p0[0],p0[1],p1[0]),b=max3f(p0[2],p0[3],p1[1]);a=max3f(a,p1[2],p1[3]);
  #pragma unroll
  for(int r=4;r<16;r+=4){a=max3f(a,p0[r],p0[r+1]);b=max3f(b,p0[r+2],p0[r+3]);a=max3f(a,p1[r],p1[r+1]);b=max3f(b,p1[r+2],p1[r+3]);}
  const float m=max2f(a,b);
  auto rr=__builtin_amdgcn_permlane32_swap(__float_as_uint(m),__float_as_uint(m),false,false);
  return max2f(__uint_as_float(rr[0]),__uint_as_float(rr[1]));
}
__device__ __forceinline__ void pv(f32x16*o,int vb,bf16x8 pa0,bf16x8 pa1,bf16x8 pa2,bf16x8 pa3){
  #pragma unroll
  for(int d0=0;d0<2;++d0){s16x4 lo[4],hi[4];
    #pragma unroll
    for(int ks=0;ks<4;++ks){
      asm volatile("ds_read_b64_tr_b16 %0,%1 offset:%c2":"=&v"(lo[ks]):"v"(vb),"i"(d0*4096+ks*1024):"memory");
      asm volatile("ds_read_b64_tr_b16 %0,%1 offset:%c2":"=&v"(hi[ks]):"v"(vb),"i"(d0*4096+ks*1024+512):"memory");}
    asm volatile("s_waitcnt lgkmcnt(0)":::"memory");SBAR();
    #define PK(k) (bf16x8){lo[k][0],lo[k][1],lo[k][2],lo[k][3],hi[k][0],hi[k][1],hi[k][2],hi[k][3]}
    o[d0]=__builtin_amdgcn_mfma_f32_32x32x16_bf16(pa0,PK(0),o[d0],0,0,0);
    o[d0]=__builtin_amdgcn_mfma_f32_32x32x16_bf16(pa1,PK(1),o[d0],0,0,0);
    o[d0]=__builtin_amdgcn_mfma_f32_32x32x16_bf16(pa2,PK(2),o[d0],0,0,0);
    o[d0]=__builtin_amdgcn_mfma_f32_32x32x16_bf16(pa3,PK(3),o[d0],0,0,0);
    #undef PK
  }
}

typedef __attribute__((address_space(3))) const float* lds_fptr;
typedef float f32x4_t __attribute__((ext_vector_type(4)));
typedef unsigned u32x2_t __attribute__((ext_vector_type(2)));
__device__ __forceinline__ unsigned bfr(float f){ const unsigned u=__float_as_uint(f); return (u+0x7fffu+((u>>16)&1u))>>16; }
__device__ __forceinline__ void split3(float v,unsigned&h,unsigned&m,unsigned&l){ h=bfr(v); const float r=v-__uint_as_float(h<<16); m=bfr(r); const float r2=r-__uint_as_float(m<<16); l=bfr(r2); }
__device__ __forceinline__ bf16x8 kxfrag(lds_cptr p){ const u32x2_t w=*(const __attribute__((address_space(3))) u32x2_t*)p; const u32x4 f={w[0],w[1],0xBF80BF80u,0u}; return __builtin_bit_cast(bf16x8,f); }
__device__ __forceinline__ bf16x8 mkqx(float mh,int hi){ unsigned h,m,l; split3(mh,h,m,l); u32x4 f={0x3F803F80u,0x3F80u|(h<<16),m|(l<<16),0u}; if(hi)f=u32x4{0u,0u,0u,0u}; return __builtin_bit_cast(bf16x8,f); }
#ifndef ATTN_STORE16
#define ATTN_STORE16(p,v) (*(u32x4*)(p)=(v))
#endif
template<int THRL> __device__ __forceinline__ void attn_unit(int b,int h,int qb,const bf16*Q,const bf16*__restrict__ K,const bf16*__restrict__ V,const bf16*__restrict__ SG,bf16*O,char*shm,const int tid_in,const bool pre,const bool nxt,const float bref){
  int tid=tid_in; asm volatile("":"+v"(tid));
  const int lane=tid&63,r32=lane&31,hi=lane>>5; const int wid=__builtin_amdgcn_readfirstlane(tid>>6);
  const long rowbase=(long)b*SEQ; const int q0=qb*QB;
  const bf16*Qw=Q+(rowbase+q0+wid*QBLK)*DM+h*D;
  const bf16*Kh=K+rowbase*DM+h*D,*Vh=V+rowbase*DM+h*D;
  const unsigned lds0=(unsigned)(uintptr_t)shm;
  float*wsf=(float*)(shm+LDS_WS)+wid*64;
  const bf16*ksrc=Kh+(long)lane*DM+wid*8;
  const bf16*vsrc=Vh+(long)(16*(wid&3)+(lane>>2))*DM+(wid>>2)*32+(lane&3)*8;
  const unsigned kdst=lds0+LDS_K+wid*1024, vdst=lds0+LDS_V+wid*1024;
  #define DMA_K(t,slot) glds16(ksrc+(long)(t)*KVBLK*DM,(unsigned)__builtin_amdgcn_readfirstlane(kdst+(slot)))
  #define DMA_V(t,slot) glds16(vsrc+(long)(t)*KVBLK*DM,(unsigned)__builtin_amdgcn_readfirstlane(vdst+(slot)))
  const int vb0=(int)(lds0+LDS_V)+((lane>>4)&1)*32+(lane&3)*8+(4*hi+((lane&15)>>2))*64;
  const char*Kbase=shm+LDS_K; bf16x8 kf[8];
  const lds_cptr shm3=(lds_cptr)shm; const lds_cptr kxp=shm3+LDS_CK+r32*8; const lds_cptr kp0=shm3+LDS_K+hi*1024+r32*16; const lds_cptr vp0=shm3+LDS_V+((lane>>4)&1)*32+(lane&3)*8+(4*hi+((lane&15)>>2))*64;
  const int NT=(q0+QB)/KVBLK;
  if(!pre){DMA_K(0,0);DMA_V(0,0);DMA_K(1,SLOTB);}
  bf16x8 qr[4];
  #pragma unroll
  for(int d0=0;d0<4;++d0)qr[d0]=*reinterpret_cast<const bf16x8*>(&Qw[(long)r32*DM+d0*16+hi*8]);
  float l_reg=0.f;f32x16 o[2];o[0]=f32x16{};o[1]=f32x16{};
  const int qrel=wid*QBLK+r32;
  #define CMASK(P0,P1,t) do{int jb_=(t)-(NT-4); if(jb_>=0)cmask(P0,P1,jb_,qrel,hi);}while(0)
  f32x16 pA0,pA1,pB0,pB1;
  int sl_prev=0,sl_cur=0,sl_next=SLOTB;
  #define ROT() do{sl_prev=sl_cur;sl_cur=sl_next;sl_next=(sl_next==(NSLOT-1)*SLOTB)?0:sl_next+SLOTB;}while(0)
  if(!pre){DMA_K(2,2*SLOTB);}
  WAIT_BAR(3);
  float mref; { const u32x2_t w=*(const __attribute__((address_space(3))) u32x2_t*)(shm3+LDS_CK+(q0+wid*QBLK+r32)*8); mref=(__uint_as_float(w[0]<<16)+__uint_as_float(w[0]&0xffff0000u))+__uint_as_float(w[1]<<16)+bref; }
  const bf16x8 qx=mkqx(mref,hi); const f32x16 zero16=f32x16{};
  pA0=__builtin_amdgcn_mfma_f32_32x32x16_bf16(kxfrag(kxp),qx,zero16,0,0,0); pA1=__builtin_amdgcn_mfma_f32_32x32x16_bf16(kxfrag(kxp+256),qx,zero16,0,0,0);
  qkt(pA0,pA1,Kbase,qr,r32,hi);asm volatile("s_nop 15\n\ts_nop 7":"+v"(pA0),"+v"(pA1));CMASK(pA0,pA1,0);
  _Pragma("unroll") for(int r=0;r<16;++r){pA0[r]=__builtin_amdgcn_exp2f(pA0[r]);pA1[r]=__builtin_amdgcn_exp2f(pA1[r]);}
  WAIT_BAR(0);
  DMA_K(3,0);DMA_V(1,SLOTB);
  ROT();
  kload8(kf,kp0+sl_cur);
  WAIT_BAR(2);
  s16x4 vlo[8],vhi[8]; u32x4 pw0,pw1,pw2,pw3;
  #define PKW(P,B) cvtpk_s(P[B],P[B+1])
  #define PAF(k) __builtin_bit_cast(bf16x8,pw##k)
  #define VFR(i) (bf16x8){vlo[i][0],vlo[i][1],vlo[i][2],vlo[i][3],vhi[i][0],vhi[i][1],vhi[i][2],vhi[i][3]}
  #define PIN(x) asm volatile("":"+v"(x))
  #define MX3(a,b,c) __builtin_fmaxf(__builtin_fmaxf((a),(b)),(c))
  #define GAPA(MF,A0,A1,A2,A3,W0,W1,PW) do{ MF; sacc+=A0; sacc+=A1; sacc+=A2; sacc+=A3; PIN(sacc); W0; W1; PIN(PW); SBAR(); }while(0)
  #define EX(v) __builtin_amdgcn_exp2f(v)
  #define GAPB(MF,X,B) do{ MF; X[B]=EX(X[B]); X[B+1]=EX(X[B+1]); X[B+2]=EX(X[B+2]); X[B+3]=EX(X[B+3]); PIN(X); SBAR(); }while(0)
  #define VRD(i) do{ vlo[i]=vtr(vp_+(((i)>>2)*4096+((i)&3)*1024)); vhi[i]=vtr(vp_+(((i)>>2)*4096+((i)&3)*1024+512)); }while(0)
  #define KRD(G,j) do{ if(G){ kload2(kf,kp0+sl_next,j); SBAR(); } }while(0)
  #define STEP(C0,C1,P0,P1,t,GK,GV,GL) do{ SBAR(); \
    const lds_cptr vp_=vp0+sl_prev; \
    C0=__builtin_amdgcn_mfma_f32_32x32x16_bf16(kxfrag(kxp+(t)*512),qx,zero16,0,0,0); C1=__builtin_amdgcn_mfma_f32_32x32x16_bf16(kxfrag(kxp+(t)*512+256),qx,zero16,0,0,0); SBAR(); \
    VRD(0); SBAR(); float sacc=(P0[0]+P0[1]); \
    GAPA(C0=__builtin_amdgcn_mfma_f32_32x32x16_bf16(kf[0],qr[0],C0,0,0,0), P0[2],P0[3],P0[4],P0[5],     pw0[0]=PKW(P0,0), pw0[1]=PKW(P0,2), pw0); \
    VRD(4); SBAR(); GAPA(C1=__builtin_amdgcn_mfma_f32_32x32x16_bf16(kf[1],qr[0],C1,0,0,0), P0[6],P0[7],P0[8],P0[9],     pw0[2]=PKW(P0,4), pw0[3]=PKW(P0,6), pw0); \
    VRD(1); SBAR(); GAPA(C0=__builtin_amdgcn_mfma_f32_32x32x16_bf16(kf[2],qr[1],C0,0,0,0),   P0[10],P0[11],P0[12],P0[13], pw1[0]=PKW(P0,8), pw1[1]=PKW(P0,10), pw1); \
    VRD(5); SBAR(); GAPA(C1=__builtin_amdgcn_mfma_f32_32x32x16_bf16(kf[3],qr[1],C1,0,0,0),   P0[14],P0[15],P1[0],P1[1],   pw1[2]=PKW(P0,12),pw1[3]=PKW(P0,14), pw1); \
    VRD(2); SBAR(); GAPA(C0=__builtin_amdgcn_mfma_f32_32x32x16_bf16(kf[4],qr[2],C0,0,0,0),   P1[2],P1[3],P1[4],P1[5],     pw2[0]=PKW(P1,0), pw2[1]=PKW(P1,2), pw2); \
    VRD(6); SBAR(); GAPA(C1=__builtin_amdgcn_mfma_f32_32x32x16_bf16(kf[5],qr[2],C1,0,0,0),   P1[6],P1[7],P1[8],P1[9],     pw2[2]=PKW(P1,4), pw2[3]=PKW(P1,6), pw2); \
    VRD(3); SBAR(); GAPA(C0=__builtin_amdgcn_mfma_f32_32x32x16_bf16(kf[6],qr[3],C0,0,0,0),   P1[10],P1[11],P1[12],P1[13], pw3[0]=PKW(P1,8), pw3[1]=PKW(P1,10), pw3); \
    VRD(7); SBAR(); GAPA(C1=__builtin_amdgcn_mfma_f32_32x32x16_bf16(kf[7],qr[3],C1,0,0,0),   P1[14],P1[15],0.f,0.f,       pw3[2]=PKW(P1,12),pw3[3]=PKW(P1,14), pw3); \
    l_reg+=sacc; \
    if(GK){DMA_K((t)+3,sl_cur);} if(GV){DMA_V((t)+1,sl_next);} \
    CMASK(C0,C1,t); \
    SBAR(); \
    GAPB(o[0]=__builtin_amdgcn_mfma_f32_32x32x16_bf16(PAF(0),VFR(0),o[0],0,0,0), C0,0); \
    GAPB(o[1]=__builtin_amdgcn_mfma_f32_32x32x16_bf16(PAF(0),VFR(4),o[1],0,0,0), C0,4); \
    KRD(GL,0); GAPB(o[0]=__builtin_amdgcn_mfma_f32_32x32x16_bf16(PAF(1),VFR(1),o[0],0,0,0), C0,8); \
    KRD(GL,1); GAPB(o[1]=__builtin_amdgcn_mfma_f32_32x32x16_bf16(PAF(1),VFR(5),o[1],0,0,0), C0,12); \
    KRD(GL,2); GAPB(o[0]=__builtin_amdgcn_mfma_f32_32x32x16_bf16(PAF(2),VFR(2),o[0],0,0,0), C1,0); \
    KRD(GL,3); GAPB(o[1]=__builtin_amdgcn_mfma_f32_32x32x16_bf16(PAF(2),VFR(6),o[1],0,0,0), C1,4); \
    GAPB(o[0]=__builtin_amdgcn_mfma_f32_32x32x16_bf16(PAF(3),VFR(3),o[0],0,0,0), C1,8); \
    GAPB(o[1]=__builtin_amdgcn_mfma_f32_32x32x16_bf16(PAF(3),VFR(7),o[1],0,0,0), C1,12); \
    }while(0)
  int t=1;
  #undef CMASK
  #define CMASK(P0,P1,t) do{}while(0)
  for(;t+5<NT;t+=2){
    STEP(pB0,pB1,pA0,pA1,t,true,true,true);     WAIT_BAR(2); ROT();
    STEP(pA0,pA1,pB0,pB1,t+1,true,true,true);   WAIT_BAR(2); ROT();
  }
  #undef CMASK
  #define CMASK(P0,P1,t) do{int jb_=(t)-(NT-4); if(jb_>=0)cmask(P0,P1,jb_,qrel,hi);}while(0)
  #define ENDW(tt) do{ if((tt)+3<NT){WAIT_BAR(2);} else if((tt)+2<NT){WAIT_BAR(1);} else {WAIT_BAR(0);} }while(0)
  for(;t+1<NT;t+=2){
    STEP(pB0,pB1,pA0,pA1,t,(t+3<NT),(t+1<NT),(t+1<NT));       ENDW(t);   ROT();
    STEP(pA0,pA1,pB0,pB1,t+1,(t+4<NT),(t+2<NT),(t+2<NT));     ENDW(t+1); ROT();
  }
  STEP(pB0,pB1,pA0,pA1,NT-1,false,false,false);
  u32x4 sgv[4]; { const bf16*SGw=SG+(rowbase+q0+wid*QBLK)*DM+h*D;
    #pragma unroll
    for(int i=0;i<4;++i) sgv[i]=*(const u32x4*)(SGw+(long)(i*8+(lane>>3))*DM+(lane&7)*8); }
  SBAR();
  { float sacc=pB0[0]+pB0[1]; _Pragma("unroll") for(int r=2;r<16;++r)sacc+=pB0[r]; _Pragma("unroll") for(int r=0;r<16;++r)sacc+=pB1[r]; l_reg+=sacc;
    pw0=(u32x4){PKW(pB0,0),PKW(pB0,2),PKW(pB0,4),PKW(pB0,6)};pw1=(u32x4){PKW(pB0,8),PKW(pB0,10),PKW(pB0,12),PKW(pB0,14)};pw2=(u32x4){PKW(pB1,0),PKW(pB1,2),PKW(pB1,4),PKW(pB1,6)};pw3=(u32x4){PKW(pB1,8),PKW(pB1,10),PKW(pB1,12),PKW(pB1,14)};
    SBAR(); pv(o,vb0+sl_cur,PAF(0),PAF(1),PAF(2),PAF(3)); }
  asm volatile("s_waitcnt lgkmcnt(0)\n\ts_barrier":::"memory");
  if(nxt){DMA_K(0,0);DMA_V(0,0);DMA_K(1,SLOTB);DMA_K(2,2*SLOTB);}
  #undef PKW
  #undef PAF
  #undef VFR
  #undef PIN
  #undef MX3
  #undef GAPA
  #undef GAPB
  #undef EX
  #undef VRD
  #undef KRD
  #undef STEP
  #undef ENDW
  {auto rr=__builtin_amdgcn_permlane32_swap(__float_as_uint(l_reg),__float_as_uint(l_reg),false,false);l_reg=__uint_as_float(rr[0])+__uint_as_float(rr[1]);}
  if(hi==0)wsf[32+r32]=l_reg;asm volatile("s_waitcnt lgkmcnt(0)":::"memory");
  float rli[16];
  #pragma unroll
  for(int r=0;r<16;++r)rli[r]=__builtin_amdgcn_rcpf(wsf[32+crow(r,hi)]);
  bf16*Ow=O+(rowbase+q0+wid*QBLK)*DM+h*D;
  { bf16*stg=(bf16*)(shm+LDS_OST)+wid*2048;
    #pragma unroll
    for(int r=0;r<16;++r){const int orow=crow(r,hi);
      #pragma unroll
      for(int d0=0;d0<2;++d0)stg[orow*64+d0*32+r32]=__float2bfloat16(o[d0][r]*rli[r]);}
    asm volatile("s_waitcnt lgkmcnt(0)":::"memory");
    #pragma unroll
    for(int i=0;i<4;++i){const int row=i*8+(lane>>3),ch=lane&7; u32x4 v=*(const u32x4*)(stg+row*64+ch*8); const u32x4 g=sgv[i];
      #pragma unroll
      for(int e=0;e<4;++e){ const float lo=__uint_as_float(v[e]<<16)*__uint_as_float(g[e]<<16), hh=__uint_as_float(v[e]&0xffff0000u)*__uint_as_float(g[e]&0xffff0000u); v[e]=cvtpk_s(lo,hh); }
      ATTN_STORE16(Ow+(long)row*DM+ch*8,v);} }
  asm volatile("s_waitcnt lgkmcnt(0)":::"memory");
  #undef DMA_K
  #undef DMA_V
  #undef CMASK
  #undef ROT
}
constexpr int ATTN_LDS_BYTES=LDS_BYTES;
struct AttnTensors { const bf16* Q; const bf16* K; const bf16* V; const bf16* SG; bf16* O; const float* cumloc; const float* ctot; const float* qg; const float* kg; };
struct AttnUnit { int bh; int qb; };
struct StaticOrder {
  int vcu, G;
  __device__ __forceinline__ explicit StaticOrder(int grid,int block):vcu((grid%8==0)?(block%8)*(grid/8)+block/8:block),G(grid){}
  __device__ __forceinline__ bool next(int i,AttnUnit&u)const{
    if(G==256){ if(i>=4)return false; const int s=vcu&1; u.bh=vcu>>1; u.qb=(i==0)?s:(i==1)?7-s:(i==2)?3-s:4+s; return true; }
    const int id=vcu+i*G; if(id>=BATCH*NHEAD*NQB)return false; u.bh=id/NQB; u.qb=id%NQB; return true; }
  __device__ __forceinline__ void a_ready(const AttnUnit&)const{}
  __device__ __forceinline__ void done(const AttnUnit&)const{}
};
template<class Sched,int THRL=8> __device__ __forceinline__ void attn_phase(char*lds,const AttnTensors&T,const Sched&S,const int tid){
  AttnUnit u,un; int cur_bh=-1; bool pre=false; bool has=S.next(0,u);
  float bref; { float gq=fabsf(T.qg[tid&63]),gk=fabsf(T.kg[tid&63]);
    #pragma unroll
    for(int o=1;o<64;o<<=1){ gq=fmaxf(gq,__shfl_xor(gq,o)); gk=fmaxf(gk,__shfl_xor(gk,o)); }
    bref=8.0f*1.4426950408889634f*gq*gk+1.0f; }
  for(int i=0;has;++i){ S.a_ready(u); const bool hasn=S.next(i+1,un); const bool nxt=hasn&&un.bh==u.bh;
    if(u.bh!=cur_bh){ cur_bh=u.bh;
      int tq=tid; asm volatile("":"+v"(tq));
      const int b_=u.bh/NHEAD,h_=u.bh%NHEAD,l_=tq&31,c_=tq>>4;
      float v=T.ctot[(size_t)(b_*(SEQ/64)+l_)*16+h_];
      #pragma unroll
      for(int o=1;o<32;o<<=1){ const float nn=__shfl_up(v,o,32); if(l_>=o)v+=nn; }
      const float pre=__shfl(v,(c_+31)&31,32); const float base=(c_==0)?0.f:pre;
      const f32x4_t cl=*(const f32x4_t*)(T.cumloc+((size_t)u.bh)*SEQ+4*tq);
      { u32x4 w0,w1; unsigned h_,m_,l_;
        split3(-(cl[0]+base),h_,m_,l_); w0[0]=h_|(m_<<16); w0[1]=l_|0xBF800000u; split3(-(cl[1]+base),h_,m_,l_); w0[2]=h_|(m_<<16); w0[3]=l_|0xBF800000u;
        split3(-(cl[2]+base),h_,m_,l_); w1[0]=h_|(m_<<16); w1[1]=l_|0xBF800000u; split3(-(cl[3]+base),h_,m_,l_); w1[2]=h_|(m_<<16); w1[3]=l_|0xBF800000u;
        *(u32x4*)(lds+LDS_CK+32*tq)=w0; *(u32x4*)(lds+LDS_CK+32*tq+16)=w1; }
      asm volatile("s_waitcnt vmcnt(0) lgkmcnt(0)\n\ts_barrier":::"memory"); }
    attn_unit<THRL>(u.bh/NHEAD,u.bh%NHEAD,u.qb,T.Q,T.K,T.V,T.SG,T.O,lds,tid,pre,nxt,bref); S.done(u); pre=nxt; u=un; has=hasn; }
}
#undef SBAR
#undef WAIT_BAR
}
#define LAS __attribute__((address_space(3)))
typedef unsigned short bf16_t;
typedef short bf16x8_t __attribute__((ext_vector_type(8)));
typedef float f32x4 __attribute__((ext_vector_type(4)));
typedef float f32x2 __attribute__((ext_vector_type(2)));
typedef unsigned u32x4 __attribute__((ext_vector_type(4)));
constexpr int NWAVES = 8;
constexpr int RING_BYTES = 131072, LDS_BYTES = 147456, MISC_OFF = LDS_BYTES - 256;
static_assert(attn_body::LDS_BYTES <= RING_BYTES, "attention scratch must fit the ring region");
constexpr size_t MiB = 1u << 20;
constexpr size_t WS_P = 1 * MiB, WS_CUMLOC = 2 * MiB, WS_CTOT = 3 * MiB, WS_SSM = 4 * MiB, WS_W = 16 * MiB, WS_HB = 52 * MiB;
constexpr size_t WS_B1 = 84 * MiB, WS_B2 = 116 * MiB, WS_B3 = 148 * MiB, WS_B4 = 180 * MiB, WS_Y = 212 * MiB, WS_END = 244 * MiB;
constexpr int W_C0IN = 0, W_C0OUT = 3072, W_FIN = 4096, W_FF = 8192, W_FOUT = 8448, W_SIN = 9472, W_SGLU = 11520, W_SOUT = 12544, W_C1IN = 13568, W_C1OUT = 16640, W_ROWS = 17664;
static_assert(WS_W + (size_t)W_ROWS * 2048 <= WS_HB, "weights fit");

__device__ __forceinline__ unsigned f2bf_(float f) { unsigned u = __builtin_bit_cast(unsigned, f); return (u + 0x7fffu + ((u >> 16) & 1u)) >> 16; }
__device__ __forceinline__ unsigned pk2(float lo, float hi) { return f2bf_(lo) | (f2bf_(hi) << 16); }
__device__ __forceinline__ float wave_sum(float v) {
#pragma unroll
    for (int o = 1; o < 64; o <<= 1) v += __shfl_xor(v, o);
    return v;
}
#define GAS __attribute__((address_space(1)))
#define RLX_AGENT __ATOMIC_RELAXED, __HIP_MEMORY_SCOPE_AGENT
#define LDS_WAIT() asm volatile("s_waitcnt lgkmcnt(0)" ::: "memory")
#define VM_WAIT() asm volatile("s_waitcnt vmcnt(0)" ::: "memory")
#define XB_TMO      128
#define XB_XCNT(j)  (256  + 64 * (j))
#define XB_XSUB(j)  (1280 + 64 * (j))
#define XB_XGEN(j)  (2304 + 64 * (j))
#define XB_TOP      3328
#define XB_TOPGEN   3392
#define XCD_BAR_WORDS 3456
#define XB_SPIN_CAP (1u << 18)

__device__ __forceinline__ unsigned xb_ld(unsigned* p)              { return __hip_atomic_load(p, __ATOMIC_RELAXED, __HIP_MEMORY_SCOPE_AGENT); }
__device__ __forceinline__ unsigned xb_add(unsigned* p, unsigned v) { return __hip_atomic_fetch_add(p, v, __ATOMIC_RELAXED, __HIP_MEMORY_SCOPE_AGENT); }
__device__ __forceinline__ unsigned xb_xcc_id() { return (unsigned)__builtin_amdgcn_s_getreg((3 << 11) | 20) & 0xFu; }
#define XB_SPIN(cond, bar) do { unsigned _sp = 0; while (cond) { __builtin_amdgcn_s_sleep(1); \
    if ((++_sp & 255u) == 0u) { if (xb_ld(&(bar)[XB_TMO])) break; if (_sp > XB_SPIN_CAP) { atomicAdd(&(bar)[XB_TMO], 1u); break; } } } } while (0)

struct XcdBarrier {
    unsigned* bar; unsigned x;
    volatile LAS unsigned* st;
};

__device__ __forceinline__ XcdBarrier xcd_barrier_post(unsigned* bar, volatile LAS unsigned* st, const int tid) {
    XcdBarrier b; b.bar = bar; b.x = xb_xcc_id(); b.st = st;
    if (tid == 0) (void)xb_add(&bar[XB_XCNT(b.x)], 1u);
    return b;
}
__device__ __forceinline__ void xcd_barrier_complete(unsigned* bar, unsigned x, unsigned& nloc, unsigned& nx) {
    const unsigned G = gridDim.x * gridDim.y * gridDim.z;
    unsigned sum, cnt, mine, sp = 0u;
    for (;;) {
        sum = 0u; cnt = 0u; mine = 0u;
#pragma unroll
        for (unsigned j = 0; j < 16; ++j) { const unsigned c = xb_ld(&bar[XB_XCNT(j)]); sum += c; cnt += (c > 0u) ? 1u : 0u; mine = (j == x) ? c : mine; }
        if (sum == G) break;
        __builtin_amdgcn_s_sleep(1);
        if ((++sp & 255u) == 0u) { if (xb_ld(&bar[XB_TMO])) break; if (sp > XB_SPIN_CAP) { atomicAdd(&bar[XB_TMO], 1u); break; } }
    }
    nloc = mine > 0u ? mine : 1u; nx = cnt > 0u ? cnt : 1u;
}

__device__ __forceinline__ void xcd_barrier(const XcdBarrier& b, const int tid) {
    asm volatile("s_waitcnt vmcnt(0)" ::: "memory");
    __syncthreads();
    if (tid == 0) {
        unsigned* bar = b.bar;
        __builtin_amdgcn_s_waitcnt(0);
        unsigned nloc = b.st[0], nx = b.st[1];
        if (nloc == 0u) { xcd_barrier_complete(bar, b.x, nloc, nx); b.st[0] = nloc; b.st[1] = nx; }
        const unsigned old = xb_add(&bar[XB_XSUB(b.x)], 1u);
        const unsigned gen = old / nloc;
        if (old + 1u == (gen + 1u) * nloc) {
            __builtin_amdgcn_fence(__ATOMIC_RELEASE, "agent");
            asm volatile("s_waitcnt vmcnt(0)" ::: "memory");
            const unsigned og = xb_add(&bar[XB_TOP], 1u);
            const unsigned tg = og / nx;
            if (og + 1u == (tg + 1u) * nx) xb_add(&bar[XB_TOPGEN], 1u);
            else XB_SPIN(xb_ld(&bar[XB_TOPGEN]) == tg, bar);
            __builtin_amdgcn_fence(__ATOMIC_ACQUIRE, "agent");
            xb_add(&bar[XB_XGEN(b.x)], 1u);
            asm volatile("s_waitcnt vmcnt(0)" ::: "memory");
        } else {
            XB_SPIN(xb_ld(&bar[XB_XGEN(b.x)]) == gen, bar);
            __builtin_amdgcn_fence(__ATOMIC_ACQUIRE, "agent");
            asm volatile("s_waitcnt vmcnt(0)" ::: "memory");
        }
    }
    __syncthreads();
}

__device__ __forceinline__ int lane_id_fresh() { int r; asm volatile("v_mbcnt_lo_u32_b32 %0, -1, 0\n\tv_mbcnt_hi_u32_b32 %0, -1, %0" : "=v"(r)); return r; }
struct Args { const float* in[25]; float* out; unsigned char* ws; int ph_lo, ph_hi; };

__device__ __forceinline__ int dst_row32(int s, int mode) {
    if (mode == 1) { if (s < 1024) return 256 * (s >> 7) + (s & 127); if (s < 2048) { const int t = s - 1024; return 256 * (t >> 7) + 128 + (t & 127); } return s; }
    if (mode == 2) { const int sec = s >> 10, hd = (s & 1023) >> 6, bj = (s & 63) >> 5, e = s & 31; return 1024 * sec + 256 * (hd >> 2) + 128 * bj + 32 * (hd & 3) + e; }
    return s;
}
__device__ __forceinline__ void p0_transpose_item(const float* W, int ldw, int N, const float* gain, bf16_t* WT, int mode, int item, int lane) {
    const int nblk = N / 64, kb = item / nblk, nb = item % nblk, k0 = 64 * kb, n0 = 64 * nb, q = lane >> 4, nn = lane & 15;
    f32x4 v[16]; f32x4 gk[4];
    const float* src = W + (size_t)(k0 + 16 * q) * ldw + n0 + 4 * nn;
#pragma unroll
    for (int i = 0; i < 16; ++i) v[i] = __builtin_nontemporal_load((const f32x4*)(src + (size_t)i * ldw));
#pragma unroll
    for (int i = 0; i < 4; ++i) gk[i] = (f32x4){1.f, 1.f, 1.f, 1.f};
    if (gain) {
#pragma unroll
        for (int i = 0; i < 4; ++i) gk[i] = *(const f32x4*)(gain + k0 + 16 * q + 4 * i);
    }
#pragma unroll
    for (int i = 0; i < 16; ++i) v[i] = v[i] * gk[i >> 2][i & 3];
#pragma unroll
    for (int e = 0; e < 4; ++e) { const int n = 4 * nn + e, r = dst_row32(n0 + (n & 32), mode) + (n & 31); bf16_t* d = WT + (size_t)r * 1024 + k0 + 16 * q;
#pragma unroll
        for (int h = 0; h < 2; ++h) { u32x4 o; o.x = pk2(v[8 * h][e], v[8 * h + 1][e]); o.y = pk2(v[8 * h + 2][e], v[8 * h + 3][e]); o.z = pk2(v[8 * h + 4][e], v[8 * h + 5][e]); o.w = pk2(v[8 * h + 6][e], v[8 * h + 7][e]);
            *(u32x4*)(d + 8 * h) = o; } }
}
__device__ __forceinline__ void p0_prologue(const Args& a, LAS unsigned char* lds, int vcu, int G, const int tid) {
    const int lane = tid & 63, wave = __builtin_amdgcn_readfirstlane(tid >> 6);
    const int gw = vcu * NWAVES + wave, NGW = G * NWAVES;
    bf16_t* WB = (bf16_t*)(a.ws + WS_W);
    const float* ng = a.in[1];
    constexpr int I3072 = 16 * 3072 / 64, I1024 = 16 * 1024 / 64, I4096 = 16 * 4096 / 64, I2048 = 16 * 2048 / 64;
    constexpr int NITEMS = 2 * I3072 + 5 * I1024 + I4096 + I2048;
    const int nfull = NITEMS / NGW, nloop = nfull + ((NITEMS - nfull * NGW) + G * NWAVES - 1) / (G * NWAVES);
    for (int k = 0; k < nloop; ++k) {
        const int it = k < nfull ? k * NGW + gw : nfull * NGW + (k - nfull) * NGW + vcu + G * wave;
        if (it >= NITEMS) continue;
        int r = it;
        if (r < I3072) { p0_transpose_item(a.in[2], 3072, 3072, ng, WB + (size_t)W_C0IN * 1024, 1, r, lane); continue; } r -= I3072;
        if (r < I1024) { p0_transpose_item(a.in[7], 1024, 1024, nullptr, WB + (size_t)W_C0OUT * 1024, 0, r, lane); continue; } r -= I1024;
        if (r < I4096) { p0_transpose_item(a.in[8], 4112, 4096, ng + 1024, WB + (size_t)W_FIN * 1024, 2, r, lane); continue; } r -= I4096;
        if (r < I1024) { p0_transpose_item(a.in[12], 1024, 1024, nullptr, WB + (size_t)W_FOUT * 1024, 0, r, lane); continue; } r -= I1024;
        if (r < I2048) { p0_transpose_item(a.in[13], 2048, 2048, ng + 2048, WB + (size_t)W_SIN * 1024, 0, r, lane); continue; } r -= I2048;
        if (r < I1024) { p0_transpose_item(a.in[22], 1024, 1024, nullptr, WB + (size_t)W_SGLU * 1024, 0, r, lane); continue; } r -= I1024;
        if (r < I1024) { p0_transpose_item(a.in[24], 1024, 1024, nullptr, WB + (size_t)W_SOUT * 1024, 0, r, lane); continue; } r -= I1024;
        if (r < I3072) { p0_transpose_item(a.in[2] + (size_t)1024 * 3072, 3072, 3072, ng + 3072, WB + (size_t)W_C1IN * 1024, 1, r, lane); continue; } r -= I3072;
        p0_transpose_item(a.in[7] + (size_t)1024 * 1024, 1024, 1024, nullptr, WB + (size_t)W_C1OUT * 1024, 0, r, lane);
    }
    for (int e = vcu * 512 + tid; e < 16 * 1024; e += G * 512) { const int n = e >> 10, k = e & 1023; WB[(size_t)(W_FF + n) * 1024 + k] = (bf16_t)f2bf_(a.in[8][(size_t)k * 4112 + 4096 + n] * ng[1024 + k]); }
    bf16_t* hb = (bf16_t*)(a.ws + WS_HB); float* P = (float*)(a.ws + WS_P);
    for (int m0 = 4 * gw; m0 < MTOK; m0 += 4 * NGW) {
        f32x4 v[4][4];
#pragma unroll
        for (int r = 0; r < 4; ++r)
#pragma unroll
            for (int j = 0; j < 4; ++j) v[r][j] = __builtin_nontemporal_load(((const f32x4*)(a.in[0] + (size_t)(m0 + r) * 1024)) + lane + 64 * j);
#pragma unroll
        for (int r = 0; r < 4; ++r) { float s = 0.f; unsigned long long* o8 = (unsigned long long*)(hb + (size_t)(m0 + r) * 1024) + lane;
#pragma unroll
            for (int j = 0; j < 4; ++j) { const f32x4 x = v[r][j]; s += (x[0] * x[0] + x[1] * x[1]) + (x[2] * x[2] + x[3] * x[3]);
                o8[64 * j] = (unsigned long long)pk2(x[0], x[1]) | ((unsigned long long)pk2(x[2], x[3]) << 32); }
            s = wave_sum(s);
            if (lane < 4) ((f32x4*)(P + (size_t)(m0 + r) * 16))[lane] = (f32x4){lane == 0 ? s : 0.f, 0.f, 0.f, 0.f}; }
    }
}
__device__ __forceinline__ void conv_phase(LAS unsigned char* lds, const bf16_t* U, const bf16_t* SG, const float* cw, const float* cb, const float* lg, const float* lb, bf16_t* Y, int vcu, int G, const int tid) {
    const int lane = tid & 63, wave = __builtin_amdgcn_readfirstlane(tid >> 6);
    f32x2 w[CONV_K];
#pragma unroll
    for (int j = 0; j < CONV_K; ++j) w[j] = *(const f32x2*)(cw + (size_t)j * 1024 + 2 * tid);
    const f32x2 bias = *(const f32x2*)(cb + 2 * tid);
    LAS float* tile = (LAS float*)lds;
    for (int unit = vcu; unit < MTOK / 32; unit += G) {
        const int t0 = unit * 32, seq0 = t0 & ~(SEQ - 1);

        f32x2 out[32];
#pragma unroll
        for (int tt = 0; tt < 32; ++tt) out[tt] = bias;
#pragma unroll
        for (int i = 0; i < 62; ++i) {
            const int row = t0 - 30 + i, rowc = row < seq0 ? seq0 : row;
            const unsigned raw = *(const unsigned*)(U + (size_t)rowc * 1024 + 2 * tid);
            f32x2 uv; uv.x = __uint_as_float(raw << 16); uv.y = __uint_as_float(raw & 0xffff0000u);
            if (row < seq0) uv = (f32x2){0.f, 0.f};
#pragma unroll
            for (int tt = (i > 30 ? i - 30 : 0); tt <= (i < 31 ? i : 31); ++tt) out[tt] += w[i - tt] * uv;
        }
#pragma unroll
        for (int tt = 0; tt < 32; ++tt) *(LAS f32x2*)(tile + tt * 1024 + 2 * tid) = out[tt];
        __syncthreads();
        {
            u32x4 sgv[4][2]; f32x4 gg[4], bbv[4];
#pragma unroll
            for (int q = 0; q < 4; ++q)
#pragma unroll
                for (int hf = 0; hf < 2; ++hf) sgv[q][hf] = __builtin_nontemporal_load((const u32x4*)(SG + (size_t)(t0 + wave * 4 + q) * 1024 + 8 * lane + 512 * hf));
#pragma unroll
            for (int hf = 0; hf < 2; ++hf) { gg[2 * hf] = *(const f32x4*)(lg + 8 * lane + 512 * hf); gg[2 * hf + 1] = *(const f32x4*)(lg + 8 * lane + 512 * hf + 4);
                bbv[2 * hf] = *(const f32x4*)(lb + 8 * lane + 512 * hf); bbv[2 * hf + 1] = *(const f32x4*)(lb + 8 * lane + 512 * hf + 4); }
            f32x4 v[4][4]; float s1[4], s2[4];
#pragma unroll
            for (int q = 0; q < 4; ++q) { const LAS float* tr = tile + (wave * 4 + q) * 1024 + 8 * lane;
                v[q][0] = *(const LAS f32x4*)(tr); v[q][1] = *(const LAS f32x4*)(tr + 4); v[q][2] = *(const LAS f32x4*)(tr + 512); v[q][3] = *(const LAS f32x4*)(tr + 516);
                s1[q] = 0.f; s2[q] = 0.f;
#pragma unroll
                for (int j = 0; j < 4; ++j) { s1[q] += (v[q][j][0] + v[q][j][1]) + (v[q][j][2] + v[q][j][3]); s2[q] += (v[q][j][0] * v[q][j][0] + v[q][j][1] * v[q][j][1]) + (v[q][j][2] * v[q][j][2] + v[q][j][3] * v[q][j][3]); } }
#pragma unroll
            for (int o = 1; o < 64; o <<= 1)
#pragma unroll
                for (int q = 0; q < 4; ++q) { s1[q] += __shfl_xor(s1[q], o); s2[q] += __shfl_xor(s2[q], o); }
#pragma unroll
            for (int q = 0; q < 4; ++q) {
                const float mu = s1[q] * (1.0f / 1024.0f), var = fmaxf(s2[q] * (1.0f / 1024.0f) - mu * mu, 0.f), rstd = rsqrtf(var + LN_EPS);
                const size_t off = (size_t)(t0 + wave * 4 + q) * 1024 + 8 * lane;
#pragma unroll
                for (int hf = 0; hf < 2; ++hf) { const u32x4 sg = sgv[q][hf];
                    const f32x4 y0 = (v[q][2 * hf] - mu) * rstd * gg[2 * hf] + bbv[2 * hf], y1 = (v[q][2 * hf + 1] - mu) * rstd * gg[2 * hf + 1] + bbv[2 * hf + 1]; u32x4 o;
                    o.x = pg8::cvt_pk_bf16(pg8::silu(y0[0]) * pg8::bflo(sg.x), pg8::silu(y0[1]) * pg8::bfhi(sg.x));
                    o.y = pg8::cvt_pk_bf16(pg8::silu(y0[2]) * pg8::bflo(sg.y), pg8::silu(y0[3]) * pg8::bfhi(sg.y));
                    o.z = pg8::cvt_pk_bf16(pg8::silu(y1[0]) * pg8::bflo(sg.z), pg8::silu(y1[1]) * pg8::bfhi(sg.z));
                    o.w = pg8::cvt_pk_bf16(pg8::silu(y1[2]) * pg8::bflo(sg.w), pg8::silu(y1[3]) * pg8::bfhi(sg.w));
                    *(u32x4*)(Y + off + 512 * hf) = o; }
            }
        }
        __syncthreads();
    }
}
__device__ __forceinline__ void fcum_phase(LAS unsigned char* lds, const bf16_t* hb, const bf16_t* Wf, const float* P, const float* fbias, float* cumloc, float* ctot, int vcu, int G, const int tid) {
    const int lane = tid & 63, wave = __builtin_amdgcn_readfirstlane(tid >> 6);
    LAS float* part = (LAS float*)lds;
    LAS float* lf = part + 2 * 64 * 17;
    for (int ch = vcu; ch < MTOK / 64; ch += G) {
        f32x4 pq[2][4];
#pragma unroll
        for (int e = 0; e < 2; ++e) { const f32x4* pp = (const f32x4*)(P + (size_t)(ch * 64 + ((tid + 512 * e) >> 4)) * 16); pq[e][0] = pp[0]; pq[e][1] = pp[1]; pq[e][2] = pp[2]; pq[e][3] = pp[3]; }
        {
            const int tg = wave & 3, kh = wave >> 2, tok0 = ch * 64 + tg * 16;
            const bf16_t* ap = hb + (size_t)(tok0 + (lane & 15)) * 1024 + kh * 512 + 8 * (lane >> 4);
            const bf16_t* bp = Wf + (size_t)(lane & 15) * 1024 + kh * 512 + 8 * (lane >> 4);
            bf16x8_t av[16], bv[16];
#pragma unroll
            for (int ks = 0; ks < 16; ++ks) { av[ks] = *(const bf16x8_t*)(ap + ks * 32); bv[ks] = *(const bf16x8_t*)(bp + ks * 32); }
            f32x4 acc = (f32x4){0.f, 0.f, 0.f, 0.f};
#pragma unroll
            for (int ks = 0; ks < 16; ++ks) acc = __builtin_amdgcn_mfma_f32_16x16x32_bf16(av[ks], bv[ks], acc, 0, 0, 0);
#pragma unroll
            for (int r = 0; r < 4; ++r) part[(kh * 64 + tg * 16 + 4 * (lane >> 4) + r) * 17 + (lane & 15)] = acc[r];
        }
        __syncthreads();
#pragma unroll
        for (int e = 0; e < 2; ++e) {
            const int idx = tid + 512 * e, tl = idx >> 4, h = idx & 15;
            const f32x4 p0 = pq[e][0], p1 = pq[e][1], p2 = pq[e][2], p3 = pq[e][3];
            const float ss = ((p0[0] + p0[1]) + (p0[2] + p0[3])) + ((p1[0] + p1[1]) + (p1[2] + p1[3])) + ((p2[0] + p2[1]) + (p2[2] + p2[3])) + ((p3[0] + p3[1]) + (p3[2] + p3[3]));
            const float x = (part[tl * 17 + h] + part[(64 + tl) * 17 + h]) * rsqrtf(ss * (1.0f / 1024.0f) + RMS_EPS) + fbias[h];
            lf[tl * 17 + h] = (fminf(x, 0.f) - log1pf(__expf(-fabsf(x)))) * LOG2E; }
        __syncthreads();
#pragma unroll
        for (int e = 0; e < 2; ++e) {
            const int h = 2 * wave + e; float c = lf[lane * 17 + h];
#pragma unroll
            for (int o = 1; o < 64; o <<= 1) { const float nn = __shfl_up(c, o); if (lane >= o) c += nn; }
            const int b = ch / (SEQ / 64), cc = ch % (SEQ / 64);
            cumloc[((size_t)(b * NHEADS + h)) * SEQ + cc * 64 + lane] = c;
            if (lane == 63) ctot[(size_t)ch * 16 + h] = c; }
        __syncthreads();
    }
}
constexpr int SSM_OFF_BM = 0, SSM_OFF_PW = 65536, SSM_OFF_KT = SSM_OFF_PW + 2560, SSM_OFF_CM = SSM_OFF_KT + 8704, SSM_GS = SSM_OFF_CM + 65536;
constexpr size_t WS_SSM_PN = 13 * MiB;
static_assert(WS_SSM + (size_t)NGRP * SSM_GS <= WS_SSM_PN && SSM_GS <= MISC_OFF, "ssm tables");

__device__ __forceinline__ f32x4 cmul2(const f32x4 a, const f32x4 x) { return (f32x4){a[0] * x[0] - a[1] * x[1], a[0] * x[1] + a[1] * x[0], a[2] * x[2] - a[3] * x[3], a[2] * x[3] + a[3] * x[2]}; }
template <int CTRL> __device__ __forceinline__ float dpp_f(float v) { return __builtin_bit_cast(float, __builtin_amdgcn_update_dpp(0, __builtin_bit_cast(int, v), CTRL, 0xf, 0xf, true)); }
template <int CTRL> __device__ __forceinline__ f32x4 dpp4(const f32x4 v) { return (f32x4){dpp_f<CTRL>(v[0]), dpp_f<CTRL>(v[1]), dpp_f<CTRL>(v[2]), dpp_f<CTRL>(v[3])}; }

__device__ __forceinline__ void ssm_tables(const Args& a, LAS unsigned char* lds, int vcu, int G, const int tid) {
    const float* log_dt = a.in[14]; const float* a_re = a.in[15]; const float* a_im = a.in[16]; const float* b_re = a.in[17]; const float* b_im = a.in[18];
    const float* c_re = a.in[19]; const float* c_im = a.in[20];
    LAS float* pw = (LAS float*)lds;
    LAS float* bb = pw + 17 * 64 * 2;
    LAS float* big = bb + 64 * 16 * 2;
    LAS float* cc = big + 21 * 64 * 2;
    for (int unit = vcu; unit < 4 * NGRP; unit += G) {
        const int g = unit >> 2, sub = unit & 3;
        __syncthreads();
        const double dt = exp((double)log_dt[g]);
        for (int job = tid; job < 38 * 64; job += 512) { const int li = job >> 6, p = job & 63;
            const int l = li < 17 ? li : (li < 22 ? (16 << (li - 17)) : 16 * (li - 22));
            const double are = a_re[g * 64 + p], aim = a_im[g * 64 + p];
            double ang = aim * dt * (double)l; ang -= 6.283185307179586 * rint(ang * 0.15915494309189535);
            const float mag = expf((float)(are * dt * (double)l)); float sn, cs; sincosf((float)ang, &sn, &cs);
            LAS float* d = li < 17 ? pw + (li * 64 + p) * 2 : big + ((li - 17) * 64 + p) * 2; d[0] = mag * cs; d[1] = mag * sn; }
        for (int job = tid; job < 1024; job += 512) { cc[job * 2] = c_re[(size_t)g * 1024 + job]; cc[job * 2 + 1] = c_im[(size_t)g * 1024 + job]; }
        for (int job = tid; job < 1024; job += 512) { const int p = job >> 4, c = job & 15;
            const float are = a_re[g * 64 + p], aim = a_im[g * 64 + p], x = are * (float)dt;
            double ang = (double)aim * dt; ang -= 6.283185307179586 * rint(ang * 0.15915494309189535);
            float sn, cs, sh, ch; sincosf((float)ang, &sn, &cs); sincosf(0.5f * (float)ang, &sh, &ch);
            const float em1 = expm1f(x), nr = em1 * cs - 2.0f * sh * sh, ni = (em1 + 1.0f) * sn, den = are * are + aim * aim;
            const float zr = (nr * are + ni * aim) / den, zi = (ni * are - nr * aim) / den;
            const float br = b_re[(size_t)(g * 64 + p) * 16 + c], bi = b_im[(size_t)(g * 64 + p) * 16 + c];
            bb[(p * 16 + c) * 2] = zr * br - zi * bi; bb[(p * 16 + c) * 2 + 1] = zr * bi + zi * br; }
        __syncthreads();
        unsigned char* gb = a.ws + WS_SSM + (size_t)g * SSM_GS;
        for (int job = tid; job < 1024; job += 512) {
            const int fl = job >> 6, l = job & 63, rt = 2 * sub + (fl >> 3), s = fl & 7, R = 16 * rt + (l & 15), p = R >> 1, part = R & 1, j = 2 * s + (l >> 5), c0 = 8 * ((l >> 4) & 1);
            const float pr = pw[((15 - j) * 64 + p) * 2], pi = pw[((15 - j) * 64 + p) * 2 + 1]; float v[8];
#pragma unroll
            for (int e = 0; e < 8; ++e) { const float xr = bb[(p * 16 + c0 + e) * 2], xi = bb[(p * 16 + c0 + e) * 2 + 1]; v[e] = part ? (pr * xi + pi * xr) : (pr * xr - pi * xi); }
            *(u32x4*)(gb + SSM_OFF_BM + ((rt * 8 + s) * 64 + l) * 16) = (u32x4){pk2(v[0], v[1]), pk2(v[2], v[3]), pk2(v[4], v[5]), pk2(v[6], v[7])}; }
        for (int job = tid; job < 1024; job += 512) {
            const int fl = job >> 6, l = job & 63, i = 4 * sub + (fl >> 2), s = fl & 3, c = l & 15, q = l >> 4; float v[8];
#pragma unroll
            for (int e = 0; e < 8; ++e) { const int R = 16 * (2 * s + (e >> 2)) + 4 * q + (e & 3), p = R >> 1, part = R & 1;
                const float cr = cc[(c * 64 + p) * 2], ci = cc[(c * 64 + p) * 2 + 1], pr = pw[((i + 1) * 64 + p) * 2], pi = pw[((i + 1) * 64 + p) * 2 + 1];
                v[e] = part ? -(cr * pi + ci * pr) : (cr * pr - ci * pi); }
            *(u32x4*)(gb + SSM_OFF_CM + ((i * 4 + s) * 64 + l) * 16) = (u32x4){pk2(v[0], v[1]), pk2(v[2], v[3]), pk2(v[4], v[5]), pk2(v[6], v[7])}; }
        for (int idx = sub + 4 * tid; idx < 17 * 256; idx += 2048) {
            const int lagi = idx >> 8, c = (idx >> 4) & 15, c2 = idx & 15; float acc = 0.f;
            if (lagi > 0)
#pragma unroll 16
            for (int p = 0; p < 64; ++p) { const float cr = cc[(c * 64 + p) * 2], ci = cc[(c * 64 + p) * 2 + 1], pr = pw[((lagi - 1) * 64 + p) * 2], pi = pw[((lagi - 1) * 64 + p) * 2 + 1];
                const float tr = cr * pr - ci * pi, ti = cr * pi + ci * pr; acc += tr * bb[(p * 16 + c2) * 2] - ti * bb[(p * 16 + c2) * 2 + 1]; }
            *(bf16_t*)(gb + SSM_OFF_KT + idx * 2) = (bf16_t)f2bf_(acc); }
        if (sub == 0) for (int job = tid; job < 21 * 32; job += 512) {
            const int d = job >> 5, rt = (job >> 2) & 7, q = job & 3, p0 = 8 * rt + 2 * q;
            const f32x4 v = (f32x4){big[(d * 64 + p0) * 2], big[(d * 64 + p0) * 2 + 1], big[(d * 64 + p0 + 1) * 2], big[(d * 64 + p0 + 1) * 2 + 1]};
            if (d < 5) *(f32x4*)(gb + SSM_OFF_PW + ((d * 8 + rt) * 4 + q) * 16) = v;
            else *(f32x4*)(a.ws + WS_SSM_PN + ((((size_t)g * 8 + rt) * 16 + (d - 5)) * 4 + q) * 16) = v; }
    }
}
constexpr int SSM_OFF_EX = SSM_GS;
static_assert(SSM_OFF_EX + 8 * 128 * 4 <= MISC_OFF, "ssm exchange area");
__device__ __forceinline__ void ssm_phase(LAS unsigned char* lds, unsigned char* ws, const bf16_t* U, const float* dsk, bf16_t* GO, int vcu, int G, const int tid) {
    const int lane = tid & 63, wave = __builtin_amdgcn_readfirstlane(tid >> 6), n = lane & 15, q = lane >> 4;
    for (int unit = vcu; unit < 4 * NGRP; unit += G) {
        const int g = unit >> 2, sub = unit & 3;
        __syncthreads();
        { const unsigned char* gb = ws + WS_SSM + (size_t)g * SSM_GS;
          constexpr int NFULL = SSM_GS / 8192, TAIL = SSM_GS - NFULL * 8192; u32x4 tv[NFULL + 1];
#pragma unroll
          for (int it = 0; it < NFULL; ++it) tv[it] = ((const u32x4*)(gb + it * 8192))[tid];
          tv[NFULL] = ((const u32x4*)(gb + NFULL * 8192))[tid < TAIL / 16 ? tid : 0];
#pragma unroll
          for (int it = 0; it < NFULL; ++it) ((LAS u32x4*)(lds + it * 8192))[tid] = tv[it];
          if (tid < TAIL / 16) ((LAS u32x4*)(lds + NFULL * 8192))[tid] = tv[NFULL]; }
        __syncthreads();
        const int pair = sub * 8 + wave, b = pair >> 2, seg = pair & 3;
        const LAS f32x4* PW = (const LAS f32x4*)(lds + SSM_OFF_PW);
        const f32x4* PN = (const f32x4*)(ws + WS_SSM_PN) + (size_t)g * 8 * 16 * 4;
#define A16(rt) (PW[(4 * 8 + (rt)) * 4 + QQ])
#define QQ q
        const int tokb = b * SEQ + seg * 512;
        const bf16_t* Ub = U + (size_t)tokb * 1024 + g * 16; bf16_t* Gb = GO + (size_t)tokb * 1024 + g * 16;
        unsigned uoff = (unsigned)((16 * n + (lane >> 5)) * 1024 + 8 * ((lane >> 4) & 1)), eoff = (unsigned)(16 * n * 1024 + 4 * q);
        f32x4 I0[8], I1[8];
        {
            bf16x8_t uf[8];
#pragma unroll
            for (int s = 0; s < 8; ++s) uf[s] = *(const bf16x8_t*)((Ub + (2 * s) * 1024) + uoff);
            bf16x8_t fa[2][8];
#pragma unroll
            for (int s = 0; s < 8; ++s) fa[0][s] = *(const LAS bf16x8_t*)(lds + SSM_OFF_BM + ((0 * 8 + s) * 64 + lane) * 16);
#pragma unroll
            for (int rt = 0; rt < 8; ++rt) { I0[rt] = (f32x4){0.f, 0.f, 0.f, 0.f};
                if (rt < 7) {
#pragma unroll
                    for (int s = 0; s < 8; ++s) fa[(rt + 1) & 1][s] = *(const LAS bf16x8_t*)(lds + SSM_OFF_BM + (((rt + 1) * 8 + s) * 64 + lane) * 16);
                }
                __builtin_amdgcn_sched_barrier(0);
#pragma unroll
                for (int s = 0; s < 8; ++s) I0[rt] = __builtin_amdgcn_mfma_f32_16x16x32_bf16(fa[rt & 1][s], uf[s], I0[rt], 0, 0, 0);
                __builtin_amdgcn_sched_barrier(0); }
#pragma unroll
            for (int s = 0; s < 8; ++s) uf[s] = *(const bf16x8_t*)((Ub + (256 + 2 * s) * 1024) + uoff);
#pragma unroll
            for (int s = 0; s < 8; ++s) fa[0][s] = *(const LAS bf16x8_t*)(lds + SSM_OFF_BM + ((0 * 8 + s) * 64 + lane) * 16);
#pragma unroll
            for (int rt = 0; rt < 8; ++rt) { I1[rt] = (f32x4){0.f, 0.f, 0.f, 0.f};
                if (rt < 7) {
#pragma unroll
                    for (int s = 0; s < 8; ++s) fa[(rt + 1) & 1][s] = *(const LAS bf16x8_t*)(lds + SSM_OFF_BM + (((rt + 1) * 8 + s) * 64 + lane) * 16);
                }
                __builtin_amdgcn_sched_barrier(0);
#pragma unroll
                for (int s = 0; s < 8; ++s) I1[rt] = __builtin_amdgcn_mfma_f32_16x16x32_bf16(fa[rt & 1][s], uf[s], I1[rt], 0, 0, 0);
                __builtin_amdgcn_sched_barrier(0); }
        }
#pragma unroll
        for (int rt = 0; rt < 8; ++rt) { const f32x4 an = PN[(rt * 16 + (15 - n)) * 4 + q];
            f32x4 t0 = cmul2(an, I0[rt]), t1 = cmul2(an, I1[rt]);
            t0 = t0 + dpp4<0x128>(t0); t0 = t0 + dpp4<0x124>(t0); t0 = t0 + dpp4<0x122>(t0); t0 = t0 + dpp4<0x121>(t0);
            t1 = t1 + dpp4<0x128>(t1); t1 = t1 + dpp4<0x124>(t1); t1 = t1 + dpp4<0x122>(t1); t1 = t1 + dpp4<0x121>(t1);
            const f32x4 e = cmul2(A16(rt), t0) + t1;
            if (n == 0) *(LAS f32x4*)(lds + SSM_OFF_EX + wave * 512 + (rt * 4 + q) * 16) = e; }
        __syncthreads();
#undef QQ
#define QQ qb_
        int tqb = tid; asm volatile("" : "+v"(tqb));
        const int laneb = tqb & 63, nb_ = laneb & 15, qb_ = laneb >> 4;
        unsigned uoffb = (unsigned)((16 * nb_ + (laneb >> 5)) * 1024 + 8 * ((laneb >> 4) & 1)), eoffb = (unsigned)(16 * nb_ * 1024 + 4 * qb_);
        f32x4 carry[8];
#pragma unroll
        for (int rt = 0; rt < 8; ++rt) carry[rt] = (f32x4){0.f, 0.f, 0.f, 0.f};
        for (int m = 0; m < seg; ++m) {
#pragma unroll
            for (int rt = 0; rt < 8; ++rt) { const f32x4 a16 = A16(rt); const f32x4 a32 = cmul2(a16, a16); const f32x4 e = *(const LAS f32x4*)(lds + SSM_OFF_EX + (wave - seg + m) * 512 + (rt * 4 + qb_) * 16);
                carry[rt] = cmul2(a32, carry[rt]) + e; }
        }
        __syncthreads();
        const f32x4 dv = *(const f32x4*)(dsk + g * 16 + 4 * qb_);
#pragma unroll
        for (int rt = 0; rt < 8; ++rt) *(LAS f32x4*)(lds + SSM_OFF_BM + wave * 8192 + (rt * 64 + laneb) * 16) = I1[rt];
#pragma unroll
        for (int batch = 0; batch < 2; ++batch) {
            f32x4 (&I)[8] = I0;
            asm volatile("" : "+v"(uoffb), "+v"(eoffb));
            if (batch == 1) {
#pragma unroll
                for (int rt = 0; rt < 8; ++rt) { I0[rt] = *(const LAS f32x4*)(lds + SSM_OFF_BM + wave * 8192 + (rt * 64 + laneb) * 16); carry[rt] = *(const LAS f32x4*)(lds + SSM_OFF_EX + wave * 512 + (rt * 4 + qb_) * 16); }
            }
#pragma unroll
            for (int rt = 0; rt < 8; ++rt) I[rt] = I[rt] + cmul2(PW[(0 * 8 + rt) * 4 + qb_], dpp4<0x111>(I[rt]));
#pragma unroll
            for (int rt = 0; rt < 8; ++rt) I[rt] = I[rt] + cmul2(PW[(1 * 8 + rt) * 4 + qb_], dpp4<0x112>(I[rt]));
#pragma unroll
            for (int rt = 0; rt < 8; ++rt) I[rt] = I[rt] + cmul2(PW[(2 * 8 + rt) * 4 + qb_], dpp4<0x114>(I[rt]));
#pragma unroll
            for (int rt = 0; rt < 8; ++rt) I[rt] = I[rt] + cmul2(PW[(3 * 8 + rt) * 4 + qb_], dpp4<0x118>(I[rt]));
            bf16x8_t sf[4];
#pragma unroll
            for (int s = 0; s < 4; ++s) {
                const f32x4 p0 = dpp4<0x111>(I[2 * s]) + cmul2(PN[((2 * s) * 16 + nb_) * 4 + qb_], carry[2 * s]);
                const f32x4 p1 = dpp4<0x111>(I[2 * s + 1]) + cmul2(PN[((2 * s + 1) * 16 + nb_) * 4 + qb_], carry[2 * s + 1]);
                const u32x4 w = (u32x4){pg8::cvt_pk_bf16(p0[0], p0[1]), pg8::cvt_pk_bf16(p0[2], p0[3]), pg8::cvt_pk_bf16(p1[0], p1[1]), pg8::cvt_pk_bf16(p1[2], p1[3])};
                sf[s] = __builtin_bit_cast(bf16x8_t, w);
            }
            if (batch == 0) {
#pragma unroll
                for (int rt = 0; rt < 8; ++rt) { const f32x4 last = (f32x4){__shfl(I[rt][0], 15, 16), __shfl(I[rt][1], 15, 16), __shfl(I[rt][2], 15, 16), __shfl(I[rt][3], 15, 16)};
                    const f32x4 cn = cmul2(A16(rt), carry[rt]) + last; if (nb_ == 0) *(LAS f32x4*)(lds + SSM_OFF_EX + wave * 512 + (rt * 4 + qb_) * 16) = cn; }
            }
            bf16x8_t uf[8];
#pragma unroll
            for (int s = 0; s < 8; ++s) uf[s] = *(const bf16x8_t*)((Ub + (batch * 256 + 2 * s) * 1024) + uoffb);
            uint2 uwv[16]; bf16x8_t fc[4], kt[16];
#define SSM_LDC(ii) do { _Pragma("unroll") for (int s = 0; s < 4; ++s) fc[s] = *(const LAS bf16x8_t*)(lds + SSM_OFF_CM + (((ii) * 4 + s) * 64 + laneb) * 16); } while (0)
#define SSM_LDK(f) (*(const LAS bf16x8_t*)(lds + SSM_OFF_KT + (((f) + 1 - (laneb >> 5)) * 256 + (laneb & 15) * 16 + 8 * ((laneb >> 4) & 1)) * 2))
#pragma unroll
            for (int i = 0; i < 4; ++i) uwv[i] = *(const uint2*)((Ub + (batch * 256 + i) * 1024) + eoffb);
            SSM_LDC(0); kt[0] = SSM_LDK(0);
#pragma unroll
            for (int i = 0; i < 16; ++i) {
                __builtin_amdgcn_sched_barrier(0);
                f32x4 acc = (f32x4){0.f, 0.f, 0.f, 0.f};
#pragma unroll
                for (int s = 0; s < 4; ++s) acc = __builtin_amdgcn_mfma_f32_16x16x32_bf16(fc[s], sf[s], acc, 0, 0, 0);
                __builtin_amdgcn_sched_barrier(0);
                if (i + 1 < 16) { SSM_LDC(i + 1); kt[i + 1] = SSM_LDK(i + 1); }
                if (i + 4 < 16) uwv[i + 4] = *(const uint2*)((Ub + (batch * 256 + i + 4) * 1024) + eoffb);
                __builtin_amdgcn_sched_barrier(0);
#pragma unroll
                for (int s = 0; s <= i / 2; ++s) acc = __builtin_amdgcn_mfma_f32_16x16x32_bf16(kt[i - 2 * s], uf[s], acc, 0, 0, 0);
                const uint2 uw = uwv[i];
                const float y[4] = {acc[0] + dv[0] * pg8::bflo(uw.x), acc[1] + dv[1] * pg8::bfhi(uw.x), acc[2] + dv[2] * pg8::bflo(uw.y), acc[3] + dv[3] * pg8::bfhi(uw.y)};
                float ge[4];
#pragma unroll
                for (int r = 0; r < 4; ++r) ge[r] = y[r] * pg8::sigm(1.5957691216057308f * (y[r] + 0.044715f * y[r] * y[r] * y[r]));
                *(uint2*)((Gb + (batch * 256 + i) * 1024) + eoffb) = make_uint2(pg8::cvt_pk_bf16(ge[0], ge[1]), pg8::cvt_pk_bf16(ge[2], ge[3]));
                __builtin_amdgcn_sched_barrier(0);
            }
#undef SSM_LDC
#undef SSM_LDK
        }
#undef A16
#undef QQ
    }
}

template <class Epi> __device__ __forceinline__ void run_gemm(LAS unsigned char* lds, const bf16_t* A, const bf16_t* Bt, int N, const Epi& E, int G, const int tid) {
    pg8::Gemm g{A, Bt, MTOK, N, 1024}; pg8::StaticOrder S; S.init(MTOK, N, G, (int)blockIdx.x);
    pg8::gemm_phase<Epi, pg8::StaticOrder, true, true>(lds, g, S, E, tid);
}
__global__ void __launch_bounds__(NWAVES * 64, 2) mega_fwd(Args args) {
    extern __shared__ __attribute__((aligned(16))) unsigned char lds_raw[];
    LAS unsigned char* lds = (LAS unsigned char*)lds_raw;
    const int G = gridDim.x, bx = blockIdx.x, vcu = (G % 8 == 0) ? (bx % 8) * (G / 8) + bx / 8 : bx;
    const int wave = __builtin_amdgcn_readfirstlane((int)threadIdx.x >> 6);
#define TID() (wave * 64 + lane_id_fresh())
    unsigned char* ws = args.ws;
    bf16_t* WB = (bf16_t*)(ws + WS_W); bf16_t* HB = (bf16_t*)(ws + WS_HB);
    bf16_t* B1 = (bf16_t*)(ws + WS_B1); bf16_t* B2 = (bf16_t*)(ws + WS_B2); bf16_t* B3 = (bf16_t*)(ws + WS_B3); bf16_t* B4 = (bf16_t*)(ws + WS_B4); bf16_t* YB = (bf16_t*)(ws + WS_Y);
    float* P = (float*)(ws + WS_P); float* cumloc = (float*)(ws + WS_CUMLOC); float* ctot = (float*)(ws + WS_CTOT);
    const int lo = args.ph_lo, hi = args.ph_hi;
#define IN(k) (lo <= (k) && (k) < hi)
    { const int t_ = TID(); if (t_ < 64) ((LAS unsigned*)(lds + MISC_OFF))[t_] = 0u; __syncthreads(); }
    XcdBarrier bar; bar.bar = (unsigned*)ws; bar.x = 0; bar.st = nullptr;
    if (hi - lo > 1) bar = xcd_barrier_post((unsigned*)ws, (volatile LAS unsigned*)(lds + MISC_OFF + 32), TID());
    if (lo < 0) cg::this_grid().sync();
#define SEAM(k) do { if (IN(k) && IN((k) + 1)) xcd_barrier(bar, TID()); } while (0)
    if (IN(0)) { p0_prologue(args, lds, vcu, G, TID()); ssm_tables(args, lds, vcu, G, TID()); } SEAM(0);
    if (IN(1)) { pg8::EpiConvIn E{P, B1, B2}; run_gemm(lds, HB, WB + (size_t)W_C0IN * 1024, 3072, E, G, TID()); } SEAM(1);
    if (IN(2)) { conv_phase(lds, B1, B2, args.in[3], args.in[4], args.in[5], args.in[6], YB, vcu, G, TID()); } SEAM(2);
    if (IN(3)) { pg8::EpiOut E{HB, P, args.out, 0}; run_gemm(lds, YB, WB + (size_t)W_C0OUT * 1024, 1024, E, G, TID()); } SEAM(3);
    if (IN(4)) { pg8::EpiFoxIn E{P, B1, B3, B4, B2, args.in[10], args.in[11]}; run_gemm(lds, HB, WB + (size_t)W_FIN * 1024, 4096, E, G, TID());
                 fcum_phase(lds, HB, WB + (size_t)W_FF * 1024, P, args.in[9], cumloc, ctot, vcu, G, TID()); } SEAM(4);
    if (IN(5)) { const attn_body::AttnTensors AT{(const attn_body::bf16*)B1, (const attn_body::bf16*)B3, (const attn_body::bf16*)B4, (const attn_body::bf16*)B2, (attn_body::bf16*)YB, cumloc, ctot, args.in[10], args.in[11]};
                 const attn_body::StaticOrder S(G, bx); attn_body::attn_phase<attn_body::StaticOrder>((char*)lds_raw, AT, S, TID()); } SEAM(5);
    if (IN(6)) { pg8::EpiOut E{HB, P, args.out, 0}; run_gemm(lds, YB, WB + (size_t)W_FOUT * 1024, 1024, E, G, TID()); } SEAM(6);
    if (IN(7)) { pg8::EpiSsmIn E{P, B1, B2}; run_gemm(lds, HB, WB + (size_t)W_SIN * 1024, 2048, E, G, TID()); } SEAM(7);
    if (IN(8)) { ssm_phase(lds, ws, B1, args.in[21], B3, vcu, G, TID()); } SEAM(8);
    if (IN(10)) { pg8::EpiGlu E{B3, B2, args.in[23], YB}; run_gemm(lds, B3, WB + (size_t)W_SGLU * 1024, 1024, E, G, TID()); } SEAM(10);
    if (IN(11)) { pg8::EpiOut E{HB, P, args.out, 0}; run_gemm(lds, YB, WB + (size_t)W_SOUT * 1024, 1024, E, G, TID()); } SEAM(11);
    if (IN(12)) { pg8::EpiConvIn E{P, B1, B2}; run_gemm(lds, HB, WB + (size_t)W_C1IN * 1024, 3072, E, G, TID()); } SEAM(12);
    if (IN(13)) { conv_phase(lds, B1, B2, args.in[3] + (size_t)CONV_K * 1024, args.in[4] + 1024, args.in[5] + 1024, args.in[6] + 1024, YB, vcu, G, TID()); } SEAM(13);
    if (IN(14)) { pg8::EpiOut E{HB, P, args.out, 1}; run_gemm(lds, YB, WB + (size_t)W_C1OUT * 1024, 1024, E, G, TID()); }
#undef IN
#undef SEAM
}

#ifndef MK_ONE_LAUNCH
#define MK_ONE_LAUNCH 1
#endif
constexpr int N_PHASES = 15;
extern "C" void kernel_launch(void* const* d_in, const int* in_sizes, int n_in, void* d_out, int out_size, void* d_ws, size_t ws_size, hipStream_t stream) {
    static int grid = 0;
    if (grid == 0) {
        if (n_in != 25 || out_size != MTOK * DMODEL || ws_size < WS_END) { fprintf(stderr, "kernel_launch: unexpected shapes (n_in %d, out %d, ws %zu)\n", n_in, out_size, ws_size); grid = -1; return; }
        int dev = 0, cus = 0, per_cu = 0;
        if (hipGetDevice(&dev) != hipSuccess || hipDeviceGetAttribute(&cus, hipDeviceAttributeMultiprocessorCount, dev) != hipSuccess) { grid = -1; return; }
        if (hipFuncSetAttribute((const void*)mega_fwd, hipFuncAttributeMaxDynamicSharedMemorySize, LDS_BYTES) != hipSuccess) { fprintf(stderr, "kernel_launch: hipFuncSetAttribute failed\n"); grid = -1; return; }
        if (hipOccupancyMaxActiveBlocksPerMultiprocessor(&per_cu, (const void*)mega_fwd, NWAVES * 64, LDS_BYTES) != hipSuccess || per_cu < 1) { fprintf(stderr, "kernel_launch: occupancy query says %d blocks per CU\n", per_cu); grid = -1; (void)hipGetLastError(); return; }
        grid = cus;
    }
    if (grid < 0) return;
    if (hipMemsetAsync(d_ws, 0, 16384, stream) != hipSuccess) { fprintf(stderr, "kernel_launch: memset failed\n"); return; }
    Args a{};
    for (int i = 0; i < 25; ++i) a.in[i] = (const float*)d_in[i];
    a.out = (float*)d_out; a.ws = (unsigned char*)d_ws;
#if MK_ONE_LAUNCH
    a.ph_lo = 0; a.ph_hi = N_PHASES;
    void* kargs[] = {&a};
    const hipError_t e = hipLaunchCooperativeKernel((const void*)mega_fwd, dim3(grid), dim3(NWAVES * 64), kargs, LDS_BYTES, stream);
    if (e != hipSuccess) fprintf(stderr, "kernel_launch: cooperative launch failed: %s (grid %d)\n", hipGetErrorString(e), grid);
#else
    for (int p = 0; p < N_PHASES; ++p) { a.ph_lo = p; a.ph_hi = p + 1; hipLaunchKernelGGL(mega_fwd, dim3(grid), dim3(NWAVES * 64), LDS_BYTES, stream, a); }
#endif
}
```

```cpp
#include <hip/hip_runtime.h>
#include <hip/hip_cooperative_groups.h>
#include <cstdio>
#include <cstdint>
#include <cmath>
namespace cg = cooperative_groups;

constexpr int BATCH = 8, SEQ = 2048, DMODEL = 1024, MTOK = BATCH * SEQ;
constexpr int CONV_K = 31, NHEADS = 16, HDIM = 64, NGRP = 64, NST = 64, CGRP = 16;
constexpr float RMS_EPS = 1e-6f, LN_EPS = 1e-5f, LOG2E = 1.4426950408889634f;

namespace pg8 {
#define PG8_LAS __attribute__((address_space(3)))
typedef unsigned short bf16_t;
typedef short bf16x8 __attribute__((ext_vector_type(8)));
typedef float f32x4 __attribute__((ext_vector_type(4)));
typedef unsigned u32x4 __attribute__((ext_vector_type(4)));
constexpr int BM = 256, BK = 64, HALF = 128, HTB = HALF * BK * 2  , STAGE_BYTES = 8 * HTB, NXCD = 8, WGM = 8;

__host__ __device__ __forceinline__ int lds_byte(int r, int c) { const int st = (r >> 4) * 2 + (c >> 5), rr = r & 15, cc = c & 31, ob = rr * 64 + cc * 2; return st * 1024 + (ob ^ (((ob >> 9) & 1) << 5)); }
__host__ __device__ __forceinline__ void stage_rc(int b, int& R, int& C) { const int st = b / 1024, sb = b % 1024, swz = sb ^ (((sb >> 9) & 1) << 5); R = (st >> 1) * 16 + swz / 64; C = (st & 1) * 32 + (swz % 64) / 2; }
__host__ __device__ __forceinline__ int perm32(int rho) { const int n = rho >> 4, i = rho & 15; return 8 * (i >> 2) + 4 * n + (i & 3); }

struct Unit { int pm, pn; };
struct Gemm { const bf16_t* A; const bf16_t* Bt; int M, N, K; };

struct StaticOrder {
    int nM, nN, nwg, G, c;
    __host__ __device__ void init(int M, int N, int G_, int c_) { nM = M / BM; nN = N / BM; nwg = nM * nN; G = G_; c = c_; }
    __host__ __device__ bool next(int i, Unit& u) const {
        const long L = (long)i * G + c; if (L >= nwg) return false;
        int wgid = (int)L; { const int q = nwg / NXCD, r = nwg % NXCD, xcd = wgid % NXCD, off = wgid / NXCD; wgid = (xcd < r ? xcd * (q + 1) : r * (q + 1) + (xcd - r) * q) + off; }
        const int nig = WGM * nN, gid = wgid / nig, fm = gid * WGM, gsz = (nM - fm) < WGM ? (nM - fm) : WGM;
        u.pm = fm + ((wgid % nig) % gsz); u.pn = (wgid % nig) / gsz; return true;
    }
    __device__ __forceinline__ void a_ready(const Unit&) const {}
    __device__ __forceinline__ void done(const Unit&) const {}
};
__device__ __forceinline__ unsigned cvt_pk_bf16(float lo, float hi) { unsigned r; asm volatile("v_cvt_pk_bf16_f32 %0, %1, %2" : "=v"(r) : "v"(lo), "v"(hi)); return r; }
typedef float f32x2 __attribute__((ext_vector_type(2)));
typedef unsigned u32x2 __attribute__((ext_vector_type(2)));
__device__ __forceinline__ float sigm(float x) { return __builtin_amdgcn_rcpf(1.0f + __builtin_amdgcn_exp2f(-1.4426950408889634f * x)); }
__device__ __forceinline__ float silu(float x) { return x * sigm(x); }
__device__ __forceinline__ float bflo(unsigned w) { return __uint_as_float(w << 16); }
__device__ __forceinline__ float bfhi(unsigned w) { return __uint_as_float(w & 0xffff0000u); }
__device__ __forceinline__ void row_scales(float (&sc)[2][4], const float* P, int row0, int fq) {
#pragma unroll
    for (int ai = 0; ai < 2; ++ai)
#pragma unroll
        for (int m = 0; m < 4; ++m) { const f32x4 p = *(const f32x4*)(P + (size_t)(row0 + ai * HALF + m * 16) * 16 + 4 * fq);
            float s = (p[0] + p[1]) + (p[2] + p[3]); s += __shfl_xor(s, 16); s += __shfl_xor(s, 32);
            sc[ai][m] = rsqrtf(s * (1.0f / 1024.0f) + 1e-6f); }
}
struct EpiConvIn {
    static constexpr bool PERM = true, AFTER_DRAIN = false;
    const float* P; bf16_t* U; bf16_t* SG;
    __device__ __forceinline__ void operator()(const f32x4 (&acc)[2][2][4][2], const Unit& u, int wr, int wc, int fr, int fq) const {
        const int row0 = u.pm * BM + wr * 64 + fr; float sc[2][4]; row_scales(sc, P, row0, fq);
        if (u.pn < 8) {
            bf16_t* base = U + u.pn * 128 + wc * 32 + 8 * fq;
#pragma unroll
            for (int ai = 0; ai < 2; ++ai)
#pragma unroll
                for (int m = 0; m < 4; ++m) { const float s = sc[ai][m];
                    const f32x4 a0 = acc[ai][0][m][0] * s, a1 = acc[ai][0][m][1] * s, b0 = acc[ai][1][m][0] * s, b1 = acc[ai][1][m][1] * s; u32x4 w;
                    w.x = cvt_pk_bf16(a0[0] * sigm(b0[0]), a0[1] * sigm(b0[1])); w.y = cvt_pk_bf16(a0[2] * sigm(b0[2]), a0[3] * sigm(b0[3]));
                    w.z = cvt_pk_bf16(a1[0] * sigm(b1[0]), a1[1] * sigm(b1[1])); w.w = cvt_pk_bf16(a1[2] * sigm(b1[2]), a1[3] * sigm(b1[3]));
                    *(u32x4*)(base + (size_t)(row0 + ai * HALF + m * 16) * 1024) = w; }
        } else {
            bf16_t* base = SG + (u.pn - 8) * 256 + wc * 32 + 8 * fq;
#pragma unroll
            for (int ai = 0; ai < 2; ++ai)
#pragma unroll
                for (int m = 0; m < 4; ++m) { const float s = sc[ai][m];
#pragma unroll
                    for (int bj = 0; bj < 2; ++bj) { const f32x4 v0 = acc[ai][bj][m][0] * s, v1 = acc[ai][bj][m][1] * s; u32x4 w;
                        w.x = cvt_pk_bf16(silu(v0[0]), silu(v0[1])); w.y = cvt_pk_bf16(silu(v0[2]), silu(v0[3])); w.z = cvt_pk_bf16(silu(v1[0]), silu(v1[1])); w.w = cvt_pk_bf16(silu(v1[2]), silu(v1[3]));
                        *(u32x4*)(base + (size_t)(row0 + ai * HALF + m * 16) * 1024 + bj * HALF) = w; } }
        }
    }
};
struct EpiFoxIn {
    static constexpr bool PERM = true, AFTER_DRAIN = false;
    const float* P; bf16_t* Q; bf16_t* K; bf16_t* V; bf16_t* SG; const float* qg; const float* kg;
    __device__ __forceinline__ void operator()(const f32x4 (&acc)[2][2][4][2], const Unit& u, int wr, int wc, int fr, int fq) const {
        const int row0 = u.pm * BM + wr * 64 + fr; float sc[2][4]; row_scales(sc, P, row0, fq);
        const int sec = u.pn >> 2, colb = (4 * (u.pn & 3) + wc) * 64 + 8 * fq;
        if (sec < 2) {
            const float* g = sec == 0 ? qg : kg; bf16_t* dst = (sec == 0 ? Q : K) + colb; const float post = sec == 0 ? 0.125f * 1.4426950408889634f : 1.0f;
            f32x4 gv[2][2];
#pragma unroll
            for (int bj = 0; bj < 2; ++bj)
#pragma unroll
                for (int n = 0; n < 2; ++n) gv[bj][n] = *(const f32x4*)(g + 32 * bj + 8 * fq + 4 * n);
#pragma unroll
            for (int ai = 0; ai < 2; ++ai)
#pragma unroll
                for (int m = 0; m < 4; ++m) { const float s = sc[ai][m]; f32x4 x[2][2]; float ss = 0.f;
#pragma unroll
                    for (int bj = 0; bj < 2; ++bj)
#pragma unroll
                        for (int n = 0; n < 2; ++n) { x[bj][n] = acc[ai][bj][m][n] * s; ss += (x[bj][n][0] * x[bj][n][0] + x[bj][n][1] * x[bj][n][1]) + (x[bj][n][2] * x[bj][n][2] + x[bj][n][3] * x[bj][n][3]); }
                    ss += __shfl_xor(ss, 16); ss += __shfl_xor(ss, 32);
                    const float r = rsqrtf(ss * (1.0f / 64.0f) + 1e-6f) * post;
#pragma unroll
                    for (int bj = 0; bj < 2; ++bj) { const f32x4 y0 = x[bj][0] * gv[bj][0] * r, y1 = x[bj][1] * gv[bj][1] * r; u32x4 w;
                        w.x = cvt_pk_bf16(y0[0], y0[1]); w.y = cvt_pk_bf16(y0[2], y0[3]); w.z = cvt_pk_bf16(y1[0], y1[1]); w.w = cvt_pk_bf16(y1[2], y1[3]);
                        *(u32x4*)(dst + (size_t)(row0 + ai * HALF + m * 16) * 1024 + 32 * bj) = w; } }
        } else {
            bf16_t* dst = (sec == 2 ? V : SG) + colb;
#pragma unroll
            for (int ai = 0; ai < 2; ++ai)
#pragma unroll
                for (int m = 0; m < 4; ++m) { const float s = sc[ai][m];
#pragma unroll
                    for (int bj = 0; bj < 2; ++bj) { f32x4 v0 = acc[ai][bj][m][0] * s, v1 = acc[ai][bj][m][1] * s;
                        if (sec == 3) { v0 = (f32x4){silu(v0[0]), silu(v0[1]), silu(v0[2]), silu(v0[3])}; v1 = (f32x4){silu(v1[0]), silu(v1[1]), silu(v1[2]), silu(v1[3])}; }
                        u32x4 w; w.x = cvt_pk_bf16(v0[0], v0[1]); w.y = cvt_pk_bf16(v0[2], v0[3]); w.z = cvt_pk_bf16(v1[0], v1[1]); w.w = cvt_pk_bf16(v1[2], v1[3]);
                        *(u32x4*)(dst + (size_t)(row0 + ai * HALF + m * 16) * 1024 + 32 * bj) = w; } }
        }
    }
};
struct EpiSsmIn {
    static constexpr bool PERM = true, AFTER_DRAIN = false;
    const float* P; bf16_t* U; bf16_t* SG;
    __device__ __forceinline__ void operator()(const f32x4 (&acc)[2][2][4][2], const Unit& u, int wr, int wc, int fr, int fq) const {
        const int row0 = u.pm * BM + wr * 64 + fr; float sc[2][4]; row_scales(sc, P, row0, fq);
        const bool gate = u.pn >= 4; bf16_t* dst = (gate ? SG : U) + (u.pn & 3) * 256 + wc * 32 + 8 * fq;
#pragma unroll
        for (int ai = 0; ai < 2; ++ai)
#pragma unroll
            for (int m = 0; m < 4; ++m) { const float s = sc[ai][m];
#pragma unroll
                for (int bj = 0; bj < 2; ++bj) { f32x4 v0 = acc[ai][bj][m][0] * s, v1 = acc[ai][bj][m][1] * s;
                    if (gate) { v0 = (f32x4){silu(v0[0]), silu(v0[1]), silu(v0[2]), silu(v0[3])}; v1 = (f32x4){silu(v1[0]), silu(v1[1]), silu(v1[2]), silu(v1[3])}; }
                    u32x4 w; w.x = cvt_pk_bf16(v0[0], v0[1]); w.y = cvt_pk_bf16(v0[2], v0[3]); w.z = cvt_pk_bf16(v1[0], v1[1]); w.w = cvt_pk_bf16(v1[2], v1[3]);
                    *(u32x4*)(dst + (size_t)(row0 + ai * HALF + m * 16) * 1024 + bj * HALF) = w; } }
    }
};
struct EpiOut {
    static constexpr bool PERM = true, AFTER_DRAIN = false;
    bf16_t* hb; float* P; float* out; int last;
    __device__ __forceinline__ void operator()(const f32x4 (&acc)[2][2][4][2], const Unit& u, int wr, int wc, int fr, int fq) const {
        const int row0 = u.pm * BM + wr * 64 + fr, col0 = u.pn * BM + wc * 32 + 8 * fq;
#pragma unroll
        for (int ai = 0; ai < 2; ++ai)
#pragma unroll
            for (int m = 0; m < 4; ++m) { const int row = row0 + ai * HALF + m * 16; float ss = 0.f;
#pragma unroll
                for (int bj = 0; bj < 2; ++bj) { const size_t off = (size_t)row * 1024 + col0 + bj * HALF;
                    const u32x4 r = *(const u32x4*)(hb + off);
                    const f32x4 h0 = (f32x4){bflo(r.x), bfhi(r.x), bflo(r.y), bfhi(r.y)} + acc[ai][bj][m][0], h1 = (f32x4){bflo(r.z), bfhi(r.z), bflo(r.w), bfhi(r.w)} + acc[ai][bj][m][1];
                    if (last) { __builtin_nontemporal_store(h0, (f32x4*)(out + off)); __builtin_nontemporal_store(h1, (f32x4*)(out + off + 4)); }
                    else { ss += ((h0[0] * h0[0] + h0[1] * h0[1]) + (h0[2] * h0[2] + h0[3] * h0[3])) + ((h1[0] * h1[0] + h1[1] * h1[1]) + (h1[2] * h1[2] + h1[3] * h1[3]));
                        u32x4 w; w.x = cvt_pk_bf16(h0[0], h0[1]); w.y = cvt_pk_bf16(h0[2], h0[3]); w.z = cvt_pk_bf16(h1[0], h1[1]); w.w = cvt_pk_bf16(h1[2], h1[3]); *(u32x4*)(hb + off) = w; } }
                if (!last) { ss += __shfl_xor(ss, 16); ss += __shfl_xor(ss, 32); if (fq == 0) P[(size_t)row * 16 + 4 * u.pn + wc] = ss; } }
    }
};
struct EpiGlu {
    static constexpr bool PERM = true, AFTER_DRAIN = false;
    const bf16_t* G; const bf16_t* SG; const float* bias; bf16_t* Y;
    __device__ __forceinline__ void operator()(const f32x4 (&acc)[2][2][4][2], const Unit& u, int wr, int wc, int fr, int fq) const {
        const int row0 = u.pm * BM + wr * 64 + fr, col0 = u.pn * BM + wc * 32 + 8 * fq;
        f32x4 bv[2][2];
#pragma unroll
        for (int bj = 0; bj < 2; ++bj)
#pragma unroll
            for (int n = 0; n < 2; ++n) bv[bj][n] = *(const f32x4*)(bias + col0 + bj * HALF + 4 * n);
#pragma unroll
        for (int ai = 0; ai < 2; ++ai)
#pragma unroll
            for (int m = 0; m < 4; ++m)
#pragma unroll
                for (int bj = 0; bj < 2; ++bj) { const size_t off = (size_t)(row0 + ai * HALF + m * 16) * 1024 + col0 + bj * HALF;
                    const u32x4 gq = *(const u32x4*)(G + off), sq = *(const u32x4*)(SG + off);
                    const f32x4 t0 = acc[ai][bj][m][0] + bv[bj][0], t1 = acc[ai][bj][m][1] + bv[bj][1]; u32x4 w;
                    w.x = cvt_pk_bf16(bflo(gq.x) * sigm(t0[0]) * bflo(sq.x), bfhi(gq.x) * sigm(t0[1]) * bfhi(sq.x));
                    w.y = cvt_pk_bf16(bflo(gq.y) * sigm(t0[2]) * bflo(sq.y), bfhi(gq.y) * sigm(t0[3]) * bfhi(sq.y));
                    w.z = cvt_pk_bf16(bflo(gq.z) * sigm(t1[0]) * bflo(sq.z), bfhi(gq.z) * sigm(t1[1]) * bfhi(sq.z));
                    w.w = cvt_pk_bf16(bflo(gq.w) * sigm(t1[2]) * bflo(sq.w), bfhi(gq.w) * sigm(t1[3]) * bfhi(sq.w));
                    *(u32x4*)(Y + off) = w; }
    }
};

template <class Epi, class Sched, bool ALIGN_EPI = false, bool SP2 = false>
__device__ __forceinline__ void gemm_phase(PG8_LAS unsigned char* lds, const Gemm g, const Sched& S, const Epi& E, const int tid) {
    const int wid = __builtin_amdgcn_readfirstlane(tid >> 6), lane = tid & 63, wr = wid >> 2, wc = wid & 3, fr = lane & 15, fq = lane >> 4;
    const int K = g.K, nt = K / BK;
    unsigned voffA[2], voffB[2];
#pragma unroll
    for (int i = 0; i < 2; ++i) { int R, C; stage_rc(tid * 16 + i * 8192, R, C); const int Rb = Epi::PERM ? ((R & ~31) + perm32(R & 31)) : R;
        voffA[i] = (unsigned)(R * K + C) * 2u; voffB[i] = (unsigned)(Rb * K + C) * 2u; }
    const size_t kstep = (size_t)(BK * 2);
    const size_t hstep = (size_t)HALF * K * 2;
    const size_t tstep = 2 * hstep;
    const unsigned ldsw = (unsigned)wid * 1024u;
    const int aoff = lds_byte(wr * 64 + fr, fq * 8), boff = lds_byte(wc * 32 + fr, fq * 8);
#define PG8_SA(b, h) (((b) * 2 + (h)) * HTB)
#define PG8_SB(b, h) ((4 + (b) * 2 + (h)) * HTB)
#define PG8_STAGE(bufoff, gbase, voff) do { _Pragma("unroll") for (int _i = 0; _i < 2; ++_i) \
        __builtin_amdgcn_global_load_lds((const unsigned*)((const char*)(gbase) + (voff)[_i]), (PG8_LAS unsigned*)(lds + (bufoff) + ldsw + _i * 8192), 16, 0, 0); } while (0)
#define PG8_LDA(dst, b, h) do { _Pragma("unroll") for (int m = 0; m < 4; ++m) _Pragma("unroll") for (int k = 0; k < 2; ++k) dst[m][k] = *(const PG8_LAS bf16x8*)(lds + PG8_SA(b, h) + aoff + m * 2048 + k * 1024); } while (0)
#define PG8_LDB(dst, b, h) do { _Pragma("unroll") for (int n = 0; n < 2; ++n) _Pragma("unroll") for (int k = 0; k < 2; ++k) dst[n][k] = *(const PG8_LAS bf16x8*)(lds + PG8_SB(b, h) + boff + n * 2048 + k * 1024); } while (0)
#define PG8_MMA(ai, bj, At, Bt) do { __builtin_amdgcn_s_setprio(1); _Pragma("unroll") for (int m = 0; m < 4; ++m) _Pragma("unroll") for (int n = 0; n < 2; ++n) _Pragma("unroll") for (int k = 0; k < 2; ++k) \
        acc[ai][bj][m][n] = __builtin_amdgcn_mfma_f32_16x16x32_bf16(Bt[n][k], At[m][k], acc[ai][bj][m][n], 0, 0, 0); __builtin_amdgcn_s_setprio(0); } while (0)
#define PG8_WAIT_V(n) asm volatile("s_waitcnt vmcnt(" #n ")" ::: "memory")
#define PG8_WAIT_L(n) asm volatile("s_waitcnt lgkmcnt(" #n ")" ::: "memory")
#define PG8_BAR __builtin_amdgcn_s_barrier()
#define PG8_SCHED __builtin_amdgcn_sched_barrier(0)
    Unit cur, nxt; int ui = 0;
    if (!S.next(0, cur)) return;
    f32x4 acc[2][2][4][2];
#pragma unroll
    for (int a = 0; a < 2; ++a)
#pragma unroll
        for (int b = 0; b < 2; ++b)
#pragma unroll
            for (int m = 0; m < 4; ++m)
#pragma unroll
                for (int n = 0; n < 2; ++n) acc[a][b][m][n] = (f32x4){0.f, 0.f, 0.f, 0.f};
    bf16x8 At[4][2], B0[2][2], B1[2][2];
    const char* cA = (const char*)g.A + (size_t)cur.pm * tstep; const char* cB = (const char*)g.Bt + (size_t)cur.pn * tstep;
    S.a_ready(cur);
    if constexpr (SP2) {
        PG8_STAGE(PG8_SB(0, 0), cB, voffB); PG8_STAGE(PG8_SB(0, 1), cB + hstep, voffB); PG8_STAGE(PG8_SA(0, 0), cA, voffA); PG8_STAGE(PG8_SA(0, 1), cA + hstep, voffA);
        if (wr == 1) PG8_BAR;
        PG8_WAIT_V(2); PG8_BAR;
        PG8_STAGE(PG8_SB(1, 0), cB + kstep, voffB); PG8_STAGE(PG8_SA(1, 0), cA + kstep, voffA); PG8_STAGE(PG8_SB(1, 1), cB + hstep + kstep, voffB);
        PG8_WAIT_V(6); PG8_BAR;
    } else {
        PG8_STAGE(PG8_SB(0, 0), cB, voffB); PG8_STAGE(PG8_SA(0, 0), cA, voffA); PG8_STAGE(PG8_SB(0, 1), cB + hstep, voffB); PG8_STAGE(PG8_SA(0, 1), cA + hstep, voffA);
        if (wr == 1) PG8_BAR;
        PG8_WAIT_V(4); PG8_BAR;
        PG8_STAGE(PG8_SB(1, 0), cB + kstep, voffB); PG8_STAGE(PG8_SA(1, 0), cA + kstep, voffA); PG8_STAGE(PG8_SB(1, 1), cB + hstep + kstep, voffB);
        PG8_WAIT_V(6); PG8_BAR;
    }
    for (;;) {
        const bool has_next = S.next(ui + 1, nxt);
        const char* nA = has_next ? (const char*)g.A + (size_t)nxt.pm * tstep : cA; const char* nB = has_next ? (const char*)g.Bt + (size_t)nxt.pn * tstep : cB;
        for (int t = 0; t < nt; t += 2) {
            const bool last = (t == nt - 2);
            const char* a1 = cA + (size_t)(t + 1) * kstep;
            const char* a2 = last ? nA : cA + (size_t)(t + 2) * kstep; const char* b2 = last ? nB : cB + (size_t)(t + 2) * kstep;
            const char* a3 = a2 + kstep; const char* b3 = b2 + kstep;
            if (last && has_next) S.a_ready(nxt);
            if constexpr (SP2) {
            PG8_LDB(B0, 0, 0); PG8_LDB(B1, 0, 1); PG8_SCHED; PG8_LDA(At, 0, 0); PG8_STAGE(PG8_SA(1, 1), a1 + hstep, voffA);
            PG8_WAIT_V(8); PG8_WAIT_L(0); PG8_BAR; PG8_MMA(0, 0, At, B0); PG8_MMA(0, 1, At, B1); PG8_BAR; PG8_SCHED;
            PG8_LDA(At, 0, 1); PG8_STAGE(PG8_SB(0, 0), b2, voffB); PG8_STAGE(PG8_SB(0, 1), b2 + hstep, voffB); PG8_STAGE(PG8_SA(0, 0), a2, voffA);
            PG8_WAIT_V(8); PG8_WAIT_L(0); PG8_BAR; PG8_MMA(1, 0, At, B0); PG8_MMA(1, 1, At, B1); PG8_BAR; PG8_SCHED;
            PG8_LDB(B0, 1, 0); PG8_LDB(B1, 1, 1); PG8_SCHED; PG8_LDA(At, 1, 0); PG8_STAGE(PG8_SA(0, 1), a2 + hstep, voffA);
            PG8_WAIT_V(8); PG8_WAIT_L(0); PG8_BAR; PG8_MMA(0, 0, At, B0); PG8_MMA(0, 1, At, B1); PG8_BAR; PG8_SCHED;
            PG8_LDA(At, 1, 1); PG8_STAGE(PG8_SB(1, 0), b3, voffB); PG8_STAGE(PG8_SB(1, 1), b3 + hstep, voffB); PG8_STAGE(PG8_SA(1, 0), a3, voffA);
            PG8_WAIT_V(8); PG8_WAIT_L(0); PG8_BAR; PG8_MMA(1, 0, At, B0); PG8_MMA(1, 1, At, B1); PG8_BAR; PG8_SCHED;
            } else {
            PG8_LDB(B0, 0, 0); PG8_SCHED; PG8_LDA(At, 0, 0); PG8_STAGE(PG8_SA(1, 1), a1 + hstep, voffA);
            PG8_WAIT_L(8); PG8_BAR; PG8_WAIT_L(0); PG8_MMA(0, 0, At, B0); PG8_BAR; PG8_SCHED;
            PG8_LDB(B1, 0, 1); PG8_STAGE(PG8_SB(0, 0), b2, voffB);
            PG8_BAR; PG8_WAIT_L(0); PG8_MMA(0, 1, At, B1); PG8_BAR;
            PG8_LDA(At, 0, 1); PG8_STAGE(PG8_SA(0, 0), a2, voffA);
            PG8_BAR; PG8_WAIT_L(0); PG8_MMA(1, 0, At, B0); PG8_BAR; PG8_SCHED;
            PG8_STAGE(PG8_SB(0, 1), b2 + hstep, voffB);
            PG8_WAIT_V(6); PG8_BAR; PG8_MMA(1, 1, At, B1); PG8_BAR;
            PG8_LDB(B0, 1, 0); PG8_SCHED; PG8_LDA(At, 1, 0); PG8_STAGE(PG8_SA(0, 1), a2 + hstep, voffA);
            PG8_WAIT_L(8); PG8_BAR; PG8_WAIT_L(0); PG8_MMA(0, 0, At, B0); PG8_BAR; PG8_SCHED;
            PG8_LDB(B1, 1, 1); PG8_STAGE(PG8_SB(1, 0), b3, voffB);
            PG8_BAR; PG8_WAIT_L(0); PG8_MMA(0, 1, At, B1); PG8_BAR;
            PG8_LDA(At, 1, 1); PG8_STAGE(PG8_SA(1, 0), a3, voffA);
            PG8_BAR; PG8_WAIT_L(0); PG8_MMA(1, 0, At, B0); PG8_BAR; PG8_SCHED;
            PG8_STAGE(PG8_SB(1, 1), b3 + hstep, voffB);
            PG8_WAIT_V(6); PG8_BAR; PG8_MMA(1, 1, At, B1); PG8_BAR;
            }
        }
        if constexpr (ALIGN_EPI) { if (wr == 0) PG8_BAR; }
        if constexpr (!Epi::AFTER_DRAIN) { E(acc, cur, wr, wc, fr, fq); S.done(cur); }
        if (!has_next) break;
#pragma unroll
        for (int a = 0; a < 2; ++a)
#pragma unroll
            for (int b = 0; b < 2; ++b)
#pragma unroll
                for (int m = 0; m < 4; ++m)
#pragma unroll
                    for (int n = 0; n < 2; ++n) acc[a][b][m][n] = (f32x4){0.f, 0.f, 0.f, 0.f};
        cur = nxt; cA = nA; cB = nB; ++ui;
        if constexpr (ALIGN_EPI) { if (wr == 1) PG8_BAR; }
    }
    PG8_WAIT_V(0);
    if constexpr (!ALIGN_EPI) { if (wr == 0) PG8_BAR; }
    PG8_BAR;
    if constexpr (Epi::AFTER_DRAIN) { E.fused(acc, cur, wr, wc, fr, fq, lds, wid, lane); S.done(cur); }
#undef PG8_SA
#undef PG8_SB
#undef PG8_STAGE
#undef PG8_LDA
#undef PG8_LDB
#undef PG8_MMA
#undef PG8_WAIT_V
#undef PG8_WAIT_L
#undef PG8_BAR
#undef PG8_SCHED
}
}
#include <hip/hip_bf16.h>
#include <cmath>
namespace attn_body {
using bf16=__hip_bfloat16;
using bf16x8=__attribute__((ext_vector_type(8)))short;
using s16x4=__attribute__((ext_vector_type(4)))short;
using f32x16=__attribute__((ext_vector_type(16)))float;
using u32x4=__attribute__((ext_vector_type(4)))unsigned;
constexpr int BATCH=8,NHEAD=16,SEQ=2048,D=64,DM=NHEAD*D;
constexpr int NW=8,QBLK=32,QB=QBLK*NW,KVBLK=64,NQB=SEQ/QB;
constexpr int ATTN_PITCH=DM, ATTN_UNIT_ROWS=QB;
__device__ __forceinline__ int crow(int r,int hi){return (r&3)+8*(r>>2)+4*hi;}
#define SBAR() __builtin_amdgcn_sched_barrier(0)
__device__ __forceinline__ void cmask(f32x16&p0,f32x16&p1,int jb,int qrel,int hi){
  const float NEG=-INFINITY; int kb=64*jb+4*hi;
  #pragma unroll
  for(int r=0;r<16;++r){int kv=kb+(r&3)+8*(r>>2); if(kv>qrel)p0[r]=NEG; if(kv+32>qrel)p1[r]=NEG;}
}

constexpr int NSLOT=3, SLOTB=8192;
constexpr int LDS_K=0, LDS_V=NSLOT*SLOTB, LDS_WS=2*NSLOT*SLOTB, LDS_OST=LDS_WS+NW*64*4, LDS_CK=LDS_OST+NW*4096, LDS_BYTES=LDS_CK+SEQ*8;
constexpr float C2=0.125f*1.4426950408889634f;
__device__ __forceinline__ void glds16(const void*gsrc,unsigned lds_dst){unsigned keep;
  asm volatile("s_mov_b32 %0, m0\n\ts_mov_b32 m0, %2\n\ts_nop 0\n\tglobal_load_lds_dwordx4 %1, off\n\ts_mov_b32 m0, %0":"=&s"(keep):"v"(gsrc),"s"(lds_dst):"memory");}
__device__ __forceinline__ float max3f(float a,float b,float c){float r;asm("v_max3_f32 %0, %1, %2, %3":"=v"(r):"v"(a),"v"(b),"v"(c));return r;}
__device__ __forceinline__ float max2f(float a,float b){float r;asm("v_max_f32_e32 %0, %1, %2":"=v"(r):"v"(a),"v"(b));return r;}
__device__ __forceinline__ float fadd_s(float a,float b){float r;asm("v_add_f32_e32 %0, %1, %2":"=v"(r):"v"(a),"v"(b));return r;}
__device__ __forceinline__ float fsub_s(float a,float b){float r;asm("v_sub_f32_e32 %0, %1, %2":"=v"(r):"v"(a),"v"(b));return r;}
typedef float f32x2_t __attribute__((ext_vector_type(2))); typedef __bf16 bf16x2_t __attribute__((ext_vector_type(2)));
__device__ __forceinline__ unsigned cvtpk_s(float lo,float hi){f32x2_t v={lo,hi};bf16x2_t b=__builtin_convertvector(v,bf16x2_t);return __builtin_bit_cast(unsigned,b);}
#define WAIT_BAR(N) asm volatile("s_waitcnt vmcnt(" #N ") lgkmcnt(0)\n\ts_barrier":::"memory")

__device__ __forceinline__ void qkt(f32x16&p0,f32x16&p1,const char*Kslot,const bf16x8*qr,int r32,int hi){
  const char*kb=Kslot+hi*1024+r32*16;
  #pragma unroll
  for(int d0=0;d0<4;++d0){
    const bf16x8 b0=*reinterpret_cast<const bf16x8*>(kb+d0*2048);
    const bf16x8 b1=*reinterpret_cast<const bf16x8*>(kb+d0*2048+512);
    p0=__builtin_amdgcn_mfma_f32_32x32x16_bf16(b0,qr[d0],p0,0,0,0);p1=__builtin_amdgcn_mfma_f32_32x32x16_bf16(b1,qr[d0],p1,0,0,0);}
}
typedef __attribute__((address_space(3))) const char* lds_cptr;
typedef short v4i16_t __attribute__((ext_vector_type(4)));
__device__ __forceinline__ void kload8(bf16x8*kf,lds_cptr kp){
  kf[0]=*(const __attribute__((address_space(3))) bf16x8*)(kp);      kf[1]=*(const __attribute__((address_space(3))) bf16x8*)(kp+512);
  kf[2]=*(const __attribute__((address_space(3))) bf16x8*)(kp+2048); kf[3]=*(const __attribute__((address_space(3))) bf16x8*)(kp+2560);
  kf[4]=*(const __attribute__((address_space(3))) bf16x8*)(kp+4096); kf[5]=*(const __attribute__((address_space(3))) bf16x8*)(kp+4608);
  kf[6]=*(const __attribute__((address_space(3))) bf16x8*)(kp+6144); kf[7]=*(const __attribute__((address_space(3))) bf16x8*)(kp+6656);
}
__device__ __forceinline__ void kload2(bf16x8*kf,lds_cptr kp,int j){ kf[2*j]=*(const __attribute__((address_space(3))) bf16x8*)(kp+j*2048); kf[2*j+1]=*(const __attribute__((address_space(3))) bf16x8*)(kp+j*2048+512); }
__device__ __forceinline__ s16x4 vtr(lds_cptr p){ return __builtin_bit_cast(s16x4,__builtin_amdgcn_ds_read_tr16_b64_v4i16((__attribute__((address_space(3))) v4i16_t*)p)); }
__device__ __forceinline__ float rowmax(const f32x16&p0,const f32x16&p1){
  float a=max3f(p0[0],p0[1],p1[0]),b=max3f(p0[2],p0[3],p1[1]);a=max3f(a,p1[2],p1[3]);
  #pragma unroll
  for(int r=4;r<16;r+=4){a=max3f(a,p0[r],p0[r+1]);b=max3f(b,p0[r+2],p0[r+3]);a=max3f(a,p1[r],p1[r+1]);b=max3f(b,p1[r+2],p1[r+3]);}
  const float m=max2f(a,b);
  auto rr=__builtin_amdgcn_permlane32_swap(__float_as_uint(m),__float_as_uint(m),false,false);
  return max2f(__uint_as_float(rr[0]),__uint_as_float(rr[1]));
}
__device__ __forceinline__ void pv(f32x16*o,int vb,bf16x8 pa0,bf16x8 pa1,bf16x8 pa2,bf16x8 pa3){
  #pragma unroll
  for(int d0=0;d0<2;++d0){s16x4 lo[4],hi[4];
    #pragma unroll
    for(int ks=0;ks<4;++ks){
      asm volatile("ds_read_b64_tr_b16 %0,%1 offset:%c2":"=&v"(lo[ks]):"v"(vb),"i"(d0*4096+ks*1024):"memory");
      asm volatile("ds_read_b64_tr_b16 %0,%1 offset:%c2":"=&v"(hi[ks]):"v"(vb),"i"(d0*4096+ks*1024+512):"memory");}
    asm volatile("s_waitcnt lgkmcnt(0)":::"memory");SBAR();
    #define PK(k) (bf16x8){lo[k][0],lo[k][1],lo[k][2],lo[k][3],hi[k][0],hi[k][1],hi[k][2],hi[k][3]}
    o[d0]=__builtin_amdgcn_mfma_f32_32x32x16_bf16(pa0,PK(0),o[d0],0,0,0);
    o[d0]=__builtin_amdgcn_mfma_f32_32x32x16_bf16(pa1,PK(1),o[d0],0,0,0);
    o[d0]=__builtin_amdgcn_mfma_f32_32x32x16_bf16(pa2,PK(2),o[d0],0,0,0);
    o[d0]=__builtin_amdgcn_mfma_f32_32x32x16_bf16(pa3,PK(3),o[d0],0,0,0);
    #undef PK
  }
}

typedef __attribute__((address_space(3))) const float* lds_fptr;
typedef float f32x4_t __attribute__((ext_vector_type(4)));
typedef unsigned u32x2_t __attribute__((ext_vector_type(2)));
__device__ __forceinline__ unsigned bfr(float f){ const unsigned u=__float_as_uint(f); return (u+0x7fffu+((u>>16)&1u))>>16; }
__device__ __forceinline__ void split3(float v,unsigned&h,unsigned&m,unsigned&l){ h=bfr(v); const float r=v-__uint_as_float(h<<16); m=bfr(r); const float r2=r-__uint_as_float(m<<16); l=bfr(r2); }
__device__ __forceinline__ bf16x8 kxfrag(lds_cptr p){ const u32x2_t w=*(const __attribute__((address_space(3))) u32x2_t*)p; const u32x4 f={w[0],w[1],0xBF80BF80u,0u}; return __builtin_bit_cast(bf16x8,f); }
__device__ __forceinline__ bf16x8 mkqx(float mh,int hi){ unsigned h,m,l; split3(mh,h,m,l); u32x4 f={0x3F803F80u,0x3F80u|(h<<16),m|(l<<16),0u}; if(hi)f=u32x4{0u,0u,0u,0u}; return __builtin_bit_cast(bf16x8,f); }
#ifndef ATTN_STORE16
#define ATTN_STORE16(p,v) (*(u32x4*)(p)=(v))
#endif
template<int THRL> __device__ __forceinline__ void attn_unit(int b,int h,int qb,const bf16*Q,const bf16*__restrict__ K,const bf16*__restrict__ V,const bf16*__restrict__ SG,bf16*O,char*shm,const int tid_in,const bool pre,const bool nxt,const float bref){
  int tid=tid_in; asm volatile("":"+v"(tid));
  const int lane=tid&63,r32=lane&31,hi=lane>>5; const int wid=__builtin_amdgcn_readfirstlane(tid>>6);
  const long rowbase=(long)b*SEQ; const int q0=qb*QB;
  const bf16*Qw=Q+(rowbase+q0+wid*QBLK)*DM+h*D;
  const bf16*Kh=K+rowbase*DM+h*D,*Vh=V+rowbase*DM+h*D;
  const unsigned lds0=(unsigned)(uintptr_t)shm;
  float*wsf=(float*)(shm+LDS_WS)+wid*64;
  const bf16*ksrc=Kh+(long)lane*DM+wid*8;
  const bf16*vsrc=Vh+(long)(16*(wid&3)+(lane>>2))*DM+(wid>>2)*32+(lane&3)*8;
  const unsigned kdst=lds0+LDS_K+wid*1024, vdst=lds0+LDS_V+wid*1024;
  #define DMA_K(t,slot) glds16(ksrc+(long)(t)*KVBLK*DM,(unsigned)__builtin_amdgcn_readfirstlane(kdst+(slot)))
  #define DMA_V(t,slot) glds16(vsrc+(long)(t)*KVBLK*DM,(unsigned)__builtin_amdgcn_readfirstlane(vdst+(slot)))
  const int vb0=(int)(lds0+LDS_V)+((lane>>4)&1)*32+(lane&3)*8+(4*hi+((lane&15)>>2))*64;
  const char*Kbase=shm+LDS_K; bf16x8 kf[8];
  const lds_cptr shm3=(lds_cptr)shm; const lds_cptr kxp=shm3+LDS_CK+r32*8; const lds_cptr kp0=shm3+LDS_K+hi*1024+r32*16; const lds_cptr vp0=shm3+LDS_V+((lane>>4)&1)*32+(lane&3)*8+(4*hi+((lane&15)>>2))*64;
  const int NT=(q0+QB)/KVBLK;
  if(!pre){DMA_K(0,0);DMA_V(0,0);DMA_K(1,SLOTB);}
  bf16x8 qr[4];
  #pragma unroll
  for(int d0=0;d0<4;++d0)qr[d0]=*reinterpret_cast<const bf16x8*>(&Qw[(long)r32*DM+d0*16+hi*8]);
  float l_reg=0.f;f32x16 o[2];o[0]=f32x16{};o[1]=f32x16{};
  const int qrel=wid*QBLK+r32;
  #define CMASK(P0,P1,t) do{int jb_=(t)-(NT-4); if(jb_>=0)cmask(P0,P1,jb_,qrel,hi);}while(0)
  f32x16 pA0,pA1,pB0,pB1;
  int sl_prev=0,sl_cur=0,sl_next=SLOTB;
  #define ROT() do{sl_prev=sl_cur;sl_cur=sl_next;sl_next=(sl_next==(NSLOT-1)*SLOTB)?0:sl_next+SLOTB;}while(0)
  if(!pre){DMA_K(2,2*SLOTB);}
  WAIT_BAR(3);
  float mref; { const u32x2_t w=*(const __attribute__((address_space(3))) u32x2_t*)(shm3+LDS_CK+(q0+wid*QBLK+r32)*8); mref=(__uint_as_float(w[0]<<16)+__uint_as_float(w[0]&0xffff0000u))+__uint_as_float(w[1]<<16)+bref; }
  const bf16x8 qx=mkqx(mref,hi); const f32x16 zero16=f32x16{};
  pA0=__builtin_amdgcn_mfma_f32_32x32x16_bf16(kxfrag(kxp),qx,zero16,0,0,0); pA1=__builtin_amdgcn_mfma_f32_32x32x16_bf16(kxfrag(kxp+256),qx,zero16,0,0,0);
  qkt(pA0,pA1,Kbase,qr,r32,hi);asm volatile("s_nop 15\n\ts_nop 7":"+v"(pA0),"+v"(pA1));CMASK(pA0,pA1,0);
  _Pragma("unroll") for(int r=0;r<16;++r){pA0[r]=__builtin_amdgcn_exp2f(pA0[r]);pA1[r]=__builtin_amdgcn_exp2f(pA1[r]);}
  WAIT_BAR(0);
  DMA_K(3,0);DMA_V(1,SLOTB);
  ROT();
  kload8(kf,kp0+sl_cur);
  WAIT_BAR(2);
  s16x4 vlo[8],vhi[8]; u32x4 pw0,pw1,pw2,pw3;
  #define PKW(P,B) cvtpk_s(P[B],P[B+1])
  #define PAF(k) __builtin_bit_cast(bf16x8,pw##k)
  #define VFR(i) (bf16x8){vlo[i][0],vlo[i][1],vlo[i][2],vlo[i][3],vhi[i][0],vhi[i][1],vhi[i][2],vhi[i][3]}
  #define PIN(x) asm volatile("":"+v"(x))
  #define MX3(a,b,c) __builtin_fmaxf(__builtin_fmaxf((a),(b)),(c))
  #define GAPA(MF,A0,A1,A2,A3,W0,W1,PW) do{ MF; sacc+=A0; sacc+=A1; sacc+=A2; sacc+=A3; PIN(sacc); W0; W1; PIN(PW); SBAR(); }while(0)
  #define EX(v) __builtin_amdgcn_exp2f(v)
  #define GAPB(MF,X,B) do{ MF; X[B]=EX(X[B]); X[B+1]=EX(X[B+1]); X[B+2]=EX(X[B+2]); X[B+3]=EX(X[B+3]); PIN(X); SBAR(); }while(0)
  #define VRD(i) do{ vlo[i]=vtr(vp_+(((i)>>2)*4096+((i)&3)*1024)); vhi[i]=vtr(vp_+(((i)>>2)*4096+((i)&3)*1024+512)); }while(0)
  #define KRD(G,j) do{ if(G){ kload2(kf,kp0+sl_next,j); SBAR(); } }while(0)
  #define STEP(C0,C1,P0,P1,t,GK,GV,GL) do{ SBAR(); \
    const lds_cptr vp_=vp0+sl_prev; \
    C0=__builtin_amdgcn_mfma_f32_32x32x16_bf16(kxfrag(kxp+(t)*512),qx,zero16,0,0,0); C1=__builtin_amdgcn_mfma_f32_32x32x16_bf16(kxfrag(kxp+(t)*512+256),qx,zero16,0,0,0); SBAR(); \
    VRD(0); SBAR(); float sacc=(P0[0]+P0[1]); \
    GAPA(C0=__builtin_amdgcn_mfma_f32_32x32x16_bf16(kf[0],qr[0],C0,0,0,0), P0[2],P0[3],P0[4],P0[5],     pw0[0]=PKW(P0,0), pw0[1]=PKW(P0,2), pw0); \
    VRD(4); SBAR(); GAPA(C1=__builtin_amdgcn_mfma_f32_32x32x16_bf16(kf[1],qr[0],C1,0,0,0), P0[6],P0[7],P0[8],P0[9],     pw0[2]=PKW(P0,4), pw0[3]=PKW(P0,6), pw0); \
    VRD(1); SBAR(); GAPA(C0=__builtin_amdgcn_mfma_f32_32x32x16_bf16(kf[2],qr[1],C0,0,0,0),   P0[10],P0[11],P0[12],P0[13], pw1[0]=PKW(P0,8), pw1[1]=PKW(P0,10), pw1); \
    VRD(5); SBAR(); GAPA(C1=__builtin_amdgcn_mfma_f32_32x32x16_bf16(kf[3],qr[1],C1,0,0,0),   P0[14],P0[15],P1[0],P1[1],   pw1[2]=PKW(P0,12),pw1[3]=PKW(P0,14), pw1); \
    VRD(2); SBAR(); GAPA(C0=__builtin_amdgcn_mfma_f32_32x32x16_bf16(kf[4],qr[2],C0,0,0,0),   P1[2],P1[3],P1[4],P1[5],     pw2[0]=PKW(P1,0), pw2[1]=PKW(P1,2), pw2); \
    VRD(6); SBAR(); GAPA(C1=__builtin_amdgcn_mfma_f32_32x32x16_bf16(kf[5],qr[2],C1,0,0,0),   P1[6],P1[7],P1[8],P1[9],     pw2[2]=PKW(P1,4), pw2[3]=PKW(P1,6), pw2); \
    VRD(3); SBAR(); GAPA(C0=__builtin_amdgcn_mfma_f32_32x32x16_bf16(kf[6],qr[3],C0,0,0,0),   P1[10],P1[11],P1[12],P1[13], pw3[0]=PKW(P1,8), pw3[1]=PKW(P1,10), pw3); \
    VRD(7); SBAR(); GAPA(C1=__builtin_amdgcn_mfma_f32_32x32x16_bf16(kf[7],qr[3],C1,0,0,0),   P1[14],P1[15],0.f,0.f,       pw3[2]=PKW(P1,12),pw3[3]=PKW(P1,14), pw3); \
    l_reg+=sacc; \
    if(GK){DMA_K((t)+3,sl_cur);} if(GV){DMA_V((t)+1,sl_next);} \
    CMASK(C0,C1,t); \
    SBAR(); \
    GAPB(o[0]=__builtin_amdgcn_mfma_f32_32x32x16_bf16(PAF(0),VFR(0),o[0],0,0,0), C0,0); \
    GAPB(o[1]=__builtin_amdgcn_mfma_f32_32x32x16_bf16(PAF(0),VFR(4),o[1],0,0,0), C0,4); \
    KRD(GL,0); GAPB(o[0]=__builtin_amdgcn_mfma_f32_32x32x16_bf16(PAF(1),VFR(1),o[0],0,0,0), C0,8); \
    KRD(GL,1); GAPB(o[1]=__builtin_amdgcn_mfma_f32_32x32x16_bf16(PAF(1),VFR(5),o[1],0,0,0), C0,12); \
    KRD(GL,2); GAPB(o[0]=__builtin_amdgcn_mfma_f32_32x32x16_bf16(PAF(2),VFR(2),o[0],0,0,0), C1,0); \
    KRD(GL,3); GAPB(o[1]=__builtin_amdgcn_mfma_f32_32x32x16_bf16(PAF(2),VFR(6),o[1],0,0,0), C1,4); \
    GAPB(o[0]=__builtin_amdgcn_mfma_f32_32x32x16_bf16(PAF(3),VFR(3),o[0],0,0,0), C1,8); \
    GAPB(o[1]=__builtin_amdgcn_mfma_f32_32x32x16_bf16(PAF(3),VFR(7),o[1],0,0,0), C1,12); \
    }while(0)
  int t=1;
  #undef CMASK
  #define CMASK(P0,P1,t) do{}while(0)
  for(;t+5<NT;t+=2){
    STEP(pB0,pB1,pA0,pA1,t,true,true,true);     WAIT_BAR(2); ROT();
    STEP(pA0,pA1,pB0,pB1,t+1,true,true,true);   WAIT_BAR(2); ROT();
  }
  #undef CMASK
  #define CMASK(P0,P1,t) do{int jb_=(t)-(NT-4); if(jb_>=0)cmask(P0,P1,jb_,qrel,hi);}while(0)
  #define ENDW(tt) do{ if((tt)+3<NT){WAIT_BAR(2);} else if((tt)+2<NT){WAIT_BAR(1);} else {WAIT_BAR(0);} }while(0)
  for(;t+1<NT;t+=2){
    STEP(pB0,pB1,pA0,pA1,t,(t+3<NT),(t+1<NT),(t+1<NT));       ENDW(t);   ROT();
    STEP(pA0,pA1,pB0,pB1,t+1,(t+4<NT),(t+2<NT),(t+2<NT));     ENDW(t+1); ROT();
  }
  STEP(pB0,pB1,pA0,pA1,NT-1,false,false,false);
  u32x4 sgv[4]; { const bf16*SGw=SG+(rowbase+q0+wid*QBLK)*DM+h*D;
    #pragma unroll
    for(int i=0;i<4;++i) sgv[i]=*(const u32x4*)(SGw+(long)(i*8+(lane>>3))*DM+(lane&7)*8); }
  SBAR();
  { float sacc=pB0[0]+pB0[1]; _Pragma("unroll") for(int r=2;r<16;++r)sacc+=pB0[r]; _Pragma("unroll") for(int r=0;r<16;++r)sacc+=pB1[r]; l_reg+=sacc;
    pw0=(u32x4){PKW(pB0,0),PKW(pB0,2),PKW(pB0,4),PKW(pB0,6)};pw1=(u32x4){PKW(pB0,8),PKW(pB0,10),PKW(pB0,12),PKW(pB0,14)};pw2=(u32x4){PKW(pB1,0),PKW(pB1,2),PKW(pB1,4),PKW(pB1,6)};pw3=(u32x4){PKW(pB1,8),PKW(pB1,10),PKW(pB1,12),PKW(pB1,14)};
    SBAR(); pv(o,vb0+sl_cur,PAF(0),PAF(1),PAF(2),PAF(3)); }
  asm volatile("s_waitcnt lgkmcnt(0)\n\ts_barrier":::"memory");
  if(nxt){DMA_K(0,0);DMA_V(0,0);DMA_K(1,SLOTB);DMA_K(2,2*SLOTB);}
  #undef PKW
  #undef PAF
  #undef VFR
  #undef PIN
  #undef MX3
  #undef GAPA
  #undef GAPB
  #undef EX
  #undef VRD
  #undef KRD
  #undef STEP
  #undef ENDW
  {auto rr=__builtin_amdgcn_permlane32_swap(__float_as_uint(l_reg),__float_as_uint(l_reg),false,false);l_reg=__uint_as_float(rr[0])+__uint_as_float(rr[1]);}
  if(hi==0)wsf[32+r32]=l_reg;asm volatile("s_waitcnt lgkmcnt(0)":::"memory");
  float rli[16];
  #pragma unroll
  for(int r=0;r<16;++r)rli[r]=__builtin_amdgcn_rcpf(wsf[32+crow(r,hi)]);
  bf16*Ow=O+(rowbase+q0+wid*QBLK)*DM+h*D;
  { bf16*stg=(bf16*)(shm+LDS_OST)+wid*2048;
    #pragma unroll
    for(int r=0;r<16;++r){const int orow=crow(r,hi);
      #pragma unroll
      for(int d0=0;d0<2;++d0)stg[orow*64+d0*32+r32]=__float2bfloat16(o[d0][r]*rli[r]);}
    asm volatile("s_waitcnt lgkmcnt(0)":::"memory");
    #pragma unroll
    for(int i=0;i<4;++i){const int row=i*8+(lane>>3),ch=lane&7; u32x4 v=*(const u32x4*)(stg+row*64+ch*8); const u32x4 g=sgv[i];
      #pragma unroll
      for(int e=0;e<4;++e){ const float lo=__uint_as_float(v[e]<<16)*__uint_as_float(g[e]<<16), hh=__uint_as_float(v[e]&0xffff0000u)*__uint_as_float(g[e]&0xffff0000u); v[e]=cvtpk_s(lo,hh); }
      ATTN_STORE16(Ow+(long)row*DM+ch*8,v);} }
  asm volatile("s_waitcnt lgkmcnt(0)":::"memory");
  #undef DMA_K
  #undef DMA_V
  #undef CMASK
  #undef ROT
}
constexpr int ATTN_LDS_BYTES=LDS_BYTES;
struct AttnTensors { const bf16* Q; const bf16* K; const bf16* V; const bf16* SG; bf16* O; const float* cumloc; const float* ctot; const float* qg; const float* kg; };
struct AttnUnit { int bh; int qb; };
struct StaticOrder {
  int vcu, G, nb;
  __device__ __forceinline__ explicit StaticOrder(int grid,int block,int nbatch):vcu((grid%8==0)?(block%8)*(grid/8)+block/8:block),G(grid),nb(nbatch){}
  __device__ __forceinline__ bool next(int i,AttnUnit&u)const{
    if(G==2*nb*NHEAD){ if(i>=4)return false; const int s=vcu&1; u.bh=vcu>>1; u.qb=(i==0)?s:(i==1)?7-s:(i==2)?3-s:4+s; return true; }
    const int id=vcu+i*G; if(id>=nb*NHEAD*NQB)return false; u.bh=id/NQB; u.qb=id%NQB; return true; }
  __device__ __forceinline__ void a_ready(const AttnUnit&)const{}
  __device__ __forceinline__ void done(const AttnUnit&)const{}
};
template<class Sched,int THRL=8> __device__ __forceinline__ void attn_phase(char*lds,const AttnTensors&T,const Sched&S,const int tid){
  AttnUnit u,un; int cur_bh=-1; bool pre=false; bool has=S.next(0,u);
  float bref; { float gq=fabsf(T.qg[tid&63]),gk=fabsf(T.kg[tid&63]);
    #pragma unroll
    for(int o=1;o<64;o<<=1){ gq=fmaxf(gq,__shfl_xor(gq,o)); gk=fmaxf(gk,__shfl_xor(gk,o)); }
    bref=8.0f*1.4426950408889634f*gq*gk+1.0f; }
  for(int i=0;has;++i){ S.a_ready(u); const bool hasn=S.next(i+1,un); const bool nxt=hasn&&un.bh==u.bh;
    if(u.bh!=cur_bh){ cur_bh=u.bh;
      int tq=tid; asm volatile("":"+v"(tq));
      const int b_=u.bh/NHEAD,h_=u.bh%NHEAD,l_=tq&31,c_=tq>>4;
      float v=T.ctot[(size_t)(b_*(SEQ/64)+l_)*16+h_];
      #pragma unroll
      for(int o=1;o<32;o<<=1){ const float nn=__shfl_up(v,o,32); if(l_>=o)v+=nn; }
      const float pre=__shfl(v,(c_+31)&31,32); const float base=(c_==0)?0.f:pre;
      const f32x4_t cl=*(const f32x4_t*)(T.cumloc+((size_t)u.bh)*SEQ+4*tq);
      { u32x4 w0,w1; unsigned h_,m_,l_;
        split3(-(cl[0]+base),h_,m_,l_); w0[0]=h_|(m_<<16); w0[1]=l_|0xBF800000u; split3(-(cl[1]+base),h_,m_,l_); w0[2]=h_|(m_<<16); w0[3]=l_|0xBF800000u;
        split3(-(cl[2]+base),h_,m_,l_); w1[0]=h_|(m_<<16); w1[1]=l_|0xBF800000u; split3(-(cl[3]+base),h_,m_,l_); w1[2]=h_|(m_<<16); w1[3]=l_|0xBF800000u;
        *(u32x4*)(lds+LDS_CK+32*tq)=w0; *(u32x4*)(lds+LDS_CK+32*tq+16)=w1; }
      asm volatile("s_waitcnt vmcnt(0) lgkmcnt(0)\n\ts_barrier":::"memory"); }
    attn_unit<THRL>(u.bh/NHEAD,u.bh%NHEAD,u.qb,T.Q,T.K,T.V,T.SG,T.O,lds,tid,pre,nxt,bref); S.done(u); pre=nxt; u=un; has=hasn; }
}
#undef SBAR
#undef WAIT_BAR
}
#define LAS __attribute__((address_space(3)))
typedef unsigned short bf16_t;
typedef short bf16x8_t __attribute__((ext_vector_type(8)));
typedef float f32x4 __attribute__((ext_vector_type(4)));
typedef float f32x2 __attribute__((ext_vector_type(2)));
typedef unsigned u32x4 __attribute__((ext_vector_type(4)));
constexpr int NWAVES = 8;
constexpr int RING_BYTES = 131072, LDS_BYTES = 147456, MISC_OFF = LDS_BYTES - 256;
static_assert(attn_body::LDS_BYTES <= RING_BYTES, "attention scratch must fit the ring region");
constexpr size_t MiB = 1u << 20;
constexpr size_t WS_P = 1 * MiB, WS_CUMLOC = 2 * MiB, WS_CTOT = 3 * MiB, WS_SSM = 4 * MiB, WS_W = 16 * MiB, WS_HB = 52 * MiB;
constexpr size_t WS_B1 = 84 * MiB, WS_B2 = 116 * MiB, WS_B3 = 148 * MiB, WS_B4 = 180 * MiB, WS_Y = 212 * MiB, WS_END = 244 * MiB;
constexpr int W_C0IN = 0, W_C0OUT = 3072, W_FIN = 4096, W_FF = 8192, W_FOUT = 8448, W_SIN = 9472, W_SGLU = 11520, W_SOUT = 12544, W_C1IN = 13568, W_C1OUT = 16640, W_ROWS = 17664;
static_assert(WS_W + (size_t)W_ROWS * 2048 <= WS_HB, "weights fit");

__device__ __forceinline__ unsigned f2bf_(float f) { unsigned u = __builtin_bit_cast(unsigned, f); return (u + 0x7fffu + ((u >> 16) & 1u)) >> 16; }
__device__ __forceinline__ unsigned pk2(float lo, float hi) { return f2bf_(lo) | (f2bf_(hi) << 16); }
__device__ __forceinline__ float wave_sum(float v) {
#pragma unroll
    for (int o = 1; o < 64; o <<= 1) v += __shfl_xor(v, o);
    return v;
}
#define GAS __attribute__((address_space(1)))
#define RLX_AGENT __ATOMIC_RELAXED, __HIP_MEMORY_SCOPE_AGENT
#define LDS_WAIT() asm volatile("s_waitcnt lgkmcnt(0)" ::: "memory")
#define VM_WAIT() asm volatile("s_waitcnt vmcnt(0)" ::: "memory")
#define XB_TMO      128
#define XB_XCNT(j)  (256  + 64 * (j))
#define XB_XSUB(j)  (1280 + 64 * (j))
#define XB_XGEN(j)  (2304 + 64 * (j))
#define XB_TOP      3328
#define XB_TOPGEN   3392
#define XCD_BAR_WORDS 3456
#define XB_SPIN_CAP (1u << 18)

__device__ __forceinline__ unsigned xb_ld(unsigned* p)              { return __hip_atomic_load(p, __ATOMIC_RELAXED, __HIP_MEMORY_SCOPE_AGENT); }
__device__ __forceinline__ unsigned xb_add(unsigned* p, unsigned v) { return __hip_atomic_fetch_add(p, v, __ATOMIC_RELAXED, __HIP_MEMORY_SCOPE_AGENT); }
__device__ __forceinline__ unsigned xb_xcc_id() { return (unsigned)__builtin_amdgcn_s_getreg((3 << 11) | 20) & 0xFu; }
#define XB_SPIN(cond, bar) do { unsigned _sp = 0; while (cond) { __builtin_amdgcn_s_sleep(1); \
    if ((++_sp & 255u) == 0u) { if (xb_ld(&(bar)[XB_TMO])) break; if (_sp > XB_SPIN_CAP) { atomicAdd(&(bar)[XB_TMO], 1u); break; } } } } while (0)

struct XcdBarrier {
    unsigned* bar; unsigned x; unsigned gsz;
    volatile LAS unsigned* st;
};

__device__ __forceinline__ XcdBarrier xcd_barrier_post(unsigned* bar, volatile LAS unsigned* st, const int tid, unsigned gsz) {
    XcdBarrier b; b.bar = bar; b.x = xb_xcc_id(); b.st = st; b.gsz = gsz;
    if (tid == 0) (void)xb_add(&bar[XB_XCNT(b.x)], 1u);
    return b;
}
__device__ __forceinline__ void xcd_barrier_complete(unsigned* bar, unsigned x, unsigned& nloc, unsigned& nx, const unsigned G) {
    unsigned sum, cnt, mine, sp = 0u;
    for (;;) {
        sum = 0u; cnt = 0u; mine = 0u;
#pragma unroll
        for (unsigned j = 0; j < 16; ++j) { const unsigned c = xb_ld(&bar[XB_XCNT(j)]); sum += c; cnt += (c > 0u) ? 1u : 0u; mine = (j == x) ? c : mine; }
        if (sum == G) break;
        __builtin_amdgcn_s_sleep(1);
        if ((++sp & 255u) == 0u) { if (xb_ld(&bar[XB_TMO])) break; if (sp > XB_SPIN_CAP) { atomicAdd(&bar[XB_TMO], 1u); break; } }
    }
    nloc = mine > 0u ? mine : 1u; nx = cnt > 0u ? cnt : 1u;
}

__device__ __forceinline__ void xcd_barrier(const XcdBarrier& b, const int tid) {
    asm volatile("s_waitcnt vmcnt(0)" ::: "memory");
    __syncthreads();
    if (tid == 0) {
        unsigned* bar = b.bar;
        __builtin_amdgcn_s_waitcnt(0);
        unsigned nloc = b.st[0], nx = b.st[1];
        if (nloc == 0u) { xcd_barrier_complete(bar, b.x, nloc, nx, b.gsz); b.st[0] = nloc; b.st[1] = nx; }
        const unsigned old = xb_add(&bar[XB_XSUB(b.x)], 1u);
        const unsigned gen = old / nloc;
        if (old + 1u == (gen + 1u) * nloc) {
            __builtin_amdgcn_fence(__ATOMIC_RELEASE, "agent");
            asm volatile("s_waitcnt vmcnt(0)" ::: "memory");
            const unsigned og = xb_add(&bar[XB_TOP], 1u);
            const unsigned tg = og / nx;
            if (og + 1u == (tg + 1u) * nx) xb_add(&bar[XB_TOPGEN], 1u);
            else XB_SPIN(xb_ld(&bar[XB_TOPGEN]) == tg, bar);
            __builtin_amdgcn_fence(__ATOMIC_ACQUIRE, "agent");
            xb_add(&bar[XB_XGEN(b.x)], 1u);
            asm volatile("s_waitcnt vmcnt(0)" ::: "memory");
        } else {
            XB_SPIN(xb_ld(&bar[XB_XGEN(b.x)]) == gen, bar);
            __builtin_amdgcn_fence(__ATOMIC_ACQUIRE, "agent");
            asm volatile("s_waitcnt vmcnt(0)" ::: "memory");
        }
    }
    __syncthreads();
}

__device__ __forceinline__ int lane_id_fresh() { int r; asm volatile("v_mbcnt_lo_u32_b32 %0, -1, 0\n\tv_mbcnt_hi_u32_b32 %0, -1, %0" : "=v"(r)); return r; }
struct Args { const float* in[25]; float* out; unsigned char* ws; int ph_lo, ph_hi; };

__device__ __forceinline__ int dst_row32(int s, int mode) {
    if (mode == 1) { if (s < 1024) return 256 * (s >> 7) + (s & 127); if (s < 2048) { const int t = s - 1024; return 256 * (t >> 7) + 128 + (t & 127); } return s; }
    if (mode == 2) { const int sec = s >> 10, hd = (s & 1023) >> 6, bj = (s & 63) >> 5, e = s & 31; return 1024 * sec + 256 * (hd >> 2) + 128 * bj + 32 * (hd & 3) + e; }
    return s;
}
__device__ __forceinline__ void p0_transpose_item(const float* W, int ldw, int N, const float* gain, bf16_t* WT, int mode, int item, int lane) {
    const int nblk = N / 64, kb = item / nblk, nb = item % nblk, k0 = 64 * kb, n0 = 64 * nb, q = lane >> 4, nn = lane & 15;
    f32x4 v[16]; f32x4 gk[4];
    const float* src = W + (size_t)(k0 + 16 * q) * ldw + n0 + 4 * nn;
#pragma unroll
    for (int i = 0; i < 16; ++i) v[i] = __builtin_nontemporal_load((const f32x4*)(src + (size_t)i * ldw));
#pragma unroll
    for (int i = 0; i < 4; ++i) gk[i] = (f32x4){1.f, 1.f, 1.f, 1.f};
    if (gain) {
#pragma unroll
        for (int i = 0; i < 4; ++i) gk[i] = *(const f32x4*)(gain + k0 + 16 * q + 4 * i);
    }
#pragma unroll
    for (int i = 0; i < 16; ++i) v[i] = v[i] * gk[i >> 2][i & 3];
#pragma unroll
    for (int e = 0; e < 4; ++e) { const int n = 4 * nn + e, r = dst_row32(n0 + (n & 32), mode) + (n & 31); bf16_t* d = WT + (size_t)r * 1024 + k0 + 16 * q;
#pragma unroll
        for (int h = 0; h < 2; ++h) { u32x4 o; o.x = pk2(v[8 * h][e], v[8 * h + 1][e]); o.y = pk2(v[8 * h + 2][e], v[8 * h + 3][e]); o.z = pk2(v[8 * h + 4][e], v[8 * h + 5][e]); o.w = pk2(v[8 * h + 6][e], v[8 * h + 7][e]);
            *(u32x4*)(d + 8 * h) = o; } }
}
constexpr int P0_I3072 = 16 * 3072 / 64, P0_NITEMS = 2 * (16 * 3072 / 64) + 5 * (16 * 1024 / 64) + 16 * 4096 / 64 + 16 * 2048 / 64;
__device__ __forceinline__ void p0_prologue(const Args& a, LAS unsigned char* lds, int vcu, int G, const int tid, const int item_lo, const int item_hi, const bool do_wf, const int row_lo, const int row_hi) {
    const int lane = tid & 63, wave = __builtin_amdgcn_readfirstlane(tid >> 6);
    const int gw = vcu * NWAVES + wave, NGW = G * NWAVES;
    bf16_t* WB = (bf16_t*)(a.ws + WS_W);
    const float* ng = a.in[1];
    constexpr int I3072 = 16 * 3072 / 64, I1024 = 16 * 1024 / 64, I4096 = 16 * 4096 / 64, I2048 = 16 * 2048 / 64;
    const int NITEMS = item_hi - item_lo;
    const int nfull = NITEMS / NGW, nloop = nfull + ((NITEMS - nfull * NGW) + G * NWAVES - 1) / (G * NWAVES);
    for (int k = 0; k < nloop; ++k) {
        const int it = k < nfull ? k * NGW + gw : nfull * NGW + (k - nfull) * NGW + vcu + G * wave;
        if (it >= NITEMS) continue;
        int r = it + item_lo;
        if (r < I3072) { p0_transpose_item(a.in[2], 3072, 3072, ng, WB + (size_t)W_C0IN * 1024, 1, r, lane); continue; } r -= I3072;
        if (r < I1024) { p0_transpose_item(a.in[7], 1024, 1024, nullptr, WB + (size_t)W_C0OUT * 1024, 0, r, lane); continue; } r -= I1024;
        if (r < I4096) { p0_transpose_item(a.in[8], 4112, 4096, ng + 1024, WB + (size_t)W_FIN * 1024, 2, r, lane); continue; } r -= I4096;
        if (r < I1024) { p0_transpose_item(a.in[12], 1024, 1024, nullptr, WB + (size_t)W_FOUT * 1024, 0, r, lane); continue; } r -= I1024;
        if (r < I2048) { p0_transpose_item(a.in[13], 2048, 2048, ng + 2048, WB + (size_t)W_SIN * 1024, 0, r, lane); continue; } r -= I2048;
        if (r < I1024) { p0_transpose_item(a.in[22], 1024, 1024, nullptr, WB + (size_t)W_SGLU * 1024, 0, r, lane); continue; } r -= I1024;
        if (r < I1024) { p0_transpose_item(a.in[24], 1024, 1024, nullptr, WB + (size_t)W_SOUT * 1024, 0, r, lane); continue; } r -= I1024;
        if (r < I3072) { p0_transpose_item(a.in[2] + (size_t)1024 * 3072, 3072, 3072, ng + 3072, WB + (size_t)W_C1IN * 1024, 1, r, lane); continue; } r -= I3072;
        p0_transpose_item(a.in[7] + (size_t)1024 * 1024, 1024, 1024, nullptr, WB + (size_t)W_C1OUT * 1024, 0, r, lane);
    }
    if (do_wf) for (int e = vcu * 512 + tid; e < 16 * 1024; e += G * 512) { const int n = e >> 10, k = e & 1023; WB[(size_t)(W_FF + n) * 1024 + k] = (bf16_t)f2bf_(a.in[8][(size_t)k * 4112 + 4096 + n] * ng[1024 + k]); }
    bf16_t* hb = (bf16_t*)(a.ws + WS_HB); float* P = (float*)(a.ws + WS_P);
    for (int m0 = row_lo + 4 * gw; m0 < row_hi; m0 += 4 * NGW) {
        f32x4 v[4][4];
#pragma unroll
        for (int r = 0; r < 4; ++r)
#pragma unroll
            for (int j = 0; j < 4; ++j) v[r][j] = __builtin_nontemporal_load(((const f32x4*)(a.in[0] + (size_t)(m0 + r) * 1024)) + lane + 64 * j);
#pragma unroll
        for (int r = 0; r < 4; ++r) { float s = 0.f; unsigned long long* o8 = (unsigned long long*)(hb + (size_t)(m0 + r) * 1024) + lane;
#pragma unroll
            for (int j = 0; j < 4; ++j) { const f32x4 x = v[r][j]; s += (x[0] * x[0] + x[1] * x[1]) + (x[2] * x[2] + x[3] * x[3]);
                o8[64 * j] = (unsigned long long)pk2(x[0], x[1]) | ((unsigned long long)pk2(x[2], x[3]) << 32); }
            s = wave_sum(s);
            if (lane < 4) ((f32x4*)(P + (size_t)(m0 + r) * 16))[lane] = (f32x4){lane == 0 ? s : 0.f, 0.f, 0.f, 0.f}; }
    }
}
__device__ __forceinline__ void conv_phase(LAS unsigned char* lds, const bf16_t* U, const bf16_t* SG, const float* cw, const float* cb, const float* lg, const float* lb, bf16_t* Y, int vcu, int G, const int tid, const int mtok) {
    const int lane = tid & 63, wave = __builtin_amdgcn_readfirstlane(tid >> 6);
    f32x2 w[CONV_K];
#pragma unroll
    for (int j = 0; j < CONV_K; ++j) w[j] = *(const f32x2*)(cw + (size_t)j * 1024 + 2 * tid);
    const f32x2 bias = *(const f32x2*)(cb + 2 * tid);
    LAS float* tile = (LAS float*)lds;
    for (int unit = vcu; unit < mtok / 32; unit += G) {
        const int t0 = unit * 32, seq0 = t0 & ~(SEQ - 1);

        f32x2 out[32];
#pragma unroll
        for (int tt = 0; tt < 32; ++tt) out[tt] = bias;
#pragma unroll
        for (int i = 0; i < 62; ++i) {
            const int row = t0 - 30 + i, rowc = row < seq0 ? seq0 : row;
            const unsigned raw = *(const unsigned*)(U + (size_t)rowc * 1024 + 2 * tid);
            f32x2 uv; uv.x = __uint_as_float(raw << 16); uv.y = __uint_as_float(raw & 0xffff0000u);
            if (row < seq0) uv = (f32x2){0.f, 0.f};
#pragma unroll
            for (int tt = (i > 30 ? i - 30 : 0); tt <= (i < 31 ? i : 31); ++tt) out[tt] += w[i - tt] * uv;
        }
#pragma unroll
        for (int tt = 0; tt < 32; ++tt) *(LAS f32x2*)(tile + tt * 1024 + 2 * tid) = out[tt];
        __syncthreads();
        {
            u32x4 sgv[4][2]; f32x4 gg[4], bbv[4];
#pragma unroll
            for (int q = 0; q < 4; ++q)
#pragma unroll
                for (int hf = 0; hf < 2; ++hf) sgv[q][hf] = __builtin_nontemporal_load((const u32x4*)(SG + (size_t)(t0 + wave * 4 + q) * 1024 + 8 * lane + 512 * hf));
#pragma unroll
            for (int hf = 0; hf < 2; ++hf) { gg[2 * hf] = *(const f32x4*)(lg + 8 * lane + 512 * hf); gg[2 * hf + 1] = *(const f32x4*)(lg + 8 * lane + 512 * hf + 4);
                bbv[2 * hf] = *(const f32x4*)(lb + 8 * lane + 512 * hf); bbv[2 * hf + 1] = *(const f32x4*)(lb + 8 * lane + 512 * hf + 4); }
            f32x4 v[4][4]; float s1[4], s2[4];
#pragma unroll
            for (int q = 0; q < 4; ++q) { const LAS float* tr = tile + (wave * 4 + q) * 1024 + 8 * lane;
                v[q][0] = *(const LAS f32x4*)(tr); v[q][1] = *(const LAS f32x4*)(tr + 4); v[q][2] = *(const LAS f32x4*)(tr + 512); v[q][3] = *(const LAS f32x4*)(tr + 516);
                s1[q] = 0.f; s2[q] = 0.f;
#pragma unroll
                for (int j = 0; j < 4; ++j) { s1[q] += (v[q][j][0] + v[q][j][1]) + (v[q][j][2] + v[q][j][3]); s2[q] += (v[q][j][0] * v[q][j][0] + v[q][j][1] * v[q][j][1]) + (v[q][j][2] * v[q][j][2] + v[q][j][3] * v[q][j][3]); } }
#pragma unroll
            for (int o = 1; o < 64; o <<= 1)
#pragma unroll
                for (int q = 0; q < 4; ++q) { s1[q] += __shfl_xor(s1[q], o); s2[q] += __shfl_xor(s2[q], o); }
#pragma unroll
            for (int q = 0; q < 4; ++q) {
                const float mu = s1[q] * (1.0f / 1024.0f), var = fmaxf(s2[q] * (1.0f / 1024.0f) - mu * mu, 0.f), rstd = rsqrtf(var + LN_EPS);
                const size_t off = (size_t)(t0 + wave * 4 + q) * 1024 + 8 * lane;
#pragma unroll
                for (int hf = 0; hf < 2; ++hf) { const u32x4 sg = sgv[q][hf];
                    const f32x4 y0 = (v[q][2 * hf] - mu) * rstd * gg[2 * hf] + bbv[2 * hf], y1 = (v[q][2 * hf + 1] - mu) * rstd * gg[2 * hf + 1] + bbv[2 * hf + 1]; u32x4 o;
                    o.x = pg8::cvt_pk_bf16(pg8::silu(y0[0]) * pg8::bflo(sg.x), pg8::silu(y0[1]) * pg8::bfhi(sg.x));
                    o.y = pg8::cvt_pk_bf16(pg8::silu(y0[2]) * pg8::bflo(sg.y), pg8::silu(y0[3]) * pg8::bfhi(sg.y));
                    o.z = pg8::cvt_pk_bf16(pg8::silu(y1[0]) * pg8::bflo(sg.z), pg8::silu(y1[1]) * pg8::bfhi(sg.z));
                    o.w = pg8::cvt_pk_bf16(pg8::silu(y1[2]) * pg8::bflo(sg.w), pg8::silu(y1[3]) * pg8::bfhi(sg.w));
                    *(u32x4*)(Y + off + 512 * hf) = o; }
            }
        }
        __syncthreads();
    }
}
__device__ __forceinline__ void fcum_phase(LAS unsigned char* lds, const bf16_t* hb, const bf16_t* Wf, const float* P, const float* fbias, float* cumloc, float* ctot, int vcu, int G, const int tid, const int mtok) {
    const int lane = tid & 63, wave = __builtin_amdgcn_readfirstlane(tid >> 6);
    LAS float* part = (LAS float*)lds;
    LAS float* lf = part + 2 * 64 * 17;
    for (int ch = vcu; ch < mtok / 64; ch += G) {
        f32x4 pq[2][4];
#pragma unroll
        for (int e = 0; e < 2; ++e) { const f32x4* pp = (const f32x4*)(P + (size_t)(ch * 64 + ((tid + 512 * e) >> 4)) * 16); pq[e][0] = pp[0]; pq[e][1] = pp[1]; pq[e][2] = pp[2]; pq[e][3] = pp[3]; }
        {
            const int tg = wave & 3, kh = wave >> 2, tok0 = ch * 64 + tg * 16;
            const bf16_t* ap = hb + (size_t)(tok0 + (lane & 15)) * 1024 + kh * 512 + 8 * (lane >> 4);
            const bf16_t* bp = Wf + (size_t)(lane & 15) * 1024 + kh * 512 + 8 * (lane >> 4);
            bf16x8_t av[16], bv[16];
#pragma unroll
            for (int ks = 0; ks < 16; ++ks) { av[ks] = *(const bf16x8_t*)(ap + ks * 32); bv[ks] = *(const bf16x8_t*)(bp + ks * 32); }
            f32x4 acc = (f32x4){0.f, 0.f, 0.f, 0.f};
#pragma unroll
            for (int ks = 0; ks < 16; ++ks) acc = __builtin_amdgcn_mfma_f32_16x16x32_bf16(av[ks], bv[ks], acc, 0, 0, 0);
#pragma unroll
            for (int r = 0; r < 4; ++r) part[(kh * 64 + tg * 16 + 4 * (lane >> 4) + r) * 17 + (lane & 15)] = acc[r];
        }
        __syncthreads();
#pragma unroll
        for (int e = 0; e < 2; ++e) {
            const int idx = tid + 512 * e, tl = idx >> 4, h = idx & 15;
            const f32x4 p0 = pq[e][0], p1 = pq[e][1], p2 = pq[e][2], p3 = pq[e][3];
            const float ss = ((p0[0] + p0[1]) + (p0[2] + p0[3])) + ((p1[0] + p1[1]) + (p1[2] + p1[3])) + ((p2[0] + p2[1]) + (p2[2] + p2[3])) + ((p3[0] + p3[1]) + (p3[2] + p3[3]));
            const float x = (part[tl * 17 + h] + part[(64 + tl) * 17 + h]) * rsqrtf(ss * (1.0f / 1024.0f) + RMS_EPS) + fbias[h];
            lf[tl * 17 + h] = (fminf(x, 0.f) - log1pf(__expf(-fabsf(x)))) * LOG2E; }
        __syncthreads();
#pragma unroll
        for (int e = 0; e < 2; ++e) {
            const int h = 2 * wave + e; float c = lf[lane * 17 + h];
#pragma unroll
            for (int o = 1; o < 64; o <<= 1) { const float nn = __shfl_up(c, o); if (lane >= o) c += nn; }
            const int b = ch / (SEQ / 64), cc = ch % (SEQ / 64);
            cumloc[((size_t)(b * NHEADS + h)) * SEQ + cc * 64 + lane] = c;
            if (lane == 63) ctot[(size_t)ch * 16 + h] = c; }
        __syncthreads();
    }
}
constexpr int SSM_OFF_BM = 0, SSM_OFF_PW = 65536, SSM_OFF_KT = SSM_OFF_PW + 2560, SSM_OFF_CM = SSM_OFF_KT + 8704, SSM_GS = SSM_OFF_CM + 65536;
constexpr size_t WS_SSM_PN = 13 * MiB;
static_assert(WS_SSM + (size_t)NGRP * SSM_GS <= WS_SSM_PN && SSM_GS <= MISC_OFF, "ssm tables");

__device__ __forceinline__ f32x4 cmul2(const f32x4 a, const f32x4 x) { return (f32x4){a[0] * x[0] - a[1] * x[1], a[0] * x[1] + a[1] * x[0], a[2] * x[2] - a[3] * x[3], a[2] * x[3] + a[3] * x[2]}; }
template <int CTRL> __device__ __forceinline__ float dpp_f(float v) { return __builtin_bit_cast(float, __builtin_amdgcn_update_dpp(0, __builtin_bit_cast(int, v), CTRL, 0xf, 0xf, true)); }
template <int CTRL> __device__ __forceinline__ f32x4 dpp4(const f32x4 v) { return (f32x4){dpp_f<CTRL>(v[0]), dpp_f<CTRL>(v[1]), dpp_f<CTRL>(v[2]), dpp_f<CTRL>(v[3])}; }

__device__ __forceinline__ void ssm_tables(const Args& a, LAS unsigned char* lds, int vcu, int G, const int tid) {
    const float* log_dt = a.in[14]; const float* a_re = a.in[15]; const float* a_im = a.in[16]; const float* b_re = a.in[17]; const float* b_im = a.in[18];
    const float* c_re = a.in[19]; const float* c_im = a.in[20];
    LAS float* pw = (LAS float*)lds;
    LAS float* bb = pw + 17 * 64 * 2;
    LAS float* big = bb + 64 * 17 * 2;
    LAS float* cc = big + 21 * 64 * 2;
    LAS float* zz = cc + 16 * 65 * 2;
    for (int unit = vcu; unit < 4 * NGRP; unit += G) {
        const int g = unit >> 2, sub = unit & 3;
        __syncthreads();
        if (tid < 64) {
            const int p = tid; const double dt = exp((double)log_dt[g]);
            const float are = a_re[g * 64 + p], aim = a_im[g * 64 + p], x = are * (float)dt;
            double ang = (double)aim * dt; ang -= 6.283185307179586 * rint(ang * 0.15915494309189535);
            float sn, cs, sh, ch; sincosf((float)ang, &sn, &cs); sincosf(0.5f * (float)ang, &sh, &ch);
            const float em1 = expm1f(x), mag = em1 + 1.0f, abr = mag * cs, abi = mag * sn;
            const float nr = em1 * cs - 2.0f * sh * sh, ni = mag * sn, den = are * are + aim * aim;
            zz[p * 2] = (nr * are + ni * aim) / den; zz[p * 2 + 1] = (ni * are - nr * aim) / den;
            float pr = 1.0f, pi = 0.0f;
#pragma unroll
            for (int l = 0; l <= 16; ++l) { pw[(l * 64 + p) * 2] = pr; pw[(l * 64 + p) * 2 + 1] = pi; const float t = pr * abr - pi * abi; pi = pr * abi + pi * abr; pr = t; }
            float qr = pw[(16 * 64 + p) * 2], qi = pw[(16 * 64 + p) * 2 + 1]; const float ar16 = qr, ai16 = qi;
#pragma unroll
            for (int d = 0; d < 5; ++d) { big[(d * 64 + p) * 2] = qr; big[(d * 64 + p) * 2 + 1] = qi; const float t = qr * qr - qi * qi; qi = 2.0f * qr * qi; qr = t; }
            qr = 1.0f; qi = 0.0f;
#pragma unroll
            for (int n = 0; n < 16; ++n) { big[((5 + n) * 64 + p) * 2] = qr; big[((5 + n) * 64 + p) * 2 + 1] = qi; const float t = qr * ar16 - qi * ai16; qi = qr * ai16 + qi * ar16; qr = t; }
        } else {
            for (int job = tid - 64; job < 1024; job += 448) { const int c = job >> 6, p = job & 63; cc[(c * 65 + p) * 2] = c_re[(size_t)g * 1024 + job]; cc[(c * 65 + p) * 2 + 1] = c_im[(size_t)g * 1024 + job]; }
        }
        __syncthreads();
        for (int job = tid; job < 1024; job += 512) { const int p = job >> 4, c = job & 15; const float zr = zz[p * 2], zi = zz[p * 2 + 1];
            const float br = b_re[(size_t)g * 1024 + job], bi = b_im[(size_t)g * 1024 + job];
            bb[(p * 17 + c) * 2] = zr * br - zi * bi; bb[(p * 17 + c) * 2 + 1] = zr * bi + zi * br; }
        __syncthreads();
        unsigned char* gb = a.ws + WS_SSM + (size_t)g * SSM_GS;
        for (int job = tid; job < 1024; job += 512) {
            const int fl = job >> 6, l = job & 63, rt = 2 * sub + (fl >> 3), s = fl & 7, R = 16 * rt + (l & 15), p = R >> 1, part = R & 1, j = 2 * s + (l >> 5), c0 = 8 * ((l >> 4) & 1);
            const float pr = pw[((15 - j) * 64 + p) * 2], pi = pw[((15 - j) * 64 + p) * 2 + 1]; float v[8];
#pragma unroll
            for (int e = 0; e < 8; ++e) { const float xr = bb[(p * 17 + c0 + e) * 2], xi = bb[(p * 17 + c0 + e) * 2 + 1]; v[e] = part ? (pr * xi + pi * xr) : (pr * xr - pi * xi); }
            *(u32x4*)(gb + SSM_OFF_BM + ((rt * 8 + s) * 64 + l) * 16) = (u32x4){pk2(v[0], v[1]), pk2(v[2], v[3]), pk2(v[4], v[5]), pk2(v[6], v[7])}; }
        for (int job = tid; job < 1024; job += 512) {
            const int fl = job >> 6, l = job & 63, i = 4 * sub + (fl >> 2), s = fl & 3, c = l & 15, q = l >> 4; float v[8];
#pragma unroll
            for (int e = 0; e < 8; ++e) { const int R = 16 * (2 * s + (e >> 2)) + 4 * q + (e & 3), p = R >> 1, part = R & 1;
                const float cr = cc[(c * 65 + p) * 2], ci = cc[(c * 65 + p) * 2 + 1], pr = pw[((i + 1) * 64 + p) * 2], pi = pw[((i + 1) * 64 + p) * 2 + 1];
                v[e] = part ? -(cr * pi + ci * pr) : (cr * pr - ci * pi); }
            *(u32x4*)(gb + SSM_OFF_CM + ((i * 4 + s) * 64 + l) * 16) = (u32x4){pk2(v[0], v[1]), pk2(v[2], v[3]), pk2(v[4], v[5]), pk2(v[6], v[7])}; }
        for (int idx = sub + 4 * tid; idx < 17 * 256; idx += 2048) {
            const int lagi = idx >> 8, c = (idx >> 4) & 15, c2 = idx & 15; float acc = 0.f;
            if (lagi > 0) {
#pragma unroll 16
                for (int p = 0; p < 64; ++p) { const float cr = cc[(c * 65 + p) * 2], ci = cc[(c * 65 + p) * 2 + 1], pr = pw[((lagi - 1) * 64 + p) * 2], pi = pw[((lagi - 1) * 64 + p) * 2 + 1];
                    const float tr = cr * pr - ci * pi, ti = cr * pi + ci * pr; acc += tr * bb[(p * 17 + c2) * 2] - ti * bb[(p * 17 + c2) * 2 + 1]; }
            }
            *(bf16_t*)(gb + SSM_OFF_KT + idx * 2) = (bf16_t)f2bf_(acc); }
        if (sub == 0) for (int job = tid; job < 21 * 32; job += 512) {
            const int d = job >> 5, rt = (job >> 2) & 7, q = job & 3, p0 = 8 * rt + 2 * q;
            const f32x4 v = (f32x4){big[(d * 64 + p0) * 2], big[(d * 64 + p0) * 2 + 1], big[(d * 64 + p0 + 1) * 2], big[(d * 64 + p0 + 1) * 2 + 1]};
            if (d < 5) *(f32x4*)(gb + SSM_OFF_PW + ((d * 8 + rt) * 4 + q) * 16) = v;
            else *(f32x4*)(a.ws + WS_SSM_PN + ((((size_t)g * 8 + rt) * 16 + (d - 5)) * 4 + q) * 16) = v; }
    }
}
constexpr int SSM_OFF_EX = SSM_GS;
static_assert(SSM_OFF_EX + 8 * 128 * 4 <= MISC_OFF, "ssm exchange area");
__device__ __forceinline__ void ssm_phase(LAS unsigned char* lds, unsigned char* ws, const bf16_t* U, const float* dsk, bf16_t* GO, int vcu, int G, const int tid, const int nsub) {
    const int lane = tid & 63, wave = __builtin_amdgcn_readfirstlane(tid >> 6), n = lane & 15, q = lane >> 4;
    for (int unit = vcu; unit < nsub * NGRP; unit += G) {
        const int g = unit / nsub, sub = unit % nsub;
        __syncthreads();
        { const unsigned char* gb = ws + WS_SSM + (size_t)g * SSM_GS;
          constexpr int NFULL = SSM_GS / 8192, TAIL = SSM_GS - NFULL * 8192; u32x4 tv[NFULL + 1];
#pragma unroll
          for (int it = 0; it < NFULL; ++it) tv[it] = ((const u32x4*)(gb + it * 8192))[tid];
          tv[NFULL] = ((const u32x4*)(gb + NFULL * 8192))[tid < TAIL / 16 ? tid : 0];
#pragma unroll
          for (int it = 0; it < NFULL; ++it) ((LAS u32x4*)(lds + it * 8192))[tid] = tv[it];
          if (tid < TAIL / 16) ((LAS u32x4*)(lds + NFULL * 8192))[tid] = tv[NFULL]; }
        __syncthreads();
        const int pair = sub * 8 + wave, b = pair >> 2, seg = pair & 3;
        const LAS f32x4* PW = (const LAS f32x4*)(lds + SSM_OFF_PW);
        const f32x4* PN = (const f32x4*)(ws + WS_SSM_PN) + (size_t)g * 8 * 16 * 4;
#define A16(rt) (PW[(4 * 8 + (rt)) * 4 + QQ])
#define QQ q
        const int tokb = b * SEQ + seg * 512;
        const bf16_t* Ub = U + (size_t)tokb * 1024 + g * 16; bf16_t* Gb = GO + (size_t)tokb * 1024 + g * 16;
        unsigned uoff = (unsigned)((16 * n + (lane >> 5)) * 1024 + 8 * ((lane >> 4) & 1)), eoff = (unsigned)(16 * n * 1024 + 4 * q);
        f32x4 I0[8], I1[8];
        {
            bf16x8_t uf[8];
#pragma unroll
            for (int s = 0; s < 8; ++s) uf[s] = *(const bf16x8_t*)((Ub + (2 * s) * 1024) + uoff);
            bf16x8_t fa[2][8];
#pragma unroll
            for (int s = 0; s < 8; ++s) fa[0][s] = *(const LAS bf16x8_t*)(lds + SSM_OFF_BM + ((0 * 8 + s) * 64 + lane) * 16);
#pragma unroll
            for (int rt = 0; rt < 8; ++rt) { I0[rt] = (f32x4){0.f, 0.f, 0.f, 0.f};
                if (rt < 7) {
#pragma unroll
                    for (int s = 0; s < 8; ++s) fa[(rt + 1) & 1][s] = *(const LAS bf16x8_t*)(lds + SSM_OFF_BM + (((rt + 1) * 8 + s) * 64 + lane) * 16);
                }
                __builtin_amdgcn_sched_barrier(0);
#pragma unroll
                for (int s = 0; s < 8; ++s) I0[rt] = __builtin_amdgcn_mfma_f32_16x16x32_bf16(fa[rt & 1][s], uf[s], I0[rt], 0, 0, 0);
                __builtin_amdgcn_sched_barrier(0); }
#pragma unroll
            for (int s = 0; s < 8; ++s) uf[s] = *(const bf16x8_t*)((Ub + (256 + 2 * s) * 1024) + uoff);
#pragma unroll
            for (int s = 0; s < 8; ++s) fa[0][s] = *(const LAS bf16x8_t*)(lds + SSM_OFF_BM + ((0 * 8 + s) * 64 + lane) * 16);
#pragma unroll
            for (int rt = 0; rt < 8; ++rt) { I1[rt] = (f32x4){0.f, 0.f, 0.f, 0.f};
                if (rt < 7) {
#pragma unroll
                    for (int s = 0; s < 8; ++s) fa[(rt + 1) & 1][s] = *(const LAS bf16x8_t*)(lds + SSM_OFF_BM + (((rt + 1) * 8 + s) * 64 + lane) * 16);
                }
                __builtin_amdgcn_sched_barrier(0);
#pragma unroll
                for (int s = 0; s < 8; ++s) I1[rt] = __builtin_amdgcn_mfma_f32_16x16x32_bf16(fa[rt & 1][s], uf[s], I1[rt], 0, 0, 0);
                __builtin_amdgcn_sched_barrier(0); }
        }
#pragma unroll
        for (int rt = 0; rt < 8; ++rt) { const f32x4 an = PN[(rt * 16 + (15 - n)) * 4 + q];
            f32x4 t0 = cmul2(an, I0[rt]), t1 = cmul2(an, I1[rt]);
            t0 = t0 + dpp4<0x128>(t0); t0 = t0 + dpp4<0x124>(t0); t0 = t0 + dpp4<0x122>(t0); t0 = t0 + dpp4<0x121>(t0);
            t1 = t1 + dpp4<0x128>(t1); t1 = t1 + dpp4<0x124>(t1); t1 = t1 + dpp4<0x122>(t1); t1 = t1 + dpp4<0x121>(t1);
            const f32x4 e = cmul2(A16(rt), t0) + t1;
            if (n == 0) *(LAS f32x4*)(lds + SSM_OFF_EX + wave * 512 + (rt * 4 + q) * 16) = e; }
        __syncthreads();
#undef QQ
#define QQ qb_
        int tqb = tid; asm volatile("" : "+v"(tqb));
        const int laneb = tqb & 63, nb_ = laneb & 15, qb_ = laneb >> 4;
        unsigned uoffb = (unsigned)((16 * nb_ + (laneb >> 5)) * 1024 + 8 * ((laneb >> 4) & 1)), eoffb = (unsigned)(16 * nb_ * 1024 + 4 * qb_);
        f32x4 carry[8];
#pragma unroll
        for (int rt = 0; rt < 8; ++rt) carry[rt] = (f32x4){0.f, 0.f, 0.f, 0.f};
        for (int m = 0; m < seg; ++m) {
#pragma unroll
            for (int rt = 0; rt < 8; ++rt) { const f32x4 a16 = A16(rt); const f32x4 a32 = cmul2(a16, a16); const f32x4 e = *(const LAS f32x4*)(lds + SSM_OFF_EX + (wave - seg + m) * 512 + (rt * 4 + qb_) * 16);
                carry[rt] = cmul2(a32, carry[rt]) + e; }
        }
        __syncthreads();
        const f32x4 dv = *(const f32x4*)(dsk + g * 16 + 4 * qb_);
#pragma unroll
        for (int rt = 0; rt < 8; ++rt) *(LAS f32x4*)(lds + SSM_OFF_BM + wave * 8192 + (rt * 64 + laneb) * 16) = I1[rt];
#pragma unroll
        for (int batch = 0; batch < 2; ++batch) {
            f32x4 (&I)[8] = I0;
            asm volatile("" : "+v"(uoffb), "+v"(eoffb));
            if (batch == 1) {
#pragma unroll
                for (int rt = 0; rt < 8; ++rt) { I0[rt] = *(const LAS f32x4*)(lds + SSM_OFF_BM + wave * 8192 + (rt * 64 + laneb) * 16); carry[rt] = *(const LAS f32x4*)(lds + SSM_OFF_EX + wave * 512 + (rt * 4 + qb_) * 16); }
            }
#pragma unroll
            for (int rt = 0; rt < 8; ++rt) I[rt] = I[rt] + cmul2(PW[(0 * 8 + rt) * 4 + qb_], dpp4<0x111>(I[rt]));
#pragma unroll
            for (int rt = 0; rt < 8; ++rt) I[rt] = I[rt] + cmul2(PW[(1 * 8 + rt) * 4 + qb_], dpp4<0x112>(I[rt]));
#pragma unroll
            for (int rt = 0; rt < 8; ++rt) I[rt] = I[rt] + cmul2(PW[(2 * 8 + rt) * 4 + qb_], dpp4<0x114>(I[rt]));
#pragma unroll
            for (int rt = 0; rt < 8; ++rt) I[rt] = I[rt] + cmul2(PW[(3 * 8 + rt) * 4 + qb_], dpp4<0x118>(I[rt]));
            bf16x8_t sf[4];
#pragma unroll
            for (int s = 0; s < 4; ++s) {
                const f32x4 p0 = dpp4<0x111>(I[2 * s]) + cmul2(PN[((2 * s) * 16 + nb_) * 4 + qb_], carry[2 * s]);
                const f32x4 p1 = dpp4<0x111>(I[2 * s + 1]) + cmul2(PN[((2 * s + 1) * 16 + nb_) * 4 + qb_], carry[2 * s + 1]);
                const u32x4 w = (u32x4){pg8::cvt_pk_bf16(p0[0], p0[1]), pg8::cvt_pk_bf16(p0[2], p0[3]), pg8::cvt_pk_bf16(p1[0], p1[1]), pg8::cvt_pk_bf16(p1[2], p1[3])};
                sf[s] = __builtin_bit_cast(bf16x8_t, w);
            }
            if (batch == 0) {
#pragma unroll
                for (int rt = 0; rt < 8; ++rt) { const f32x4 last = (f32x4){__shfl(I[rt][0], 15, 16), __shfl(I[rt][1], 15, 16), __shfl(I[rt][2], 15, 16), __shfl(I[rt][3], 15, 16)};
                    const f32x4 cn = cmul2(A16(rt), carry[rt]) + last; if (nb_ == 0) *(LAS f32x4*)(lds + SSM_OFF_EX + wave * 512 + (rt * 4 + qb_) * 16) = cn; }
            }
            bf16x8_t uf[8];
#pragma unroll
            for (int s = 0; s < 8; ++s) uf[s] = *(const bf16x8_t*)((Ub + (batch * 256 + 2 * s) * 1024) + uoffb);
            uint2 uwv[16]; bf16x8_t fc[4], kt[16];
#define SSM_LDC(ii) do { _Pragma("unroll") for (int s = 0; s < 4; ++s) fc[s] = *(const LAS bf16x8_t*)(lds + SSM_OFF_CM + (((ii) * 4 + s) * 64 + laneb) * 16); } while (0)
#define SSM_LDK(f) (*(const LAS bf16x8_t*)(lds + SSM_OFF_KT + (((f) + 1 - (laneb >> 5)) * 256 + (laneb & 15) * 16 + 8 * ((laneb >> 4) & 1)) * 2))
#pragma unroll
            for (int i = 0; i < 4; ++i) uwv[i] = *(const uint2*)((Ub + (batch * 256 + i) * 1024) + eoffb);
            SSM_LDC(0); kt[0] = SSM_LDK(0);
#pragma unroll
            for (int i = 0; i < 16; ++i) {
                __builtin_amdgcn_sched_barrier(0);
                f32x4 acc = (f32x4){0.f, 0.f, 0.f, 0.f};
#pragma unroll
                for (int s = 0; s < 4; ++s) acc = __builtin_amdgcn_mfma_f32_16x16x32_bf16(fc[s], sf[s], acc, 0, 0, 0);
                __builtin_amdgcn_sched_barrier(0);
                if (i + 1 < 16) { SSM_LDC(i + 1); kt[i + 1] = SSM_LDK(i + 1); }
                if (i + 4 < 16) uwv[i + 4] = *(const uint2*)((Ub + (batch * 256 + i + 4) * 1024) + eoffb);
                __builtin_amdgcn_sched_barrier(0);
#pragma unroll
                for (int s = 0; s <= i / 2; ++s) acc = __builtin_amdgcn_mfma_f32_16x16x32_bf16(kt[i - 2 * s], uf[s], acc, 0, 0, 0);
                const uint2 uw = uwv[i];
                const float y[4] = {acc[0] + dv[0] * pg8::bflo(uw.x), acc[1] + dv[1] * pg8::bfhi(uw.x), acc[2] + dv[2] * pg8::bflo(uw.y), acc[3] + dv[3] * pg8::bfhi(uw.y)};
                float ge[4];
#pragma unroll
                for (int r = 0; r < 4; ++r) ge[r] = y[r] * pg8::sigm(1.5957691216057308f * (y[r] + 0.044715f * y[r] * y[r] * y[r]));
                *(uint2*)((Gb + (batch * 256 + i) * 1024) + eoffb) = make_uint2(pg8::cvt_pk_bf16(ge[0], ge[1]), pg8::cvt_pk_bf16(ge[2], ge[3]));
                __builtin_amdgcn_sched_barrier(0);
            }
#undef SSM_LDC
#undef SSM_LDK
        }
#undef A16
#undef QQ
    }
}

template <class Epi> __device__ __forceinline__ void run_gemm(LAS unsigned char* lds, const bf16_t* A, const bf16_t* Bt, int N, const Epi& E, int G, const int tid, const int mtok, const int lb) {
    pg8::Gemm g{A, Bt, mtok, N, 1024}; pg8::StaticOrder S; S.init(mtok, N, G, lb);
    pg8::gemm_phase<Epi, pg8::StaticOrder, true, true>(lds, g, S, E, tid);
}
__global__ void __launch_bounds__(NWAVES * 64, 2) mega_fwd(Args args) {
    extern __shared__ __attribute__((aligned(16))) unsigned char lds_raw[];
    LAS unsigned char* lds = (LAS unsigned char*)lds_raw;
    const int G = gridDim.x, bx = blockIdx.x, vcu = (G % 8 == 0) ? (bx % 8) * (G / 8) + bx / 8 : bx;
    const int wave = __builtin_amdgcn_readfirstlane((int)threadIdx.x >> 6);
#define TID() (wave * 64 + lane_id_fresh())
    const int NH = (G == 256) ? 2 : 1, hh = NH == 2 ? (bx >> 3) & 1 : 0, lb = NH == 2 ? ((bx >> 4) << 3) | (bx & 7) : bx, GL = G / NH;
    const int vcl = (GL % 8 == 0) ? (lb % 8) * (GL / 8) + lb / 8 : lb, ML = MTOK / NH, BL = BATCH / NH;
    unsigned char* ws = args.ws;
    bf16_t* WB = (bf16_t*)(ws + WS_W);
    const size_t ro = (size_t)hh * ML;
    bf16_t* HB = (bf16_t*)(ws + WS_HB) + ro * 1024;
    bf16_t* B1 = (bf16_t*)(ws + WS_B1) + ro * 1024; bf16_t* B2 = (bf16_t*)(ws + WS_B2) + ro * 1024; bf16_t* B3 = (bf16_t*)(ws + WS_B3) + ro * 1024; bf16_t* B4 = (bf16_t*)(ws + WS_B4) + ro * 1024; bf16_t* YB = (bf16_t*)(ws + WS_Y) + ro * 1024;
    float* P = (float*)(ws + WS_P) + ro * 16; float* cumloc = (float*)(ws + WS_CUMLOC) + (size_t)hh * BL * NHEADS * SEQ; float* ctot = (float*)(ws + WS_CTOT) + (size_t)hh * (ML / 64) * 16;
    float* outp = args.out + ro * 1024;
    const int lo = args.ph_lo, hi = args.ph_hi;
#define IN(k) (lo <= (k) && (k) < hi)
    { const int t_ = TID(); if (t_ < 64) ((LAS unsigned*)(lds + MISC_OFF))[t_] = 0u; __syncthreads(); }
    XcdBarrier bar; bar.bar = (unsigned*)ws + hh * 4096; bar.x = 0; bar.st = nullptr; bar.gsz = 0;
    if (hi - lo > 1) bar = xcd_barrier_post((unsigned*)ws + hh * 4096, (volatile LAS unsigned*)(lds + MISC_OFF + 32), TID(), (unsigned)GL);
    if (lo < 0) cg::this_grid().sync();
#define SEAM(k) do { if (IN(k) && IN((k) + 1)) xcd_barrier(bar, TID()); } while (0)
    unsigned* const flg = (unsigned*)ws + 3 * 4096;
#define FLAG_WAIT(w) do { if (TID() == 0) { XB_SPIN(xb_ld(flg + (w)) == 0u, bar.bar); } } while (0)
#define FLAG_SET(w) do { if (lb == 0 && TID() == 0) __hip_atomic_store(flg + (w), 1u, __ATOMIC_RELAXED, __HIP_MEMORY_SCOPE_AGENT); } while (0)
    if (IN(0)) {
        if (NH == 2) { if (hh == 0) p0_prologue(args, lds, vcl, GL, TID(), 0, P0_I3072, false, 0, ML);
                       else { p0_prologue(args, lds, vcl, GL, TID(), P0_I3072, P0_NITEMS, true, ML, 2 * ML); ssm_tables(args, lds, vcl, GL, TID()); } }
        else { p0_prologue(args, lds, vcu, G, TID(), 0, P0_NITEMS, true, 0, MTOK); ssm_tables(args, lds, vcu, G, TID()); }
    }
    if (IN(0) && IN(1)) { if (NH == 2 && hh == 1) FLAG_WAIT(0); xcd_barrier(bar, TID()); if (NH == 2) FLAG_SET(64 * hh); }
    if (IN(1)) { pg8::EpiConvIn E{P, B1, B2}; run_gemm(lds, HB, WB + (size_t)W_C0IN * 1024, 3072, E, GL, TID(), ML, lb); } SEAM(1);
    if (IN(2)) { conv_phase(lds, B1, B2, args.in[3], args.in[4], args.in[5], args.in[6], YB, vcl, GL, TID(), ML); } if (NH == 2 && hh == 0 && IN(2) && IN(3)) FLAG_WAIT(64); SEAM(2);
    if (IN(3)) { pg8::EpiOut E{HB, P, outp, 0}; run_gemm(lds, YB, WB + (size_t)W_C0OUT * 1024, 1024, E, GL, TID(), ML, lb); } SEAM(3);
    if (IN(4)) { pg8::EpiFoxIn E{P, B1, B3, B4, B2, args.in[10], args.in[11]}; run_gemm(lds, HB, WB + (size_t)W_FIN * 1024, 4096, E, GL, TID(), ML, lb);
                 fcum_phase(lds, HB, WB + (size_t)W_FF * 1024, P, args.in[9], cumloc, ctot, vcl, GL, TID(), ML); } SEAM(4);
    if (IN(5)) { const attn_body::AttnTensors AT{(const attn_body::bf16*)B1, (const attn_body::bf16*)B3, (const attn_body::bf16*)B4, (const attn_body::bf16*)B2, (attn_body::bf16*)YB, cumloc, ctot, args.in[10], args.in[11]};
                 const attn_body::StaticOrder S(GL, lb, BL); attn_body::attn_phase<attn_body::StaticOrder>((char*)lds_raw, AT, S, TID()); } SEAM(5);
    if (IN(6)) { pg8::EpiOut E{HB, P, outp, 0}; run_gemm(lds, YB, WB + (size_t)W_FOUT * 1024, 1024, E, GL, TID(), ML, lb); } SEAM(6);
    if (IN(7)) { pg8::EpiSsmIn E{P, B1, B2}; run_gemm(lds, HB, WB + (size_t)W_SIN * 1024, 2048, E, GL, TID(), ML, lb); } SEAM(7);
    if (IN(8)) { ssm_phase(lds, ws, B1, args.in[21], B3, vcl, GL, TID(), BL * 4 / NWAVES); } SEAM(8);
    if (IN(10)) { pg8::EpiGlu E{B3, B2, args.in[23], YB}; run_gemm(lds, B3, WB + (size_t)W_SGLU * 1024, 1024, E, GL, TID(), ML, lb); } SEAM(10);
    if (IN(11)) { pg8::EpiOut E{HB, P, outp, 0}; run_gemm(lds, YB, WB + (size_t)W_SOUT * 1024, 1024, E, GL, TID(), ML, lb); } SEAM(11);
    if (IN(12)) { pg8::EpiConvIn E{P, B1, B2}; run_gemm(lds, HB, WB + (size_t)W_C1IN * 1024, 3072, E, GL, TID(), ML, lb); } SEAM(12);
    if (IN(13)) { conv_phase(lds, B1, B2, args.in[3] + (size_t)CONV_K * 1024, args.in[4] + 1024, args.in[5] + 1024, args.in[6] + 1024, YB, vcl, GL, TID(), ML); } SEAM(13);
    if (IN(14)) { pg8::EpiOut E{HB, P, outp, 1}; run_gemm(lds, YB, WB + (size_t)W_C1OUT * 1024, 1024, E, GL, TID(), ML, lb); }
#undef IN
#undef SEAM
}

#ifndef MK_ONE_LAUNCH
#define MK_ONE_LAUNCH 1
#endif
constexpr int N_PHASES = 15;
extern "C" void kernel_launch(void* const* d_in, const int* in_sizes, int n_in, void* d_out, int out_size, void* d_ws, size_t ws_size, hipStream_t stream) {
    static int grid = 0;
    if (grid == 0) {
        if (n_in != 25 || out_size != MTOK * DMODEL || ws_size < WS_END) { fprintf(stderr, "kernel_launch: unexpected shapes (n_in %d, out %d, ws %zu)\n", n_in, out_size, ws_size); grid = -1; return; }
        int dev = 0, cus = 0, per_cu = 0;
        if (hipGetDevice(&dev) != hipSuccess || hipDeviceGetAttribute(&cus, hipDeviceAttributeMultiprocessorCount, dev) != hipSuccess) { grid = -1; return; }
        if (hipFuncSetAttribute((const void*)mega_fwd, hipFuncAttributeMaxDynamicSharedMemorySize, LDS_BYTES) != hipSuccess) { fprintf(stderr, "kernel_launch: hipFuncSetAttribute failed\n"); grid = -1; return; }
        if (hipOccupancyMaxActiveBlocksPerMultiprocessor(&per_cu, (const void*)mega_fwd, NWAVES * 64, LDS_BYTES) != hipSuccess || per_cu < 1) { fprintf(stderr, "kernel_launch: occupancy query says %d blocks per CU\n", per_cu); grid = -1; (void)hipGetLastError(); return; }
        grid = cus;
    }
    if (grid < 0) return;
    if (hipMemsetAsync(d_ws, 0, 65536, stream) != hipSuccess) { fprintf(stderr, "kernel_launch: memset failed\n"); return; }
    Args a{};
    for (int i = 0; i < 25; ++i) a.in[i] = (const float*)d_in[i];
    a.out = (float*)d_out; a.ws = (unsigned char*)d_ws;
#if MK_ONE_LAUNCH
    a.ph_lo = 0; a.ph_hi = N_PHASES;
    void* kargs[] = {&a};
    const hipError_t e = hipLaunchCooperativeKernel((const void*)mega_fwd, dim3(grid), dim3(NWAVES * 64), kargs, LDS_BYTES, stream);
    if (e != hipSuccess) fprintf(stderr, "kernel_launch: cooperative launch failed: %s (grid %d)\n", hipGetErrorString(e), grid);
#else
    for (int p = 0; p < N_PHASES; ++p) { a.ph_lo = p; a.ph_hi = p + 1; hipLaunchKernelGGL(mega_fwd, dim3(grid), dim3(NWAVES * 64), LDS_BYTES, stream, a); }
#endif
}
```

```cpp
#include <hip/hip_runtime.h>
#include <hip/hip_cooperative_groups.h>
#include <cstdio>
#include <cstdint>
#include <cmath>
namespace cg = cooperative_groups;

constexpr int BATCH = 8, SEQ = 2048, DMODEL = 1024, MTOK = BATCH * SEQ;
constexpr int CONV_K = 31, NHEADS = 16, HDIM = 64, NGRP = 64, NST = 64, CGRP = 16;
constexpr float RMS_EPS = 1e-6f, LN_EPS = 1e-5f, LOG2E = 1.4426950408889634f;

namespace pg8 {
#define PG8_LAS __attribute__((address_space(3)))
typedef unsigned short bf16_t;
typedef short bf16x8 __attribute__((ext_vector_type(8)));
typedef float f32x4 __attribute__((ext_vector_type(4)));
typedef unsigned u32x4 __attribute__((ext_vector_type(4)));
constexpr int BM = 256, BK = 64, HALF = 128, HTB = HALF * BK * 2  , STAGE_BYTES = 8 * HTB, NXCD = 8, WGM = 8;

__host__ __device__ __forceinline__ int lds_byte(int r, int c) { const int st = (r >> 4) * 2 + (c >> 5), rr = r & 15, cc = c & 31, ob = rr * 64 + cc * 2; return st * 1024 + (ob ^ (((ob >> 9) & 1) << 5)); }
__host__ __device__ __forceinline__ void stage_rc(int b, int& R, int& C) { const int st = b / 1024, sb = b % 1024, swz = sb ^ (((sb >> 9) & 1) << 5); R = (st >> 1) * 16 + swz / 64; C = (st & 1) * 32 + (swz % 64) / 2; }
__host__ __device__ __forceinline__ int perm32(int rho) { const int n = rho >> 4, i = rho & 15; return 8 * (i >> 2) + 4 * n + (i & 3); }

struct Unit { int pm, pn; };
struct Gemm { const bf16_t* A; const bf16_t* Bt; int M, N, K; };

struct StaticOrder {
    int nM, nN, nwg, G, c;
    __host__ __device__ void init(int M, int N, int G_, int c_) { nM = M / BM; nN = N / BM; nwg = nM * nN; G = G_; c = c_; }
    __host__ __device__ bool next(int i, Unit& u) const {
        const long L = (long)i * G + c; if (L >= nwg) return false;
        int wgid = (int)L; { const int q = nwg / NXCD, r = nwg % NXCD, xcd = wgid % NXCD, off = wgid / NXCD; wgid = (xcd < r ? xcd * (q + 1) : r * (q + 1) + (xcd - r) * q) + off; }
        const int nig = WGM * nN, gid = wgid / nig, fm = gid * WGM, gsz = (nM - fm) < WGM ? (nM - fm) : WGM;
        u.pm = fm + ((wgid % nig) % gsz); u.pn = (wgid % nig) / gsz; return true;
    }
    __device__ __forceinline__ void a_ready(const Unit&) const {}
    __device__ __forceinline__ void done(const Unit&) const {}
};
__device__ __forceinline__ unsigned cvt_pk_bf16(float lo, float hi) { unsigned r; asm volatile("v_cvt_pk_bf16_f32 %0, %1, %2" : "=v"(r) : "v"(lo), "v"(hi)); return r; }
typedef float f32x2 __attribute__((ext_vector_type(2)));
typedef unsigned u32x2 __attribute__((ext_vector_type(2)));
__device__ __forceinline__ float sigm(float x) { return __builtin_amdgcn_rcpf(1.0f + __builtin_amdgcn_exp2f(-1.4426950408889634f * x)); }
__device__ __forceinline__ float silu(float x) { return x * sigm(x); }
__device__ __forceinline__ float bflo(unsigned w) { return __uint_as_float(w << 16); }
__device__ __forceinline__ float bfhi(unsigned w) { return __uint_as_float(w & 0xffff0000u); }
__device__ __forceinline__ void row_scales(float (&sc)[2][4], const float* P, int row0, int fq) {
#pragma unroll
    for (int ai = 0; ai < 2; ++ai)
#pragma unroll
        for (int m = 0; m < 4; ++m) { const f32x4 p = *(const f32x4*)(P + (size_t)(row0 + ai * HALF + m * 16) * 16 + 4 * fq);
            float s = (p[0] + p[1]) + (p[2] + p[3]); s += __shfl_xor(s, 16); s += __shfl_xor(s, 32);
            sc[ai][m] = rsqrtf(s * (1.0f / 1024.0f) + 1e-6f); }
}
struct EpiConvIn {
    static constexpr bool PERM = true, AFTER_DRAIN = false;
    const float* P; bf16_t* U; bf16_t* SG;
    __device__ __forceinline__ void operator()(const f32x4 (&acc)[2][2][4][2], const Unit& u, int wr, int wc, int fr, int fq) const {
        const int row0 = u.pm * BM + wr * 64 + fr; float sc[2][4]; row_scales(sc, P, row0, fq);
        if (u.pn < 8) {
            bf16_t* base = U + u.pn * 128 + wc * 32 + 8 * fq;
#pragma unroll
            for (int ai = 0; ai < 2; ++ai)
#pragma unroll
                for (int m = 0; m < 4; ++m) { const float s = sc[ai][m];
                    const f32x4 a0 = acc[ai][0][m][0] * s, a1 = acc[ai][0][m][1] * s, b0 = acc[ai][1][m][0] * s, b1 = acc[ai][1][m][1] * s; u32x4 w;
                    w.x = cvt_pk_bf16(a0[0] * sigm(b0[0]), a0[1] * sigm(b0[1])); w.y = cvt_pk_bf16(a0[2] * sigm(b0[2]), a0[3] * sigm(b0[3]));
                    w.z = cvt_pk_bf16(a1[0] * sigm(b1[0]), a1[1] * sigm(b1[1])); w.w = cvt_pk_bf16(a1[2] * sigm(b1[2]), a1[3] * sigm(b1[3]));
                    *(u32x4*)(base + (size_t)(row0 + ai * HALF + m * 16) * 1024) = w; }
        } else {
            bf16_t* base = SG + (u.pn - 8) * 256 + wc * 32 + 8 * fq;
#pragma unroll
            for (int ai = 0; ai < 2; ++ai)
#pragma unroll
                for (int m = 0; m < 4; ++m) { const float s = sc[ai][m];
#pragma unroll
                    for (int bj = 0; bj < 2; ++bj) { const f32x4 v0 = acc[ai][bj][m][0] * s, v1 = acc[ai][bj][m][1] * s; u32x4 w;
                        w.x = cvt_pk_bf16(silu(v0[0]), silu(v0[1])); w.y = cvt_pk_bf16(silu(v0[2]), silu(v0[3])); w.z = cvt_pk_bf16(silu(v1[0]), silu(v1[1])); w.w = cvt_pk_bf16(silu(v1[2]), silu(v1[3]));
                        *(u32x4*)(base + (size_t)(row0 + ai * HALF + m * 16) * 1024 + bj * HALF) = w; } }
        }
    }
};
struct EpiFoxIn {
    static constexpr bool PERM = true, AFTER_DRAIN = false;
    const float* P; bf16_t* Q; bf16_t* K; bf16_t* V; bf16_t* SG; const float* qg; const float* kg;
    __device__ __forceinline__ void operator()(const f32x4 (&acc)[2][2][4][2], const Unit& u, int wr, int wc, int fr, int fq) const {
        const int row0 = u.pm * BM + wr * 64 + fr; float sc[2][4]; row_scales(sc, P, row0, fq);
        const int sec = u.pn >> 2, colb = (4 * (u.pn & 3) + wc) * 64 + 8 * fq;
        if (sec < 2) {
            const float* g = sec == 0 ? qg : kg; bf16_t* dst = (sec == 0 ? Q : K) + colb; const float post = sec == 0 ? 0.125f * 1.4426950408889634f : 1.0f;
            f32x4 gv[2][2];
#pragma unroll
            for (int bj = 0; bj < 2; ++bj)
#pragma unroll
                for (int n = 0; n < 2; ++n) gv[bj][n] = *(const f32x4*)(g + 32 * bj + 8 * fq + 4 * n);
#pragma unroll
            for (int ai = 0; ai < 2; ++ai)
#pragma unroll
                for (int m = 0; m < 4; ++m) { const float s = sc[ai][m]; f32x4 x[2][2]; float ss = 0.f;
#pragma unroll
                    for (int bj = 0; bj < 2; ++bj)
#pragma unroll
                        for (int n = 0; n < 2; ++n) { x[bj][n] = acc[ai][bj][m][n] * s; ss += (x[bj][n][0] * x[bj][n][0] + x[bj][n][1] * x[bj][n][1]) + (x[bj][n][2] * x[bj][n][2] + x[bj][n][3] * x[bj][n][3]); }
                    ss += __shfl_xor(ss, 16); ss += __shfl_xor(ss, 32);
                    const float r = rsqrtf(ss * (1.0f / 64.0f) + 1e-6f) * post;
#pragma unroll
                    for (int bj = 0; bj < 2; ++bj) { const f32x4 y0 = x[bj][0] * gv[bj][0] * r, y1 = x[bj][1] * gv[bj][1] * r; u32x4 w;
                        w.x = cvt_pk_bf16(y0[0], y0[1]); w.y = cvt_pk_bf16(y0[2], y0[3]); w.z = cvt_pk_bf16(y1[0], y1[1]); w.w = cvt_pk_bf16(y1[2], y1[3]);
                        *(u32x4*)(dst + (size_t)(row0 + ai * HALF + m * 16) * 1024 + 32 * bj) = w; } }
        } else {
            bf16_t* dst = (sec == 2 ? V : SG) + colb;
#pragma unroll
            for (int ai = 0; ai < 2; ++ai)
#pragma unroll
                for (int m = 0; m < 4; ++m) { const float s = sc[ai][m];
#pragma unroll
                    for (int bj = 0; bj < 2; ++bj) { f32x4 v0 = acc[ai][bj][m][0] * s, v1 = acc[ai][bj][m][1] * s;
                        if (sec == 3) { v0 = (f32x4){silu(v0[0]), silu(v0[1]), silu(v0[2]), silu(v0[3])}; v1 = (f32x4){silu(v1[0]), silu(v1[1]), silu(v1[2]), silu(v1[3])}; }
                        u32x4 w; w.x = cvt_pk_bf16(v0[0], v0[1]); w.y = cvt_pk_bf16(v0[2], v0[3]); w.z = cvt_pk_bf16(v1[0], v1[1]); w.w = cvt_pk_bf16(v1[2], v1[3]);
                        *(u32x4*)(dst + (size_t)(row0 + ai * HALF + m * 16) * 1024 + 32 * bj) = w; } }
        }
    }
};
struct EpiSsmIn {
    static constexpr bool PERM = true, AFTER_DRAIN = false;
    const float* P; bf16_t* U; bf16_t* SG;
    __device__ __forceinline__ void operator()(const f32x4 (&acc)[2][2][4][2], const Unit& u, int wr, int wc, int fr, int fq) const {
        const int row0 = u.pm * BM + wr * 64 + fr; float sc[2][4]; row_scales(sc, P, row0, fq);
        const bool gate = u.pn >= 4; bf16_t* dst = (gate ? SG : U) + (u.pn & 3) * 256 + wc * 32 + 8 * fq;
#pragma unroll
        for (int ai = 0; ai < 2; ++ai)
#pragma unroll
            for (int m = 0; m < 4; ++m) { const float s = sc[ai][m];
#pragma unroll
                for (int bj = 0; bj < 2; ++bj) { f32x4 v0 = acc[ai][bj][m][0] * s, v1 = acc[ai][bj][m][1] * s;
                    if (gate) { v0 = (f32x4){silu(v0[0]), silu(v0[1]), silu(v0[2]), silu(v0[3])}; v1 = (f32x4){silu(v1[0]), silu(v1[1]), silu(v1[2]), silu(v1[3])}; }
                    u32x4 w; w.x = cvt_pk_bf16(v0[0], v0[1]); w.y = cvt_pk_bf16(v0[2], v0[3]); w.z = cvt_pk_bf16(v1[0], v1[1]); w.w = cvt_pk_bf16(v1[2], v1[3]);
                    *(u32x4*)(dst + (size_t)(row0 + ai * HALF + m * 16) * 1024 + bj * HALF) = w; } }
    }
};
struct EpiOut {
    static constexpr bool PERM = true, AFTER_DRAIN = false;
    bf16_t* hb; float* P; float* out; int last;
    __device__ __forceinline__ void operator()(const f32x4 (&acc)[2][2][4][2], const Unit& u, int wr, int wc, int fr, int fq) const {
        const int row0 = u.pm * BM + wr * 64 + fr, col0 = u.pn * BM + wc * 32 + 8 * fq;
#pragma unroll
        for (int ai = 0; ai < 2; ++ai)
#pragma unroll
            for (int m = 0; m < 4; ++m) { const int row = row0 + ai * HALF + m * 16; float ss = 0.f;
#pragma unroll
                for (int bj = 0; bj < 2; ++bj) { const size_t off = (size_t)row * 1024 + col0 + bj * HALF;
                    const u32x4 r = *(const u32x4*)(hb + off);
                    const f32x4 h0 = (f32x4){bflo(r.x), bfhi(r.x), bflo(r.y), bfhi(r.y)} + acc[ai][bj][m][0], h1 = (f32x4){bflo(r.z), bfhi(r.z), bflo(r.w), bfhi(r.w)} + acc[ai][bj][m][1];
                    if (last) { __builtin_nontemporal_store(h0, (f32x4*)(out + off)); __builtin_nontemporal_store(h1, (f32x4*)(out + off + 4)); }
                    else { ss += ((h0[0] * h0[0] + h0[1] * h0[1]) + (h0[2] * h0[2] + h0[3] * h0[3])) + ((h1[0] * h1[0] + h1[1] * h1[1]) + (h1[2] * h1[2] + h1[3] * h1[3]));
                        u32x4 w; w.x = cvt_pk_bf16(h0[0], h0[1]); w.y = cvt_pk_bf16(h0[2], h0[3]); w.z = cvt_pk_bf16(h1[0], h1[1]); w.w = cvt_pk_bf16(h1[2], h1[3]); *(u32x4*)(hb + off) = w; } }
                if (!last) { ss += __shfl_xor(ss, 16); ss += __shfl_xor(ss, 32); if (fq == 0) P[(size_t)row * 16 + 4 * u.pn + wc] = ss; } }
    }
};
struct EpiGlu {
    static constexpr bool PERM = true, AFTER_DRAIN = false;
    const bf16_t* G; const bf16_t* SG; const float* bias; bf16_t* Y;
    __device__ __forceinline__ void operator()(const f32x4 (&acc)[2][2][4][2], const Unit& u, int wr, int wc, int fr, int fq) const {
        const int row0 = u.pm * BM + wr * 64 + fr, col0 = u.pn * BM + wc * 32 + 8 * fq;
        f32x4 bv[2][2];
#pragma unroll
        for (int bj = 0; bj < 2; ++bj)
#pragma unroll
            for (int n = 0; n < 2; ++n) bv[bj][n] = *(const f32x4*)(bias + col0 + bj * HALF + 4 * n);
#pragma unroll
        for (int ai = 0; ai < 2; ++ai)
#pragma unroll
            for (int m = 0; m < 4; ++m)
#pragma unroll
                for (int bj = 0; bj < 2; ++bj) { const size_t off = (size_t)(row0 + ai * HALF + m * 16) * 1024 + col0 + bj * HALF;
                    const u32x4 gq = *(const u32x4*)(G + off), sq = *(const u32x4*)(SG + off);
                    const f32x4 t0 = acc[ai][bj][m][0] + bv[bj][0], t1 = acc[ai][bj][m][1] + bv[bj][1]; u32x4 w;
                    w.x = cvt_pk_bf16(bflo(gq.x) * sigm(t0[0]) * bflo(sq.x), bfhi(gq.x) * sigm(t0[1]) * bfhi(sq.x));
                    w.y = cvt_pk_bf16(bflo(gq.y) * sigm(t0[2]) * bflo(sq.y), bfhi(gq.y) * sigm(t0[3]) * bfhi(sq.y));
                    w.z = cvt_pk_bf16(bflo(gq.z) * sigm(t1[0]) * bflo(sq.z), bfhi(gq.z) * sigm(t1[1]) * bfhi(sq.z));
                    w.w = cvt_pk_bf16(bflo(gq.w) * sigm(t1[2]) * bflo(sq.w), bfhi(gq.w) * sigm(t1[3]) * bfhi(sq.w));
                    *(u32x4*)(Y + off) = w; }
    }
};

template <class Epi, class Sched, bool ALIGN_EPI = false, bool SP2 = false>
__device__ __forceinline__ void gemm_phase(PG8_LAS unsigned char* lds, const Gemm g, const Sched& S, const Epi& E, const int tid) {
    const int wid = __builtin_amdgcn_readfirstlane(tid >> 6), lane = tid & 63, wr = wid >> 2, wc = wid & 3, fr = lane & 15, fq = lane >> 4;
    const int K = g.K, nt = K / BK;
    unsigned voffA[2], voffB[2];
#pragma unroll
    for (int i = 0; i < 2; ++i) { int R, C; stage_rc(tid * 16 + i * 8192, R, C); const int Rb = Epi::PERM ? ((R & ~31) + perm32(R & 31)) : R;
        voffA[i] = (unsigned)(R * K + C) * 2u; voffB[i] = (unsigned)(Rb * K + C) * 2u; }
    const size_t kstep = (size_t)(BK * 2);
    const size_t hstep = (size_t)HALF * K * 2;
    const size_t tstep = 2 * hstep;
    const unsigned ldsw = (unsigned)wid * 1024u;
    const int aoff = lds_byte(wr * 64 + fr, fq * 8), boff = lds_byte(wc * 32 + fr, fq * 8);
#define PG8_SA(b, h) (((b) * 2 + (h)) * HTB)
#define PG8_SB(b, h) ((4 + (b) * 2 + (h)) * HTB)
#define PG8_STAGE(bufoff, gbase, voff) do { _Pragma("unroll") for (int _i = 0; _i < 2; ++_i) \
        __builtin_amdgcn_global_load_lds((const unsigned*)((const char*)(gbase) + (voff)[_i]), (PG8_LAS unsigned*)(lds + (bufoff) + ldsw + _i * 8192), 16, 0, 0); } while (0)
#define PG8_LDA(dst, b, h) do { _Pragma("unroll") for (int m = 0; m < 4; ++m) _Pragma("unroll") for (int k = 0; k < 2; ++k) dst[m][k] = *(const PG8_LAS bf16x8*)(lds + PG8_SA(b, h) + aoff + m * 2048 + k * 1024); } while (0)
#define PG8_LDB(dst, b, h) do { _Pragma("unroll") for (int n = 0; n < 2; ++n) _Pragma("unroll") for (int k = 0; k < 2; ++k) dst[n][k] = *(const PG8_LAS bf16x8*)(lds + PG8_SB(b, h) + boff + n * 2048 + k * 1024); } while (0)
#define PG8_MMA(ai, bj, At, Bt) do { __builtin_amdgcn_s_setprio(1); _Pragma("unroll") for (int m = 0; m < 4; ++m) _Pragma("unroll") for (int n = 0; n < 2; ++n) _Pragma("unroll") for (int k = 0; k < 2; ++k) \
        acc[ai][bj][m][n] = __builtin_amdgcn_mfma_f32_16x16x32_bf16(Bt[n][k], At[m][k], acc[ai][bj][m][n], 0, 0, 0); __builtin_amdgcn_s_setprio(0); } while (0)
#define PG8_WAIT_V(n) asm volatile("s_waitcnt vmcnt(" #n ")" ::: "memory")
#define PG8_WAIT_L(n) asm volatile("s_waitcnt lgkmcnt(" #n ")" ::: "memory")
#define PG8_BAR __builtin_amdgcn_s_barrier()
#define PG8_SCHED __builtin_amdgcn_sched_barrier(0)
    Unit cur, nxt; int ui = 0;
    if (!S.next(0, cur)) return;
    f32x4 acc[2][2][4][2];
#pragma unroll
    for (int a = 0; a < 2; ++a)
#pragma unroll
        for (int b = 0; b < 2; ++b)
#pragma unroll
            for (int m = 0; m < 4; ++m)
#pragma unroll
                for (int n = 0; n < 2; ++n) acc[a][b][m][n] = (f32x4){0.f, 0.f, 0.f, 0.f};
    bf16x8 At[4][2], B0[2][2], B1[2][2];
    const char* cA = (const char*)g.A + (size_t)cur.pm * tstep; const char* cB = (const char*)g.Bt + (size_t)cur.pn * tstep;
    S.a_ready(cur);
    if constexpr (SP2) {
        PG8_STAGE(PG8_SB(0, 0), cB, voffB); PG8_STAGE(PG8_SB(0, 1), cB + hstep, voffB); PG8_STAGE(PG8_SA(0, 0), cA, voffA); PG8_STAGE(PG8_SA(0, 1), cA + hstep, voffA);
        if (wr == 1) PG8_BAR;
        PG8_WAIT_V(2); PG8_BAR;
        PG8_STAGE(PG8_SB(1, 0), cB + kstep, voffB); PG8_STAGE(PG8_SA(1, 0), cA + kstep, voffA); PG8_STAGE(PG8_SB(1, 1), cB + hstep + kstep, voffB);
        PG8_WAIT_V(6); PG8_BAR;
    } else {
        PG8_STAGE(PG8_SB(0, 0), cB, voffB); PG8_STAGE(PG8_SA(0, 0), cA, voffA); PG8_STAGE(PG8_SB(0, 1), cB + hstep, voffB); PG8_STAGE(PG8_SA(0, 1), cA + hstep, voffA);
        if (wr == 1) PG8_BAR;
        PG8_WAIT_V(4); PG8_BAR;
        PG8_STAGE(PG8_SB(1, 0), cB + kstep, voffB); PG8_STAGE(PG8_SA(1, 0), cA + kstep, voffA); PG8_STAGE(PG8_SB(1, 1), cB + hstep + kstep, voffB);
        PG8_WAIT_V(6); PG8_BAR;
    }
    for (;;) {
        const bool has_next = S.next(ui + 1, nxt);
        const char* nA = has_next ? (const char*)g.A + (size_t)nxt.pm * tstep : cA; const char* nB = has_next ? (const char*)g.Bt + (size_t)nxt.pn * tstep : cB;
        for (int t = 0; t < nt; t += 2) {
            const bool last = (t == nt - 2);
            const char* a1 = cA + (size_t)(t + 1) * kstep;
            const char* a2 = last ? nA : cA + (size_t)(t + 2) * kstep; const char* b2 = last ? nB : cB + (size_t)(t + 2) * kstep;
            const char* a3 = a2 + kstep; const char* b3 = b2 + kstep;
            if (last && has_next) S.a_ready(nxt);
            if constexpr (SP2) {
            PG8_LDB(B0, 0, 0); PG8_LDB(B1, 0, 1); PG8_SCHED; PG8_LDA(At, 0, 0); PG8_STAGE(PG8_SA(1, 1), a1 + hstep, voffA);
            PG8_WAIT_V(8); PG8_WAIT_L(0); PG8_BAR; PG8_MMA(0, 0, At, B0); PG8_MMA(0, 1, At, B1); PG8_BAR; PG8_SCHED;
            PG8_LDA(At, 0, 1); PG8_STAGE(PG8_SB(0, 0), b2, voffB); PG8_STAGE(PG8_SB(0, 1), b2 + hstep, voffB); PG8_STAGE(PG8_SA(0, 0), a2, voffA);
            PG8_WAIT_V(8); PG8_WAIT_L(0); PG8_BAR; PG8_MMA(1, 0, At, B0); PG8_MMA(1, 1, At, B1); PG8_BAR; PG8_SCHED;
            PG8_LDB(B0, 1, 0); PG8_LDB(B1, 1, 1); PG8_SCHED; PG8_LDA(At, 1, 0); PG8_STAGE(PG8_SA(0, 1), a2 + hstep, voffA);
            PG8_WAIT_V(8); PG8_WAIT_L(0); PG8_BAR; PG8_MMA(0, 0, At, B0); PG8_MMA(0, 1, At, B1); PG8_BAR; PG8_SCHED;
            PG8_LDA(At, 1, 1); PG8_STAGE(PG8_SB(1, 0), b3, voffB); PG8_STAGE(PG8_SB(1, 1), b3 + hstep, voffB); PG8_STAGE(PG8_SA(1, 0), a3, voffA);
            PG8_WAIT_V(8); PG8_WAIT_L(0); PG8_BAR; PG8_MMA(1, 0, At, B0); PG8_MMA(1, 1, At, B1); PG8_BAR; PG8_SCHED;
            } else {
            PG8_LDB(B0, 0, 0); PG8_SCHED; PG8_LDA(At, 0, 0); PG8_STAGE(PG8_SA(1, 1), a1 + hstep, voffA);
            PG8_WAIT_L(8); PG8_BAR; PG8_WAIT_L(0); PG8_MMA(0, 0, At, B0); PG8_BAR; PG8_SCHED;
            PG8_LDB(B1, 0, 1); PG8_STAGE(PG8_SB(0, 0), b2, voffB);
            PG8_BAR; PG8_WAIT_L(0); PG8_MMA(0, 1, At, B1); PG8_BAR;
            PG8_LDA(At, 0, 1); PG8_STAGE(PG8_SA(0, 0), a2, voffA);
            PG8_BAR; PG8_WAIT_L(0); PG8_MMA(1, 0, At, B0); PG8_BAR; PG8_SCHED;
            PG8_STAGE(PG8_SB(0, 1), b2 + hstep, voffB);
            PG8_WAIT_V(6); PG8_BAR; PG8_MMA(1, 1, At, B1); PG8_BAR;
            PG8_LDB(B0, 1, 0); PG8_SCHED; PG8_LDA(At, 1, 0); PG8_STAGE(PG8_SA(0, 1), a2 + hstep, voffA);
            PG8_WAIT_L(8); PG8_BAR; PG8_WAIT_L(0); PG8_MMA(0, 0, At, B0); PG8_BAR; PG8_SCHED;
            PG8_LDB(B1, 1, 1); PG8_STAGE(PG8_SB(1, 0), b3, voffB);
            PG8_BAR; PG8_WAIT_L(0); PG8_MMA(0, 1, At, B1); PG8_BAR;
            PG8_LDA(At, 1, 1); PG8_STAGE(PG8_SA(1, 0), a3, voffA);
            PG8_BAR; PG8_WAIT_L(0); PG8_MMA(1, 0, At, B0); PG8_BAR; PG8_SCHED;
            PG8_STAGE(PG8_SB(1, 1), b3 + hstep, voffB);
            PG8_WAIT_V(6); PG8_BAR; PG8_MMA(1, 1, At, B1); PG8_BAR;
            }
        }
        if constexpr (ALIGN_EPI) { if (wr == 0) PG8_BAR; }
        if constexpr (!Epi::AFTER_DRAIN) { E(acc, cur, wr, wc, fr, fq); S.done(cur); }
        if (!has_next) break;
#pragma unroll
        for (int a = 0; a < 2; ++a)
#pragma unroll
            for (int b = 0; b < 2; ++b)
#pragma unroll
                for (int m = 0; m < 4; ++m)
#pragma unroll
                    for (int n = 0; n < 2; ++n) acc[a][b][m][n] = (f32x4){0.f, 0.f, 0.f, 0.f};
        cur = nxt; cA = nA; cB = nB; ++ui;
        if constexpr (ALIGN_EPI) { if (wr == 1) PG8_BAR; }
    }
    PG8_WAIT_V(0);
    if constexpr (!ALIGN_EPI) { if (wr == 0) PG8_BAR; }
    PG8_BAR;
    if constexpr (Epi::AFTER_DRAIN) { E.fused(acc, cur, wr, wc, fr, fq, lds, wid, lane); S.done(cur); }
#undef PG8_SA
#undef PG8_SB
#undef PG8_STAGE
#undef PG8_LDA
#undef PG8_LDB
#undef PG8_MMA
#undef PG8_WAIT_V
#undef PG8_WAIT_L
#undef PG8_BAR
#undef PG8_SCHED
}
}
#include <hip/hip_bf16.h>
#include <cmath>
namespace attn_body {
using bf16=__hip_bfloat16;
using bf16x8=__attribute__((ext_vector_type(8)))short;
using s16x4=__attribute__((ext_vector_type(4)))short;
using f32x16=__attribute__((ext_vector_type(16)))float;
using u32x4=__attribute__((ext_vector_type(4)))unsigned;
constexpr int BATCH=8,NHEAD=16,SEQ=2048,D=64,DM=NHEAD*D;
constexpr int NW=8,QBLK=32,QB=QBLK*NW,KVBLK=64,NQB=SEQ/QB;
constexpr int ATTN_PITCH=DM, ATTN_UNIT_ROWS=QB;
__device__ __forceinline__ int crow(int r,int hi){return (r&3)+8*(r>>2)+4*hi;}
#define SBAR() __builtin_amdgcn_sched_barrier(0)
__device__ __forceinline__ void cmask(f32x16&p0,f32x16&p1,int jb,int qrel,int hi){
  const float NEG=-INFINITY; int kb=64*jb+4*hi;
  #pragma unroll
  for(int r=0;r<16;++r){int kv=kb+(r&3)+8*(r>>2); if(kv>qrel)p0[r]=NEG; if(kv+32>qrel)p1[r]=NEG;}
}

constexpr int NSLOT=3, SLOTB=8192;
constexpr int LDS_K=0, LDS_V=NSLOT*SLOTB, LDS_WS=2*NSLOT*SLOTB, LDS_OST=LDS_WS+NW*64*4, LDS_CK=LDS_OST+NW*4096, LDS_BYTES=LDS_CK+SEQ*8;
constexpr float C2=0.125f*1.4426950408889634f;
__device__ __forceinline__ void glds16(const void*gsrc,unsigned lds_dst){unsigned keep;
  asm volatile("s_mov_b32 %0, m0\n\ts_mov_b32 m0, %2\n\ts_nop 0\n\tglobal_load_lds_dwordx4 %1, off\n\ts_mov_b32 m0, %0":"=&s"(keep):"v"(gsrc),"s"(lds_dst):"memory");}
__device__ __forceinline__ float max3f(float a,float b,float c){float r;asm("v_max3_f32 %0, %1, %2, %3":"=v"(r):"v"(a),"v"(b),"v"(c));return r;}
__device__ __forceinline__ float max2f(float a,float b){float r;asm("v_max_f32_e32 %0, %1, %2":"=v"(r):"v"(a),"v"(b));return r;}
__device__ __forceinline__ float fadd_s(float a,float b){float r;asm("v_add_f32_e32 %0, %1, %2":"=v"(r):"v"(a),"v"(b));return r;}
__device__ __forceinline__ float fsub_s(float a,float b){float r;asm("v_sub_f32_e32 %0, %1, %2":"=v"(r):"v"(a),"v"(b));return r;}
typedef float f32x2_t __attribute__((ext_vector_type(2))); typedef __bf16 bf16x2_t __attribute__((ext_vector_type(2)));
__device__ __forceinline__ unsigned cvtpk_s(float lo,float hi){f32x2_t v={lo,hi};bf16x2_t b=__builtin_convertvector(v,bf16x2_t);return __builtin_bit_cast(unsigned,b);}
#define WAIT_BAR(N) asm volatile("s_waitcnt vmcnt(" #N ") lgkmcnt(0)\n\ts_barrier":::"memory")

__device__ __forceinline__ void qkt(f32x16&p0,f32x16&p1,const char*Kslot,const bf16x8*qr,int r32,int hi){
  const char*kb=Kslot+hi*1024+r32*16;
  #pragma unroll
  for(int d0=0;d0<4;++d0){
    const bf16x8 b0=*reinterpret_cast<const bf16x8*>(kb+d0*2048);
    const bf16x8 b1=*reinterpret_cast<const bf16x8*>(kb+d0*2048+512);
    p0=__builtin_amdgcn_mfma_f32_32x32x16_bf16(b0,qr[d0],p0,0,0,0);p1=__builtin_amdgcn_mfma_f32_32x32x16_bf16(b1,qr[d0],p1,0,0,0);}
}
typedef __attribute__((address_space(3))) const char* lds_cptr;
typedef short v4i16_t __attribute__((ext_vector_type(4)));
__device__ __forceinline__ void kload8(bf16x8*kf,lds_cptr kp){
  kf[0]=*(const __attribute__((address_space(3))) bf16x8*)(kp);      kf[1]=*(const __attribute__((address_space(3))) bf16x8*)(kp+512);
  kf[2]=*(const __attribute__((address_space(3))) bf16x8*)(kp+2048); kf[3]=*(const __attribute__((address_space(3))) bf16x8*)(kp+2560);
  kf[4]=*(const __attribute__((address_space(3))) bf16x8*)(kp+4096); kf[5]=*(const __attribute__((address_space(3))) bf16x8*)(kp+4608);
  kf[6]=*(const __attribute__((address_space(3))) bf16x8*)(kp+6144); kf[7]=*(const __attribute__((address_space(3))) bf16x8*)(kp+6656);
}
__device__ __forceinline__ void kload2(bf16x8*kf,lds_cptr kp,int j){ kf[2*j]=*(const __attribute__((address_space(3))) bf16x8*)(kp+j*2048); kf[2*j+1]=*(const __attribute__((address_space(3))) bf16x8*)(kp+j*2048+512); }
__device__ __forceinline__ s16x4 vtr(lds_cptr p){ return __builtin_bit_cast(s16x4,__builtin_amdgcn_ds_read_tr16_b64_v4i16((__attribute__((address_space(3))) v4i16_t*)p)); }
__device__ __forceinline__ float rowmax(const f32x16&p0,const f32x16&p1){
  float a=max3f(p0[0],p0[1],p1[0]),b=max3f(p0[2],p0[3],p1[1]);a=max3f(a,p1[2],p1[3]);
  #pragma unroll
  for(int r=4;r<16;r+=4){a=max3f(a,p0[r],p0[r+1]);b=max3f(b,p0[r+2],p0[r+3]);a=max3f(a,p1[r],p1[r+1]);b=max3f(b,p1[r+2],p1[r+3]);}
  const float m=max2f(a,b);
  auto rr=__builtin_amdgcn_permlane32_swap(__float_as_uint(m),__float_as_uint(m),false,false);
  return max2f(__uint_as_float(rr[0]),__uint_as_float(rr[1]));
}
__device__ __forceinline__ void pv(f32x16*o,int vb,bf16x8 pa0,bf16x8 pa1,bf16x8 pa2,bf16x8 pa3){
  #pragma unroll
  for(int d0=0;d0<2;++d0){s16x4 lo[4],hi[4];
    #pragma unroll
    for(int ks=0;ks<4;++ks){
      asm volatile("ds_read_b64_tr_b16 %0,%1 offset:%c2":"=&v"(lo[ks]):"v"(vb),"i"(d0*4096+ks*1024):"memory");
      asm volatile("ds_read_b64_tr_b16 %0,%1 offset:%c2":"=&v"(hi[ks]):"v"(vb),"i"(d0*4096+ks*1024+512):"memory");}
    asm volatile("s_waitcnt lgkmcnt(0)":::"memory");SBAR();
    #define PK(k) (bf16x8){lo[k][0],lo[k][1],lo[k][2],lo[k][3],hi[k][0],hi[k][1],hi[k][2],hi[k][3]}
    o[d0]=__builtin_amdgcn_mfma_f32_32x32x16_bf16(pa0,PK(0),o[d0],0,0,0);
    o[d0]=__builtin_amdgcn_mfma_f32_32x32x16_bf16(pa1,PK(1),o[d0],0,0,0);
    o[d0]=__builtin_amdgcn_mfma_f32_32x32x16_bf16(pa2,PK(2),o[d0],0,0,0);
    o[d0]=__builtin_amdgcn_mfma_f32_32x32x16_bf16(pa3,PK(3),o[d0],0,0,0);
    #undef PK
  }
}

typedef __attribute__((address_space(3))) const float* lds_fptr;
typedef float f32x4_t __attribute__((ext_vector_type(4)));
typedef unsigned u32x2_t __attribute__((ext_vector_type(2)));
__device__ __forceinline__ unsigned bfr(float f){ const unsigned u=__float_as_uint(f); return (u+0x7fffu+((u>>16)&1u))>>16; }
__device__ __forceinline__ void split3(float v,unsigned&h,unsigned&m,unsigned&l){ h=bfr(v); const float r=v-__uint_as_float(h<<16); m=bfr(r); const float r2=r-__uint_as_float(m<<16); l=bfr(r2); }
__device__ __forceinline__ bf16x8 kxfrag(lds_cptr p){ const u32x2_t w=*(const __attribute__((address_space(3))) u32x2_t*)p; const u32x4 f={w[0],w[1],0xBF80BF80u,0u}; return __builtin_bit_cast(bf16x8,f); }
__device__ __forceinline__ bf16x8 mkqx(float mh,int hi){ unsigned h,m,l; split3(mh,h,m,l); u32x4 f={0x3F803F80u,0x3F80u|(h<<16),m|(l<<16),0u}; if(hi)f=u32x4{0u,0u,0u,0u}; return __builtin_bit_cast(bf16x8,f); }
#ifndef ATTN_STORE16
#define ATTN_STORE16(p,v) (*(u32x4*)(p)=(v))
#endif
template<int THRL> __device__ __forceinline__ void attn_unit(int b,int h,int qb,const bf16*Q,const bf16*__restrict__ K,const bf16*__restrict__ V,const bf16*__restrict__ SG,bf16*O,char*shm,const int tid_in,const bool pre,const bool nxt,const float bref){
  int tid=tid_in; asm volatile("":"+v"(tid));
  const int lane=tid&63,r32=lane&31,hi=lane>>5; const int wid=__builtin_amdgcn_readfirstlane(tid>>6);
  const long rowbase=(long)b*SEQ; const int q0=qb*QB;
  const bf16*Qw=Q+(rowbase+q0+wid*QBLK)*DM+h*D;
  const bf16*Kh=K+rowbase*DM+h*D,*Vh=V+rowbase*DM+h*D;
  const unsigned lds0=(unsigned)(uintptr_t)shm;
  float*wsf=(float*)(shm+LDS_WS)+wid*64;
  const bf16*ksrc=Kh+(long)lane*DM+wid*8;
  const bf16*vsrc=Vh+(long)(16*(wid&3)+(lane>>2))*DM+(wid>>2)*32+(lane&3)*8;
  const unsigned kdst=lds0+LDS_K+wid*1024, vdst=lds0+LDS_V+wid*1024;
  #define DMA_K(t,slot) glds16(ksrc+(long)(t)*KVBLK*DM,(unsigned)__builtin_amdgcn_readfirstlane(kdst+(slot)))
  #define DMA_V(t,slot) glds16(vsrc+(long)(t)*KVBLK*DM,(unsigned)__builtin_amdgcn_readfirstlane(vdst+(slot)))
  const int vb0=(int)(lds0+LDS_V)+((lane>>4)&1)*32+(lane&3)*8+(4*hi+((lane&15)>>2))*64;
  const char*Kbase=shm+LDS_K; bf16x8 kf[8];
  const lds_cptr shm3=(lds_cptr)shm; const lds_cptr kxp=shm3+LDS_CK+r32*8; const lds_cptr kp0=shm3+LDS_K+hi*1024+r32*16; const lds_cptr vp0=shm3+LDS_V+((lane>>4)&1)*32+(lane&3)*8+(4*hi+((lane&15)>>2))*64;
  const int NT=(q0+QB)/KVBLK;
  if(!pre){DMA_K(0,0);DMA_V(0,0);DMA_K(1,SLOTB);}
  bf16x8 qr[4];
  #pragma unroll
  for(int d0=0;d0<4;++d0)qr[d0]=*reinterpret_cast<const bf16x8*>(&Qw[(long)r32*DM+d0*16+hi*8]);
  float l_reg=0.f;f32x16 o[2];o[0]=f32x16{};o[1]=f32x16{};
  const int qrel=wid*QBLK+r32;
  #define CMASK(P0,P1,t) do{int jb_=(t)-(NT-4); if(jb_>=0)cmask(P0,P1,jb_,qrel,hi);}while(0)
  f32x16 pA0,pA1,pB0,pB1;
  int sl_prev=0,sl_cur=0,sl_next=SLOTB;
  #define ROT() do{sl_prev=sl_cur;sl_cur=sl_next;sl_next=(sl_next==(NSLOT-1)*SLOTB)?0:sl_next+SLOTB;}while(0)
  if(!pre){DMA_K(2,2*SLOTB);}
  WAIT_BAR(3);
  float mref; { const u32x2_t w=*(const __attribute__((address_space(3))) u32x2_t*)(shm3+LDS_CK+(q0+wid*QBLK+r32)*8); mref=(__uint_as_float(w[0]<<16)+__uint_as_float(w[0]&0xffff0000u))+__uint_as_float(w[1]<<16)+bref; }
  const bf16x8 qx=mkqx(mref,hi); const f32x16 zero16=f32x16{};
  pA0=__builtin_amdgcn_mfma_f32_32x32x16_bf16(kxfrag(kxp),qx,zero16,0,0,0); pA1=__builtin_amdgcn_mfma_f32_32x32x16_bf16(kxfrag(kxp+256),qx,zero16,0,0,0);
  qkt(pA0,pA1,Kbase,qr,r32,hi);asm volatile("s_nop 15\n\ts_nop 7":"+v"(pA0),"+v"(pA1));CMASK(pA0,pA1,0);
  _Pragma("unroll") for(int r=0;r<16;++r){pA0[r]=__builtin_amdgcn_exp2f(pA0[r]);pA1[r]=__builtin_amdgcn_exp2f(pA1[r]);}
  WAIT_BAR(0);
  DMA_K(3,0);DMA_V(1,SLOTB);
  ROT();
  kload8(kf,kp0+sl_cur);
  WAIT_BAR(2);
  s16x4 vlo[8],vhi[8]; u32x4 pw0,pw1,pw2,pw3;
  #define PKW(P,B) cvtpk_s(P[B],P[B+1])
  #define PAF(k) __builtin_bit_cast(bf16x8,pw##k)
  #define VFR(i) (bf16x8){vlo[i][0],vlo[i][1],vlo[i][2],vlo[i][3],vhi[i][0],vhi[i][1],vhi[i][2],vhi[i][3]}
  #define PIN(x) asm volatile("":"+v"(x))
  #define MX3(a,b,c) __builtin_fmaxf(__builtin_fmaxf((a),(b)),(c))
  #define GAPA(MF,A0,A1,A2,A3,W0,W1,PW) do{ MF; sacc+=A0; sacc+=A1; sacc+=A2; sacc+=A3; PIN(sacc); W0; W1; PIN(PW); SBAR(); }while(0)
  #define EX(v) __builtin_amdgcn_exp2f(v)
  #define GAPB(MF,X,B) do{ MF; X[B]=EX(X[B]); X[B+1]=EX(X[B+1]); X[B+2]=EX(X[B+2]); X[B+3]=EX(X[B+3]); PIN(X); SBAR(); }while(0)
  #define VRD(i) do{ vlo[i]=vtr(vp_+(((i)>>2)*4096+((i)&3)*1024)); vhi[i]=vtr(vp_+(((i)>>2)*4096+((i)&3)*1024+512)); }while(0)
  #define KRD(G,j) do{ if(G){ kload2(kf,kp0+sl_next,j); SBAR(); } }while(0)
  #define STEP(C0,C1,P0,P1,t,GK,GV,GL) do{ SBAR(); \
    const lds_cptr vp_=vp0+sl_prev; \
    C0=__builtin_amdgcn_mfma_f32_32x32x16_bf16(kxfrag(kxp+(t)*512),qx,zero16,0,0,0); C1=__builtin_amdgcn_mfma_f32_32x32x16_bf16(kxfrag(kxp+(t)*512+256),qx,zero16,0,0,0); SBAR(); \
    VRD(0); SBAR(); float sacc=(P0[0]+P0[1]); \
    GAPA(C0=__builtin_amdgcn_mfma_f32_32x32x16_bf16(kf[0],qr[0],C0,0,0,0), P0[2],P0[3],P0[4],P0[5],     pw0[0]=PKW(P0,0), pw0[1]=PKW(P0,2), pw0); \
    VRD(4); SBAR(); GAPA(C1=__builtin_amdgcn_mfma_f32_32x32x16_bf16(kf[1],qr[0],C1,0,0,0), P0[6],P0[7],P0[8],P0[9],     pw0[2]=PKW(P0,4), pw0[3]=PKW(P0,6), pw0); \
    VRD(1); SBAR(); GAPA(C0=__builtin_amdgcn_mfma_f32_32x32x16_bf16(kf[2],qr[1],C0,0,0,0),   P0[10],P0[11],P0[12],P0[13], pw1[0]=PKW(P0,8), pw1[1]=PKW(P0,10), pw1); \
    VRD(5); SBAR(); GAPA(C1=__builtin_amdgcn_mfma_f32_32x32x16_bf16(kf[3],qr[1],C1,0,0,0),   P0[14],P0[15],P1[0],P1[1],   pw1[2]=PKW(P0,12),pw1[3]=PKW(P0,14), pw1); \
    VRD(2); SBAR(); GAPA(C0=__builtin_amdgcn_mfma_f32_32x32x16_bf16(kf[4],qr[2],C0,0,0,0),   P1[2],P1[3],P1[4],P1[5],     pw2[0]=PKW(P1,0), pw2[1]=PKW(P1,2), pw2); \
    VRD(6); SBAR(); GAPA(C1=__builtin_amdgcn_mfma_f32_32x32x16_bf16(kf[5],qr[2],C1,0,0,0),   P1[6],P1[7],P1[8],P1[9],     pw2[2]=PKW(P1,4), pw2[3]=PKW(P1,6), pw2); \
    VRD(3); SBAR(); GAPA(C0=__builtin_amdgcn_mfma_f32_32x32x16_bf16(kf[6],qr[3],C0,0,0,0),   P1[10],P1[11],P1[12],P1[13], pw3[0]=PKW(P1,8), pw3[1]=PKW(P1,10), pw3); \
    VRD(7); SBAR(); GAPA(C1=__builtin_amdgcn_mfma_f32_32x32x16_bf16(kf[7],qr[3],C1,0,0,0),   P1[14],P1[15],0.f,0.f,       pw3[2]=PKW(P1,12),pw3[3]=PKW(P1,14), pw3); \
    l_reg+=sacc; \
    if(GK){DMA_K((t)+3,sl_cur);} if(GV){DMA_V((t)+1,sl_next);} \
    CMASK(C0,C1,t); \
    SBAR(); \
    GAPB(o[0]=__builtin_amdgcn_mfma_f32_32x32x16_bf16(PAF(0),VFR(0),o[0],0,0,0), C0,0); \
    GAPB(o[1]=__builtin_amdgcn_mfma_f32_32x32x16_bf16(PAF(0),VFR(4),o[1],0,0,0), C0,4); \
    KRD(GL,0); GAPB(o[0]=__builtin_amdgcn_mfma_f32_32x32x16_bf16(PAF(1),VFR(1),o[0],0,0,0), C0,8); \
    KRD(GL,1); GAPB(o[1]=__builtin_amdgcn_mfma_f32_32x32x16_bf16(PAF(1),VFR(5),o[1],0,0,0), C0,12); \
    KRD(GL,2); GAPB(o[0]=__builtin_amdgcn_mfma_f32_32x32x16_bf16(PAF(2),VFR(2),o[0],0,0,0), C1,0); \
    KRD(GL,3); GAPB(o[1]=__builtin_amdgcn_mfma_f32_32x32x16_bf16(PAF(2),VFR(6),o[1],0,0,0), C1,4); \
    GAPB(o[0]=__builtin_amdgcn_mfma_f32_32x32x16_bf16(PAF(3),VFR(3),o[0],0,0,0), C1,8); \
    GAPB(o[1]=__builtin_amdgcn_mfma_f32_32x32x16_bf16(PAF(3),VFR(7),o[1],0,0,0), C1,12); \
    }while(0)
  int t=1;
  #undef CMASK
  #define CMASK(P0,P1,t) do{}while(0)
  for(;t+5<NT;t+=2){
    STEP(pB0,pB1,pA0,pA1,t,true,true,true);     WAIT_BAR(2); ROT();
    STEP(pA0,pA1,pB0,pB1,t+1,true,true,true);   WAIT_BAR(2); ROT();
  }
  #undef CMASK
  #define CMASK(P0,P1,t) do{int jb_=(t)-(NT-4); if(jb_>=0)cmask(P0,P1,jb_,qrel,hi);}while(0)
  #define ENDW(tt) do{ if((tt)+3<NT){WAIT_BAR(2);} else if((tt)+2<NT){WAIT_BAR(1);} else {WAIT_BAR(0);} }while(0)
  for(;t+1<NT;t+=2){
    STEP(pB0,pB1,pA0,pA1,t,(t+3<NT),(t+1<NT),(t+1<NT));       ENDW(t);   ROT();
    STEP(pA0,pA1,pB0,pB1,t+1,(t+4<NT),(t+2<NT),(t+2<NT));     ENDW(t+1); ROT();
  }
  STEP(pB0,pB1,pA0,pA1,NT-1,false,false,false);
  u32x4 sgv[4]; { const bf16*SGw=SG+(rowbase+q0+wid*QBLK)*DM+h*D;
    #pragma unroll
    for(int i=0;i<4;++i) sgv[i]=*(const u32x4*)(SGw+(long)(i*8+(lane>>3))*DM+(lane&7)*8); }
  SBAR();
  { float sacc=pB0[0]+pB0[1]; _Pragma("unroll") for(int r=2;r<16;++r)sacc+=pB0[r]; _Pragma("unroll") for(int r=0;r<16;++r)sacc+=pB1[r]; l_reg+=sacc;
    pw0=(u32x4){PKW(pB0,0),PKW(pB0,2),PKW(pB0,4),PKW(pB0,6)};pw1=(u32x4){PKW(pB0,8),PKW(pB0,10),PKW(pB0,12),PKW(pB0,14)};pw2=(u32x4){PKW(pB1,0),PKW(pB1,2),PKW(pB1,4),PKW(pB1,6)};pw3=(u32x4){PKW(pB1,8),PKW(pB1,10),PKW(pB1,12),PKW(pB1,14)};
    SBAR(); pv(o,vb0+sl_cur,PAF(0),PAF(1),PAF(2),PAF(3)); }
  asm volatile("s_waitcnt lgkmcnt(0)\n\ts_barrier":::"memory");
  if(nxt){DMA_K(0,0);DMA_V(0,0);DMA_K(1,SLOTB);DMA_K(2,2*SLOTB);}
  #undef PKW
  #undef PAF
  #undef VFR
  #undef PIN
  #undef MX3
  #undef GAPA
  #undef GAPB
  #undef EX
  #undef VRD
  #undef KRD
  #undef STEP
  #undef ENDW
  {auto rr=__builtin_amdgcn_permlane32_swap(__float_as_uint(l_reg),__float_as_uint(l_reg),false,false);l_reg=__uint_as_float(rr[0])+__uint_as_float(rr[1]);}
  if(hi==0)wsf[32+r32]=l_reg;asm volatile("s_waitcnt lgkmcnt(0)":::"memory");
  float rli[16];
  #pragma unroll
  for(int r=0;r<16;++r)rli[r]=__builtin_amdgcn_rcpf(wsf[32+crow(r,hi)]);
  bf16*Ow=O+(rowbase+q0+wid*QBLK)*DM+h*D;
  { bf16*stg=(bf16*)(shm+LDS_OST)+wid*2048;
    #pragma unroll
    for(int r=0;r<16;++r){const int orow=crow(r,hi);
      #pragma unroll
      for(int d0=0;d0<2;++d0)stg[orow*64+d0*32+r32]=__float2bfloat16(o[d0][r]*rli[r]);}
    asm volatile("s_waitcnt lgkmcnt(0)":::"memory");
    #pragma unroll
    for(int i=0;i<4;++i){const int row=i*8+(lane>>3),ch=lane&7; u32x4 v=*(const u32x4*)(stg+row*64+ch*8); const u32x4 g=sgv[i];
      #pragma unroll
      for(int e=0;e<4;++e){ const float lo=__uint_as_float(v[e]<<16)*__uint_as_float(g[e]<<16), hh=__uint_as_float(v[e]&0xffff0000u)*__uint_as_float(g[e]&0xffff0000u); v[e]=cvtpk_s(lo,hh); }
      ATTN_STORE16(Ow+(long)row*DM+ch*8,v);} }
  asm volatile("s_waitcnt lgkmcnt(0)":::"memory");
  #undef DMA_K
  #undef DMA_V
  #undef CMASK
  #undef ROT
}
constexpr int ATTN_LDS_BYTES=LDS_BYTES;
struct AttnTensors { const bf16* Q; const bf16* K; const bf16* V; const bf16* SG; bf16* O; const float* cumloc; const float* ctot; const float* qg; const float* kg; };
struct AttnUnit { int bh; int qb; };
struct StaticOrder {
  int vcu, G, nb;
  __device__ __forceinline__ explicit StaticOrder(int grid,int block,int nbatch):vcu((grid%8==0)?(block%8)*(grid/8)+block/8:block),G(grid),nb(nbatch){}
  __device__ __forceinline__ bool next(int i,AttnUnit&u)const{
    if(G==2*nb*NHEAD){ if(i>=4)return false; const int s=vcu&1; u.bh=vcu>>1; u.qb=(i==0)?s:(i==1)?7-s:(i==2)?3-s:4+s; return true; }
    const int id=vcu+i*G; if(id>=nb*NHEAD*NQB)return false; u.bh=id/NQB; u.qb=id%NQB; return true; }
  __device__ __forceinline__ void a_ready(const AttnUnit&)const{}
  __device__ __forceinline__ void done(const AttnUnit&)const{}
};
template<class Sched,int THRL=8> __device__ __forceinline__ void attn_phase(char*lds,const AttnTensors&T,const Sched&S,const int tid){
  AttnUnit u,un; int cur_bh=-1; bool pre=false; bool has=S.next(0,u);
  float bref; { float gq=fabsf(T.qg[tid&63]),gk=fabsf(T.kg[tid&63]);
    #pragma unroll
    for(int o=1;o<64;o<<=1){ gq=fmaxf(gq,__shfl_xor(gq,o)); gk=fmaxf(gk,__shfl_xor(gk,o)); }
    bref=8.0f*1.4426950408889634f*gq*gk+1.0f; }
  for(int i=0;has;++i){ S.a_ready(u); const bool hasn=S.next(i+1,un); const bool nxt=hasn&&un.bh==u.bh;
    if(u.bh!=cur_bh){ cur_bh=u.bh;
      int tq=tid; asm volatile("":"+v"(tq));
      const int b_=u.bh/NHEAD,h_=u.bh%NHEAD,l_=tq&31,c_=tq>>4;
      float v=T.ctot[(size_t)(b_*(SEQ/64)+l_)*16+h_];
      #pragma unroll
      for(int o=1;o<32;o<<=1){ const float nn=__shfl_up(v,o,32); if(l_>=o)v+=nn; }
      const float pre=__shfl(v,(c_+31)&31,32); const float base=(c_==0)?0.f:pre;
      const f32x4_t cl=*(const f32x4_t*)(T.cumloc+((size_t)u.bh)*SEQ+4*tq);
      { u32x4 w0,w1; unsigned h_,m_,l_;
        split3(-(cl[0]+base),h_,m_,l_); w0[0]=h_|(m_<<16); w0[1]=l_|0xBF800000u; split3(-(cl[1]+base),h_,m_,l_); w0[2]=h_|(m_<<16); w0[3]=l_|0xBF800000u;
        split3(-(cl[2]+base),h_,m_,l_); w1[0]=h_|(m_<<16); w1[1]=l_|0xBF800000u; split3(-(cl[3]+base),h_,m_,l_); w1[2]=h_|(m_<<16); w1[3]=l_|0xBF800000u;
        *(u32x4*)(lds+LDS_CK+32*tq)=w0; *(u32x4*)(lds+LDS_CK+32*tq+16)=w1; }
      asm volatile("s_waitcnt vmcnt(0) lgkmcnt(0)\n\ts_barrier":::"memory"); }
    attn_unit<THRL>(u.bh/NHEAD,u.bh%NHEAD,u.qb,T.Q,T.K,T.V,T.SG,T.O,lds,tid,pre,nxt,bref); S.done(u); pre=nxt; u=un; has=hasn; }
}
#undef SBAR
#undef WAIT_BAR
}
#define LAS __attribute__((address_space(3)))
typedef unsigned short bf16_t;
typedef short bf16x8_t __attribute__((ext_vector_type(8)));
typedef float f32x4 __attribute__((ext_vector_type(4)));
typedef float f32x2 __attribute__((ext_vector_type(2)));
typedef unsigned u32x4 __attribute__((ext_vector_type(4)));
constexpr int NWAVES = 8;
constexpr int RING_BYTES = 131072, LDS_BYTES = 147456, MISC_OFF = LDS_BYTES - 256;
static_assert(attn_body::LDS_BYTES <= RING_BYTES, "attention scratch must fit the ring region");
constexpr size_t MiB = 1u << 20;
constexpr size_t WS_P = 1 * MiB, WS_CUMLOC = 2 * MiB, WS_CTOT = 3 * MiB, WS_SSM = 4 * MiB, WS_W = 16 * MiB, WS_HB = 52 * MiB;
constexpr size_t WS_B1 = 84 * MiB, WS_B2 = 116 * MiB, WS_B3 = 148 * MiB, WS_B4 = 180 * MiB, WS_Y = 212 * MiB, WS_END = 244 * MiB;
constexpr int W_C0IN = 0, W_C0OUT = 3072, W_FIN = 4096, W_FF = 8192, W_FOUT = 8448, W_SIN = 9472, W_SGLU = 11520, W_SOUT = 12544, W_C1IN = 13568, W_C1OUT = 16640, W_ROWS = 17664;
static_assert(WS_W + (size_t)W_ROWS * 2048 <= WS_HB, "weights fit");

__device__ __forceinline__ unsigned f2bf_(float f) { unsigned u = __builtin_bit_cast(unsigned, f); return (u + 0x7fffu + ((u >> 16) & 1u)) >> 16; }
__device__ __forceinline__ unsigned pk2(float lo, float hi) { return f2bf_(lo) | (f2bf_(hi) << 16); }
__device__ __forceinline__ float wave_sum(float v) {
#pragma unroll
    for (int o = 1; o < 64; o <<= 1) v += __shfl_xor(v, o);
    return v;
}
#define GAS __attribute__((address_space(1)))
#define RLX_AGENT __ATOMIC_RELAXED, __HIP_MEMORY_SCOPE_AGENT
#define LDS_WAIT() asm volatile("s_waitcnt lgkmcnt(0)" ::: "memory")
#define VM_WAIT() asm volatile("s_waitcnt vmcnt(0)" ::: "memory")
#define XB_TMO      128
#define XB_XCNT(j)  (256  + 64 * (j))
#define XB_XSUB(j)  (1280 + 64 * (j))
#define XB_XGEN(j)  (2304 + 64 * (j))
#define XB_TOP      3328
#define XB_TOPGEN   3392
#define XCD_BAR_WORDS 3456
#define XB_SPIN_CAP (1u << 18)

__device__ __forceinline__ unsigned xb_ld(unsigned* p)              { return __hip_atomic_load(p, __ATOMIC_RELAXED, __HIP_MEMORY_SCOPE_AGENT); }
__device__ __forceinline__ unsigned xb_add(unsigned* p, unsigned v) { return __hip_atomic_fetch_add(p, v, __ATOMIC_RELAXED, __HIP_MEMORY_SCOPE_AGENT); }
__device__ __forceinline__ unsigned xb_xcc_id() { return (unsigned)__builtin_amdgcn_s_getreg((3 << 11) | 20) & 0xFu; }
#define XB_SPIN(cond, bar) do { unsigned _sp = 0; while (cond) { __builtin_amdgcn_s_sleep(1); \
    if ((++_sp & 255u) == 0u) { if (xb_ld(&(bar)[XB_TMO])) break; if (_sp > XB_SPIN_CAP) { atomicAdd(&(bar)[XB_TMO], 1u); break; } } } } while (0)

struct XcdBarrier {
    unsigned* bar; unsigned x; unsigned gsz;
    volatile LAS unsigned* st;
};

__device__ __forceinline__ XcdBarrier xcd_barrier_post(unsigned* bar, volatile LAS unsigned* st, const int tid, unsigned gsz) {
    XcdBarrier b; b.bar = bar; b.x = xb_xcc_id(); b.st = st; b.gsz = gsz;
    if (tid == 0) (void)xb_add(&bar[XB_XCNT(b.x)], 1u);
    return b;
}
__device__ __forceinline__ void xcd_barrier_complete(unsigned* bar, unsigned x, unsigned& nloc, unsigned& nx, const unsigned G) {
    unsigned sum, cnt, mine, sp = 0u;
    for (;;) {
        sum = 0u; cnt = 0u; mine = 0u;
#pragma unroll
        for (unsigned j = 0; j < 16; ++j) { const unsigned c = xb_ld(&bar[XB_XCNT(j)]); sum += c; cnt += (c > 0u) ? 1u : 0u; mine = (j == x) ? c : mine; }
        if (sum == G) break;
        __builtin_amdgcn_s_sleep(1);
        if ((++sp & 255u) == 0u) { if (xb_ld(&bar[XB_TMO])) break; if (sp > XB_SPIN_CAP) { atomicAdd(&bar[XB_TMO], 1u); break; } }
    }
    nloc = mine > 0u ? mine : 1u; nx = cnt > 0u ? cnt : 1u;
}

__device__ __forceinline__ void xcd_barrier(const XcdBarrier& b, const int tid) {
    asm volatile("s_waitcnt vmcnt(0)" ::: "memory");
    __syncthreads();
    if (tid == 0) {
        unsigned* bar = b.bar;
        __builtin_amdgcn_s_waitcnt(0);
        unsigned nloc = b.st[0], nx = b.st[1];
        if (nloc == 0u) { xcd_barrier_complete(bar, b.x, nloc, nx, b.gsz); b.st[0] = nloc; b.st[1] = nx; }
        const unsigned old = xb_add(&bar[XB_XSUB(b.x)], 1u);
        const unsigned gen = old / nloc;
        if (old + 1u == (gen + 1u) * nloc) {
            __builtin_amdgcn_fence(__ATOMIC_RELEASE, "agent");
            asm volatile("s_waitcnt vmcnt(0)" ::: "memory");
            const unsigned og = xb_add(&bar[XB_TOP], 1u);
            const unsigned tg = og / nx;
            if (og + 1u == (tg + 1u) * nx) xb_add(&bar[XB_TOPGEN], 1u);
            else XB_SPIN(xb_ld(&bar[XB_TOPGEN]) == tg, bar);
            __builtin_amdgcn_fence(__ATOMIC_ACQUIRE, "agent");
            xb_add(&bar[XB_XGEN(b.x)], 1u);
            asm volatile("s_waitcnt vmcnt(0)" ::: "memory");
        } else {
            XB_SPIN(xb_ld(&bar[XB_XGEN(b.x)]) == gen, bar);
            __builtin_amdgcn_fence(__ATOMIC_ACQUIRE, "agent");
            asm volatile("s_waitcnt vmcnt(0)" ::: "memory");
        }
    }
    __syncthreads();
}

__device__ __forceinline__ int lane_id_fresh() { int r; asm volatile("v_mbcnt_lo_u32_b32 %0, -1, 0\n\tv_mbcnt_hi_u32_b32 %0, -1, %0" : "=v"(r)); return r; }
struct Args { const float* in[25]; float* out; unsigned char* ws; int ph_lo, ph_hi; };

__device__ __forceinline__ int dst_row32(int s, int mode) {
    if (mode == 1) { if (s < 1024) return 256 * (s >> 7) + (s & 127); if (s < 2048) { const int t = s - 1024; return 256 * (t >> 7) + 128 + (t & 127); } return s; }
    if (mode == 2) { const int sec = s >> 10, hd = (s & 1023) >> 6, bj = (s & 63) >> 5, e = s & 31; return 1024 * sec + 256 * (hd >> 2) + 128 * bj + 32 * (hd & 3) + e; }
    return s;
}
__device__ __forceinline__ void p0_transpose_item(const float* W, int ldw, int N, const float* gain, bf16_t* WT, int mode, int item, int lane) {
    const int nblk = N / 64, kb = item / nblk, nb = item % nblk, k0 = 64 * kb, n0 = 64 * nb, q = lane >> 4, nn = lane & 15;
    f32x4 v[16]; f32x4 gk[4];
    const float* src = W + (size_t)(k0 + 16 * q) * ldw + n0 + 4 * nn;
#pragma unroll
    for (int i = 0; i < 16; ++i) v[i] = __builtin_nontemporal_load((const f32x4*)(src + (size_t)i * ldw));
#pragma unroll
    for (int i = 0; i < 4; ++i) gk[i] = (f32x4){1.f, 1.f, 1.f, 1.f};
    if (gain) {
#pragma unroll
        for (int i = 0; i < 4; ++i) gk[i] = *(const f32x4*)(gain + k0 + 16 * q + 4 * i);
    }
#pragma unroll
    for (int i = 0; i < 16; ++i) v[i] = v[i] * gk[i >> 2][i & 3];
#pragma unroll
    for (int e = 0; e < 4; ++e) { const int n = 4 * nn + e, r = dst_row32(n0 + (n & 32), mode) + (n & 31); bf16_t* d = WT + (size_t)r * 1024 + k0 + 16 * q;
#pragma unroll
        for (int h = 0; h < 2; ++h) { u32x4 o; o.x = pk2(v[8 * h][e], v[8 * h + 1][e]); o.y = pk2(v[8 * h + 2][e], v[8 * h + 3][e]); o.z = pk2(v[8 * h + 4][e], v[8 * h + 5][e]); o.w = pk2(v[8 * h + 6][e], v[8 * h + 7][e]);
            *(u32x4*)(d + 8 * h) = o; } }
}
constexpr int P0_I3072 = 16 * 3072 / 64, P0_NITEMS = 2 * (16 * 3072 / 64) + 5 * (16 * 1024 / 64) + 16 * 4096 / 64 + 16 * 2048 / 64;
__device__ __forceinline__ void p0_prologue(const Args& a, LAS unsigned char* lds, int vcu, int G, const int tid, const int item_lo, const int item_hi, const bool do_wf, const int row_lo, const int row_hi) {
    const int lane = tid & 63, wave = __builtin_amdgcn_readfirstlane(tid >> 6);
    const int gw = vcu * NWAVES + wave, NGW = G * NWAVES;
    bf16_t* WB = (bf16_t*)(a.ws + WS_W);
    const float* ng = a.in[1];
    constexpr int I3072 = 16 * 3072 / 64, I1024 = 16 * 1024 / 64, I4096 = 16 * 4096 / 64, I2048 = 16 * 2048 / 64;
    const int NITEMS = item_hi - item_lo;
    const int nfull = NITEMS / NGW, nloop = nfull + ((NITEMS - nfull * NGW) + G * NWAVES - 1) / (G * NWAVES);
    for (int k = 0; k < nloop; ++k) {
        const int it = k < nfull ? k * NGW + gw : nfull * NGW + (k - nfull) * NGW + vcu + G * wave;
        if (it >= NITEMS) continue;
        int r = it + item_lo;
        if (r < I3072) { p0_transpose_item(a.in[2], 3072, 3072, ng, WB + (size_t)W_C0IN * 1024, 1, r, lane); continue; } r -= I3072;
        if (r < I1024) { p0_transpose_item(a.in[7], 1024, 1024, nullptr, WB + (size_t)W_C0OUT * 1024, 0, r, lane); continue; } r -= I1024;
        if (r < I4096) { p0_transpose_item(a.in[8], 4112, 4096, ng + 1024, WB + (size_t)W_FIN * 1024, 2, r, lane); continue; } r -= I4096;
        if (r < I1024) { p0_transpose_item(a.in[12], 1024, 1024, nullptr, WB + (size_t)W_FOUT * 1024, 0, r, lane); continue; } r -= I1024;
        if (r < I2048) { p0_transpose_item(a.in[13], 2048, 2048, ng + 2048, WB + (size_t)W_SIN * 1024, 0, r, lane); continue; } r -= I2048;
        if (r < I1024) { p0_transpose_item(a.in[22], 1024, 1024, nullptr, WB + (size_t)W_SGLU * 1024, 0, r, lane); continue; } r -= I1024;
        if (r < I1024) { p0_transpose_item(a.in[24], 1024, 1024, nullptr, WB + (size_t)W_SOUT * 1024, 0, r, lane); continue; } r -= I1024;
        if (r < I3072) { p0_transpose_item(a.in[2] + (size_t)1024 * 3072, 3072, 3072, ng + 3072, WB + (size_t)W_C1IN * 1024, 1, r, lane); continue; } r -= I3072;
        p0_transpose_item(a.in[7] + (size_t)1024 * 1024, 1024, 1024, nullptr, WB + (size_t)W_C1OUT * 1024, 0, r, lane);
    }
    if (do_wf) for (int e = vcu * 512 + tid; e < 16 * 1024; e += G * 512) { const int n = e >> 10, k = e & 1023; WB[(size_t)(W_FF + n) * 1024 + k] = (bf16_t)f2bf_(a.in[8][(size_t)k * 4112 + 4096 + n] * ng[1024 + k]); }
    bf16_t* hb = (bf16_t*)(a.ws + WS_HB); float* P = (float*)(a.ws + WS_P);
    for (int m0 = row_lo + 4 * gw; m0 < row_hi; m0 += 4 * NGW) {
        f32x4 v[4][4];
#pragma unroll
        for (int r = 0; r < 4; ++r)
#pragma unroll
            for (int j = 0; j < 4; ++j) v[r][j] = __builtin_nontemporal_load(((const f32x4*)(a.in[0] + (size_t)(m0 + r) * 1024)) + lane + 64 * j);
#pragma unroll
        for (int r = 0; r < 4; ++r) { float s = 0.f; unsigned long long* o8 = (unsigned long long*)(hb + (size_t)(m0 + r) * 1024) + lane;
#pragma unroll
            for (int j = 0; j < 4; ++j) { const f32x4 x = v[r][j]; s += (x[0] * x[0] + x[1] * x[1]) + (x[2] * x[2] + x[3] * x[3]);
                o8[64 * j] = (unsigned long long)pk2(x[0], x[1]) | ((unsigned long long)pk2(x[2], x[3]) << 32); }
            s = wave_sum(s);
            if (lane < 4) ((f32x4*)(P + (size_t)(m0 + r) * 16))[lane] = (f32x4){lane == 0 ? s : 0.f, 0.f, 0.f, 0.f}; }
    }
}
__device__ __forceinline__ void conv_phase(LAS unsigned char* lds, const bf16_t* U, const bf16_t* SG, const float* cw, const float* cb, const float* lg, const float* lb, bf16_t* Y, int vcu, int G, const int tid, const int mtok) {
    const int lane = tid & 63, wave = __builtin_amdgcn_readfirstlane(tid >> 6);
    f32x2 w[CONV_K];
#pragma unroll
    for (int j = 0; j < CONV_K; ++j) w[j] = *(const f32x2*)(cw + (size_t)j * 1024 + 2 * tid);
    const f32x2 bias = *(const f32x2*)(cb + 2 * tid);
    LAS float* tile = (LAS float*)lds;
    for (int unit = vcu; unit < mtok / 32; unit += G) {
        const int t0 = unit * 32, seq0 = t0 & ~(SEQ - 1);

        f32x2 out[32];
#pragma unroll
        for (int tt = 0; tt < 32; ++tt) out[tt] = bias;
#pragma unroll
        for (int i = 0; i < 62; ++i) {
            const int row = t0 - 30 + i, rowc = row < seq0 ? seq0 : row;
            const unsigned raw = *(const unsigned*)(U + (size_t)rowc * 1024 + 2 * tid);
            f32x2 uv; uv.x = __uint_as_float(raw << 16); uv.y = __uint_as_float(raw & 0xffff0000u);
            if (row < seq0) uv = (f32x2){0.f, 0.f};
#pragma unroll
            for (int tt = (i > 30 ? i - 30 : 0); tt <= (i < 31 ? i : 31); ++tt) out[tt] += w[i - tt] * uv;
        }
#pragma unroll
        for (int tt = 0; tt < 32; ++tt) *(LAS f32x2*)(tile + tt * 1024 + 2 * tid) = out[tt];
        __syncthreads();
        {
            u32x4 sgv[4][2]; f32x4 gg[4], bbv[4];
#pragma unroll
            for (int q = 0; q < 4; ++q)
#pragma unroll
                for (int hf = 0; hf < 2; ++hf) sgv[q][hf] = __builtin_nontemporal_load((const u32x4*)(SG + (size_t)(t0 + wave * 4 + q) * 1024 + 8 * lane + 512 * hf));
#pragma unroll
            for (int hf = 0; hf < 2; ++hf) { gg[2 * hf] = *(const f32x4*)(lg + 8 * lane + 512 * hf); gg[2 * hf + 1] = *(const f32x4*)(lg + 8 * lane + 512 * hf + 4);
                bbv[2 * hf] = *(const f32x4*)(lb + 8 * lane + 512 * hf); bbv[2 * hf + 1] = *(const f32x4*)(lb + 8 * lane + 512 * hf + 4); }
            f32x4 v[4][4]; float s1[4], s2[4];
#pragma unroll
            for (int q = 0; q < 4; ++q) { const LAS float* tr = tile + (wave * 4 + q) * 1024 + 8 * lane;
                v[q][0] = *(const LAS f32x4*)(tr); v[q][1] = *(const LAS f32x4*)(tr + 4); v[q][2] = *(const LAS f32x4*)(tr + 512); v[q][3] = *(const LAS f32x4*)(tr + 516);
                s1[q] = 0.f; s2[q] = 0.f;
#pragma unroll
                for (int j = 0; j < 4; ++j) { s1[q] += (v[q][j][0] + v[q][j][1]) + (v[q][j][2] + v[q][j][3]); s2[q] += (v[q][j][0] * v[q][j][0] + v[q][j][1] * v[q][j][1]) + (v[q][j][2] * v[q][j][2] + v[q][j][3] * v[q][j][3]); } }
#pragma unroll
            for (int o = 1; o < 64; o <<= 1)
#pragma unroll
                for (int q = 0; q < 4; ++q) { s1[q] += __shfl_xor(s1[q], o); s2[q] += __shfl_xor(s2[q], o); }
#pragma unroll
            for (int q = 0; q < 4; ++q) {
                const float mu = s1[q] * (1.0f / 1024.0f), var = fmaxf(s2[q] * (1.0f / 1024.0f) - mu * mu, 0.f), rstd = rsqrtf(var + LN_EPS);
                const size_t off = (size_t)(t0 + wave * 4 + q) * 1024 + 8 * lane;
#pragma unroll
                for (int hf = 0; hf < 2; ++hf) { const u32x4 sg = sgv[q][hf];
                    const f32x4 y0 = (v[q][2 * hf] - mu) * rstd * gg[2 * hf] + bbv[2 * hf], y1 = (v[q][2 * hf + 1] - mu) * rstd * gg[2 * hf + 1] + bbv[2 * hf + 1]; u32x4 o;
                    o.x = pg8::cvt_pk_bf16(pg8::silu(y0[0]) * pg8::bflo(sg.x), pg8::silu(y0[1]) * pg8::bfhi(sg.x));
                    o.y = pg8::cvt_pk_bf16(pg8::silu(y0[2]) * pg8::bflo(sg.y), pg8::silu(y0[3]) * pg8::bfhi(sg.y));
                    o.z = pg8::cvt_pk_bf16(pg8::silu(y1[0]) * pg8::bflo(sg.z), pg8::silu(y1[1]) * pg8::bfhi(sg.z));
                    o.w = pg8::cvt_pk_bf16(pg8::silu(y1[2]) * pg8::bflo(sg.w), pg8::silu(y1[3]) * pg8::bfhi(sg.w));
                    *(u32x4*)(Y + off + 512 * hf) = o; }
            }
        }
        __syncthreads();
    }
}
__device__ __forceinline__ void fcum_phase(LAS unsigned char* lds, const bf16_t* hb, const bf16_t* Wf, const float* P, const float* fbias, float* cumloc, float* ctot, int vcu, int G, const int tid, const int mtok) {
    const int lane = tid & 63, wave = __builtin_amdgcn_readfirstlane(tid >> 6);
    LAS float* part = (LAS float*)lds;
    LAS float* lf = part + 2 * 64 * 17;
    for (int ch = vcu; ch < mtok / 64; ch += G) {
        f32x4 pq[2][4];
#pragma unroll
        for (int e = 0; e < 2; ++e) { const f32x4* pp = (const f32x4*)(P + (size_t)(ch * 64 + ((tid + 512 * e) >> 4)) * 16); pq[e][0] = pp[0]; pq[e][1] = pp[1]; pq[e][2] = pp[2]; pq[e][3] = pp[3]; }
        {
            const int tg = wave & 3, kh = wave >> 2, tok0 = ch * 64 + tg * 16;
            const bf16_t* ap = hb + (size_t)(tok0 + (lane & 15)) * 1024 + kh * 512 + 8 * (lane >> 4);
            const bf16_t* bp = Wf + (size_t)(lane & 15) * 1024 + kh * 512 + 8 * (lane >> 4);
            bf16x8_t av[16], bv[16];
#pragma unroll
            for (int ks = 0; ks < 16; ++ks) { av[ks] = *(const bf16x8_t*)(ap + ks * 32); bv[ks] = *(const bf16x8_t*)(bp + ks * 32); }
            f32x4 acc = (f32x4){0.f, 0.f, 0.f, 0.f};
#pragma unroll
            for (int ks = 0; ks < 16; ++ks) acc = __builtin_amdgcn_mfma_f32_16x16x32_bf16(av[ks], bv[ks], acc, 0, 0, 0);
#pragma unroll
            for (int r = 0; r < 4; ++r) part[(kh * 64 + tg * 16 + 4 * (lane >> 4) + r) * 17 + (lane & 15)] = acc[r];
        }
        __syncthreads();
#pragma unroll
        for (int e = 0; e < 2; ++e) {
            const int idx = tid + 512 * e, tl = idx >> 4, h = idx & 15;
            const f32x4 p0 = pq[e][0], p1 = pq[e][1], p2 = pq[e][2], p3 = pq[e][3];
            const float ss = ((p0[0] + p0[1]) + (p0[2] + p0[3])) + ((p1[0] + p1[1]) + (p1[2] + p1[3])) + ((p2[0] + p2[1]) + (p2[2] + p2[3])) + ((p3[0] + p3[1]) + (p3[2] + p3[3]));
            const float x = (part[tl * 17 + h] + part[(64 + tl) * 17 + h]) * rsqrtf(ss * (1.0f / 1024.0f) + RMS_EPS) + fbias[h];
            lf[tl * 17 + h] = (fminf(x, 0.f) - log1pf(__expf(-fabsf(x)))) * LOG2E; }
        __syncthreads();
#pragma unroll
        for (int e = 0; e < 2; ++e) {
            const int h = 2 * wave + e; float c = lf[lane * 17 + h];
#pragma unroll
            for (int o = 1; o < 64; o <<= 1) { const float nn = __shfl_up(c, o); if (lane >= o) c += nn; }
            const int b = ch / (SEQ / 64), cc = ch % (SEQ / 64);
            cumloc[((size_t)(b * NHEADS + h)) * SEQ + cc * 64 + lane] = c;
            if (lane == 63) ctot[(size_t)ch * 16 + h] = c; }
        __syncthreads();
    }
}
constexpr int SSM_OFF_BM = 0, SSM_OFF_PW = 65536, SSM_OFF_KT = SSM_OFF_PW + 2560, SSM_OFF_CM = SSM_OFF_KT + 8704, SSM_GS = SSM_OFF_CM + 65536;
constexpr size_t WS_SSM_PN = 13 * MiB;
static_assert(WS_SSM + (size_t)NGRP * SSM_GS <= WS_SSM_PN && SSM_GS <= MISC_OFF, "ssm tables");

__device__ __forceinline__ f32x4 cmul2(const f32x4 a, const f32x4 x) { return (f32x4){a[0] * x[0] - a[1] * x[1], a[0] * x[1] + a[1] * x[0], a[2] * x[2] - a[3] * x[3], a[2] * x[3] + a[3] * x[2]}; }
template <int CTRL> __device__ __forceinline__ float dpp_f(float v) { return __builtin_bit_cast(float, __builtin_amdgcn_update_dpp(0, __builtin_bit_cast(int, v), CTRL, 0xf, 0xf, true)); }
template <int CTRL> __device__ __forceinline__ f32x4 dpp4(const f32x4 v) { return (f32x4){dpp_f<CTRL>(v[0]), dpp_f<CTRL>(v[1]), dpp_f<CTRL>(v[2]), dpp_f<CTRL>(v[3])}; }

__device__ __forceinline__ void ssm_tables(const Args& a, LAS unsigned char* lds, int vcu, int G, const int tid) {
    const float* log_dt = a.in[14]; const float* a_re = a.in[15]; const float* a_im = a.in[16]; const float* b_re = a.in[17]; const float* b_im = a.in[18];
    const float* c_re = a.in[19]; const float* c_im = a.in[20];
    LAS float* pw = (LAS float*)lds;
    LAS float* bb = pw + 17 * 64 * 2;
    LAS float* big = bb + 64 * 17 * 2;
    LAS float* cc = big + 21 * 64 * 2;
    LAS float* zz = cc + 16 * 65 * 2;
    for (int unit = vcu; unit < 4 * NGRP; unit += G) {
        const int g = unit >> 2, sub = unit & 3;
        __syncthreads();
        if (tid < 64) {
            const int p = tid; const double dt = exp((double)log_dt[g]);
            const float are = a_re[g * 64 + p], aim = a_im[g * 64 + p], x = are * (float)dt;
            double ang = (double)aim * dt; ang -= 6.283185307179586 * rint(ang * 0.15915494309189535);
            float sn, cs, sh, ch; sincosf((float)ang, &sn, &cs); sincosf(0.5f * (float)ang, &sh, &ch);
            const float em1 = expm1f(x), mag = em1 + 1.0f, abr = mag * cs, abi = mag * sn;
            const float nr = em1 * cs - 2.0f * sh * sh, ni = mag * sn, den = are * are + aim * aim;
            zz[p * 2] = (nr * are + ni * aim) / den; zz[p * 2 + 1] = (ni * are - nr * aim) / den;
            float pr = 1.0f, pi = 0.0f;
#pragma unroll
            for (int l = 0; l <= 16; ++l) { pw[(l * 64 + p) * 2] = pr; pw[(l * 64 + p) * 2 + 1] = pi; const float t = pr * abr - pi * abi; pi = pr * abi + pi * abr; pr = t; }
            float qr = pw[(16 * 64 + p) * 2], qi = pw[(16 * 64 + p) * 2 + 1]; const float ar16 = qr, ai16 = qi;
#pragma unroll
            for (int d = 0; d < 5; ++d) { big[(d * 64 + p) * 2] = qr; big[(d * 64 + p) * 2 + 1] = qi; const float t = qr * qr - qi * qi; qi = 2.0f * qr * qi; qr = t; }
            qr = 1.0f; qi = 0.0f;
#pragma unroll
            for (int n = 0; n < 16; ++n) { big[((5 + n) * 64 + p) * 2] = qr; big[((5 + n) * 64 + p) * 2 + 1] = qi; const float t = qr * ar16 - qi * ai16; qi = qr * ai16 + qi * ar16; qr = t; }
        } else {
            for (int job = tid - 64; job < 1024; job += 448) { const int c = job >> 6, p = job & 63; cc[(c * 65 + p) * 2] = c_re[(size_t)g * 1024 + job]; cc[(c * 65 + p) * 2 + 1] = c_im[(size_t)g * 1024 + job]; }
        }
        __syncthreads();
        for (int job = tid; job < 1024; job += 512) { const int p = job >> 4, c = job & 15; const float zr = zz[p * 2], zi = zz[p * 2 + 1];
            const float br = b_re[(size_t)g * 1024 + job], bi = b_im[(size_t)g * 1024 + job];
            bb[(p * 17 + c) * 2] = zr * br - zi * bi; bb[(p * 17 + c) * 2 + 1] = zr * bi + zi * br; }
        __syncthreads();
        unsigned char* gb = a.ws + WS_SSM + (size_t)g * SSM_GS;
        for (int job = tid; job < 1024; job += 512) {
            const int fl = job >> 6, l = job & 63, rt = 2 * sub + (fl >> 3), s = fl & 7, R = 16 * rt + (l & 15), p = R >> 1, part = R & 1, j = 2 * s + (l >> 5), c0 = 8 * ((l >> 4) & 1);
            const float pr = pw[((15 - j) * 64 + p) * 2], pi = pw[((15 - j) * 64 + p) * 2 + 1]; float v[8];
#pragma unroll
            for (int e = 0; e < 8; ++e) { const float xr = bb[(p * 17 + c0 + e) * 2], xi = bb[(p * 17 + c0 + e) * 2 + 1]; v[e] = part ? (pr * xi + pi * xr) : (pr * xr - pi * xi); }
            *(u32x4*)(gb + SSM_OFF_BM + ((rt * 8 + s) * 64 + l) * 16) = (u32x4){pk2(v[0], v[1]), pk2(v[2], v[3]), pk2(v[4], v[5]), pk2(v[6], v[7])}; }
        for (int job = tid; job < 1024; job += 512) {
            const int fl = job >> 6, l = job & 63, i = 4 * sub + (fl >> 2), s = fl & 3, c = l & 15, q = l >> 4; float v[8];
#pragma unroll
            for (int e = 0; e < 8; ++e) { const int R = 16 * (2 * s + (e >> 2)) + 4 * q + (e & 3), p = R >> 1, part = R & 1;
                const float cr = cc[(c * 65 + p) * 2], ci = cc[(c * 65 + p) * 2 + 1], pr = pw[((i + 1) * 64 + p) * 2], pi = pw[((i + 1) * 64 + p) * 2 + 1];
                v[e] = part ? -(cr * pi + ci * pr) : (cr * pr - ci * pi); }
            *(u32x4*)(gb + SSM_OFF_CM + ((i * 4 + s) * 64 + l) * 16) = (u32x4){pk2(v[0], v[1]), pk2(v[2], v[3]), pk2(v[4], v[5]), pk2(v[6], v[7])}; }
        for (int idx = sub + 4 * tid; idx < 17 * 256; idx += 2048) {
            const int lagi = idx >> 8, c = (idx >> 4) & 15, c2 = idx & 15; float acc = 0.f;
            if (lagi > 0) {
#pragma unroll 16
                for (int p = 0; p < 64; ++p) { const float cr = cc[(c * 65 + p) * 2], ci = cc[(c * 65 + p) * 2 + 1], pr = pw[((lagi - 1) * 64 + p) * 2], pi = pw[((lagi - 1) * 64 + p) * 2 + 1];
                    const float tr = cr * pr - ci * pi, ti = cr * pi + ci * pr; acc += tr * bb[(p * 17 + c2) * 2] - ti * bb[(p * 17 + c2) * 2 + 1]; }
            }
            *(bf16_t*)(gb + SSM_OFF_KT + idx * 2) = (bf16_t)f2bf_(acc); }
        if (sub == 0) for (int job = tid; job < 21 * 32; job += 512) {
            const int d = job >> 5, rt = (job >> 2) & 7, q = job & 3, p0 = 8 * rt + 2 * q;
            const f32x4 v = (f32x4){big[(d * 64 + p0) * 2], big[(d * 64 + p0) * 2 + 1], big[(d * 64 + p0 + 1) * 2], big[(d * 64 + p0 + 1) * 2 + 1]};
            if (d < 5) *(f32x4*)(gb + SSM_OFF_PW + ((d * 8 + rt) * 4 + q) * 16) = v;
            else *(f32x4*)(a.ws + WS_SSM_PN + ((((size_t)g * 8 + rt) * 16 + (d - 5)) * 4 + q) * 16) = v; }
    }
}
constexpr int SSM_OFF_EX = SSM_GS;
static_assert(SSM_OFF_EX + 8 * 128 * 4 <= MISC_OFF, "ssm exchange area");
__device__ __forceinline__ void ssm_phase(LAS unsigned char* lds, unsigned char* ws, const bf16_t* U, const float* dsk, bf16_t* GO, int vcu, int G, const int tid, const int nsub) {
    const int lane = tid & 63, wave = __builtin_amdgcn_readfirstlane(tid >> 6), n = lane & 15, q = lane >> 4;
    for (int unit = vcu; unit < nsub * NGRP; unit += G) {
        const int g = unit / nsub, sub = unit % nsub;
        __syncthreads();
        { const unsigned char* gb = ws + WS_SSM + (size_t)g * SSM_GS;
          constexpr int NFULL = SSM_GS / 8192, TAIL = SSM_GS - NFULL * 8192; u32x4 tv[NFULL + 1];
#pragma unroll
          for (int it = 0; it < NFULL; ++it) tv[it] = ((const u32x4*)(gb + it * 8192))[tid];
          tv[NFULL] = ((const u32x4*)(gb + NFULL * 8192))[tid < TAIL / 16 ? tid : 0];
#pragma unroll
          for (int it = 0; it < NFULL; ++it) ((LAS u32x4*)(lds + it * 8192))[tid] = tv[it];
          if (tid < TAIL / 16) ((LAS u32x4*)(lds + NFULL * 8192))[tid] = tv[NFULL]; }
        __syncthreads();
        const int pair = sub * 8 + wave, b = pair >> 2, seg = pair & 3;
        const LAS f32x4* PW = (const LAS f32x4*)(lds + SSM_OFF_PW);
        const f32x4* PN = (const f32x4*)(ws + WS_SSM_PN) + (size_t)g * 8 * 16 * 4;
#define A16(rt) (PW[(4 * 8 + (rt)) * 4 + QQ])
#define QQ q
        const int tokb = b * SEQ + seg * 512;
        const bf16_t* Ub = U + (size_t)tokb * 1024 + g * 16; bf16_t* Gb = GO + (size_t)tokb * 1024 + g * 16;
        unsigned uoff = (unsigned)((16 * n + (lane >> 5)) * 1024 + 8 * ((lane >> 4) & 1)), eoff = (unsigned)(16 * n * 1024 + 4 * q);
        f32x4 I0[8], I1[8];
        {
            bf16x8_t uf[8];
#pragma unroll
            for (int s = 0; s < 8; ++s) uf[s] = *(const bf16x8_t*)((Ub + (2 * s) * 1024) + uoff);
            bf16x8_t fa[2][8];
#pragma unroll
            for (int s = 0; s < 8; ++s) fa[0][s] = *(const LAS bf16x8_t*)(lds + SSM_OFF_BM + ((0 * 8 + s) * 64 + lane) * 16);
#pragma unroll
            for (int rt = 0; rt < 8; ++rt) { I0[rt] = (f32x4){0.f, 0.f, 0.f, 0.f};
                if (rt < 7) {
#pragma unroll
                    for (int s = 0; s < 8; ++s) fa[(rt + 1) & 1][s] = *(const LAS bf16x8_t*)(lds + SSM_OFF_BM + (((rt + 1) * 8 + s) * 64 + lane) * 16);
                }
                __builtin_amdgcn_sched_barrier(0);
#pragma unroll
                for (int s = 0; s < 8; ++s) I0[rt] = __builtin_amdgcn_mfma_f32_16x16x32_bf16(fa[rt & 1][s], uf[s], I0[rt], 0, 0, 0);
                __builtin_amdgcn_sched_barrier(0); }
#pragma unroll
            for (int s = 0; s < 8; ++s) uf[s] = *(const bf16x8_t*)((Ub + (256 + 2 * s) * 1024) + uoff);
#pragma unroll
            for (int s = 0; s < 8; ++s) fa[0][s] = *(const LAS bf16x8_t*)(lds + SSM_OFF_BM + ((0 * 8 + s) * 64 + lane) * 16);
#pragma unroll
            for (int rt = 0; rt < 8; ++rt) { I1[rt] = (f32x4){0.f, 0.f, 0.f, 0.f};
                if (rt < 7) {
#pragma unroll
                    for (int s = 0; s < 8; ++s) fa[(rt + 1) & 1][s] = *(const LAS bf16x8_t*)(lds + SSM_OFF_BM + (((rt + 1) * 8 + s) * 64 + lane) * 16);
                }
                __builtin_amdgcn_sched_barrier(0);
#pragma unroll
                for (int s = 0; s < 8; ++s) I1[rt] = __builtin_amdgcn_mfma_f32_16x16x32_bf16(fa[rt & 1][s], uf[s], I1[rt], 0, 0, 0);
                __builtin_amdgcn_sched_barrier(0); }
        }
#pragma unroll
        for (int rt = 0; rt < 8; ++rt) { const f32x4 an = PN[(rt * 16 + (15 - n)) * 4 + q];
            f32x4 t0 = cmul2(an, I0[rt]), t1 = cmul2(an, I1[rt]);
            t0 = t0 + dpp4<0x128>(t0); t0 = t0 + dpp4<0x124>(t0); t0 = t0 + dpp4<0x122>(t0); t0 = t0 + dpp4<0x121>(t0);
            t1 = t1 + dpp4<0x128>(t1); t1 = t1 + dpp4<0x124>(t1); t1 = t1 + dpp4<0x122>(t1); t1 = t1 + dpp4<0x121>(t1);
            const f32x4 e = cmul2(A16(rt), t0) + t1;
            if (n == 0) *(LAS f32x4*)(lds + SSM_OFF_EX + wave * 512 + (rt * 4 + q) * 16) = e; }
        __syncthreads();
#undef QQ
#define QQ qb_
        int tqb = tid; asm volatile("" : "+v"(tqb));
        const int laneb = tqb & 63, nb_ = laneb & 15, qb_ = laneb >> 4;
        unsigned uoffb = (unsigned)((16 * nb_ + (laneb >> 5)) * 1024 + 8 * ((laneb >> 4) & 1)), eoffb = (unsigned)(16 * nb_ * 1024 + 4 * qb_);
        f32x4 carry[8];
#pragma unroll
        for (int rt = 0; rt < 8; ++rt) carry[rt] = (f32x4){0.f, 0.f, 0.f, 0.f};
        for (int m = 0; m < seg; ++m) {
#pragma unroll
            for (int rt = 0; rt < 8; ++rt) { const f32x4 a16 = A16(rt); const f32x4 a32 = cmul2(a16, a16); const f32x4 e = *(const LAS f32x4*)(lds + SSM_OFF_EX + (wave - seg + m) * 512 + (rt * 4 + qb_) * 16);
                carry[rt] = cmul2(a32, carry[rt]) + e; }
        }
        __syncthreads();
        const f32x4 dv = *(const f32x4*)(dsk + g * 16 + 4 * qb_);
#pragma unroll
        for (int rt = 0; rt < 8; ++rt) *(LAS f32x4*)(lds + SSM_OFF_BM + wave * 8192 + (rt * 64 + laneb) * 16) = I1[rt];
#pragma unroll
        for (int batch = 0; batch < 2; ++batch) {
            f32x4 (&I)[8] = I0;
            asm volatile("" : "+v"(uoffb), "+v"(eoffb));
            if (batch == 1) {
#pragma unroll
                for (int rt = 0; rt < 8; ++rt) { I0[rt] = *(const LAS f32x4*)(lds + SSM_OFF_BM + wave * 8192 + (rt * 64 + laneb) * 16); carry[rt] = *(const LAS f32x4*)(lds + SSM_OFF_EX + wave * 512 + (rt * 4 + qb_) * 16); }
            }
#pragma unroll
            for (int rt = 0; rt < 8; ++rt) I[rt] = I[rt] + cmul2(PW[(0 * 8 + rt) * 4 + qb_], dpp4<0x111>(I[rt]));
#pragma unroll
            for (int rt = 0; rt < 8; ++rt) I[rt] = I[rt] + cmul2(PW[(1 * 8 + rt) * 4 + qb_], dpp4<0x112>(I[rt]));
#pragma unroll
            for (int rt = 0; rt < 8; ++rt) I[rt] = I[rt] + cmul2(PW[(2 * 8 + rt) * 4 + qb_], dpp4<0x114>(I[rt]));
#pragma unroll
            for (int rt = 0; rt < 8; ++rt) I[rt] = I[rt] + cmul2(PW[(3 * 8 + rt) * 4 + qb_], dpp4<0x118>(I[rt]));
            bf16x8_t sf[4];
#pragma unroll
            for (int s = 0; s < 4; ++s) {
                const f32x4 p0 = dpp4<0x111>(I[2 * s]) + cmul2(PN[((2 * s) * 16 + nb_) * 4 + qb_], carry[2 * s]);
                const f32x4 p1 = dpp4<0x111>(I[2 * s + 1]) + cmul2(PN[((2 * s + 1) * 16 + nb_) * 4 + qb_], carry[2 * s + 1]);
                const u32x4 w = (u32x4){pg8::cvt_pk_bf16(p0[0], p0[1]), pg8::cvt_pk_bf16(p0[2], p0[3]), pg8::cvt_pk_bf16(p1[0], p1[1]), pg8::cvt_pk_bf16(p1[2], p1[3])};
                sf[s] = __builtin_bit_cast(bf16x8_t, w);
            }
            if (batch == 0) {
#pragma unroll
                for (int rt = 0; rt < 8; ++rt) { const f32x4 last = (f32x4){__shfl(I[rt][0], 15, 16), __shfl(I[rt][1], 15, 16), __shfl(I[rt][2], 15, 16), __shfl(I[rt][3], 15, 16)};
                    const f32x4 cn = cmul2(A16(rt), carry[rt]) + last; if (nb_ == 0) *(LAS f32x4*)(lds + SSM_OFF_EX + wave * 512 + (rt * 4 + qb_) * 16) = cn; }
            }
            bf16x8_t uf[8];
#pragma unroll
            for (int s = 0; s < 8; ++s) uf[s] = *(const bf16x8_t*)((Ub + (batch * 256 + 2 * s) * 1024) + uoffb);
            uint2 uwv[16]; bf16x8_t fc[4], kt[16];
#define SSM_LDC(ii) do { _Pragma("unroll") for (int s = 0; s < 4; ++s) fc[s] = *(const LAS bf16x8_t*)(lds + SSM_OFF_CM + (((ii) * 4 + s) * 64 + laneb) * 16); } while (0)
#define SSM_LDK(f) (*(const LAS bf16x8_t*)(lds + SSM_OFF_KT + (((f) + 1 - (laneb >> 5)) * 256 + (laneb & 15) * 16 + 8 * ((laneb >> 4) & 1)) * 2))
#pragma unroll
            for (int i = 0; i < 4; ++i) uwv[i] = *(const uint2*)((Ub + (batch * 256 + i) * 1024) + eoffb);
            SSM_LDC(0); kt[0] = SSM_LDK(0);
#pragma unroll
            for (int i = 0; i < 16; ++i) {
                __builtin_amdgcn_sched_barrier(0);
                f32x4 acc = (f32x4){0.f, 0.f, 0.f, 0.f};
#pragma unroll
                for (int s = 0; s < 4; ++s) acc = __builtin_amdgcn_mfma_f32_16x16x32_bf16(fc[s], sf[s], acc, 0, 0, 0);
                __builtin_amdgcn_sched_barrier(0);
                if (i + 1 < 16) { SSM_LDC(i + 1); kt[i + 1] = SSM_LDK(i + 1); }
                if (i + 4 < 16) uwv[i + 4] = *(const uint2*)((Ub + (batch * 256 + i + 4) * 1024) + eoffb);
                __builtin_amdgcn_sched_barrier(0);
#pragma unroll
                for (int s = 0; s <= i / 2; ++s) acc = __builtin_amdgcn_mfma_f32_16x16x32_bf16(kt[i - 2 * s], uf[s], acc, 0, 0, 0);
                const uint2 uw = uwv[i];
                const float y[4] = {acc[0] + dv[0] * pg8::bflo(uw.x), acc[1] + dv[1] * pg8::bfhi(uw.x), acc[2] + dv[2] * pg8::bflo(uw.y), acc[3] + dv[3] * pg8::bfhi(uw.y)};
                float ge[4];
#pragma unroll
                for (int r = 0; r < 4; ++r) ge[r] = y[r] * pg8::sigm(1.5957691216057308f * (y[r] + 0.044715f * y[r] * y[r] * y[r]));
                *(uint2*)((Gb + (batch * 256 + i) * 1024) + eoffb) = make_uint2(pg8::cvt_pk_bf16(ge[0], ge[1]), pg8::cvt_pk_bf16(ge[2], ge[3]));
                __builtin_amdgcn_sched_barrier(0);
            }
#undef SSM_LDC
#undef SSM_LDK
        }
#undef A16
#undef QQ
    }
}

template <class Epi> __device__ __forceinline__ void run_gemm(LAS unsigned char* lds, const bf16_t* A, const bf16_t* Bt, int N, const Epi& E, int G, const int tid, const int mtok, const int lb) {
    pg8::Gemm g{A, Bt, mtok, N, 1024}; pg8::StaticOrder S; S.init(mtok, N, G, lb);
    pg8::gemm_phase<Epi, pg8::StaticOrder, true, true>(lds, g, S, E, tid);
}
__global__ void __launch_bounds__(NWAVES * 64, 2) mega_fwd(Args args) {
    extern __shared__ __attribute__((aligned(16))) unsigned char lds_raw[];
    LAS unsigned char* lds = (LAS unsigned char*)lds_raw;
    const int G = gridDim.x, bx = blockIdx.x, vcu = (G % 8 == 0) ? (bx % 8) * (G / 8) + bx / 8 : bx;
    const int wave = __builtin_amdgcn_readfirstlane((int)threadIdx.x >> 6);
#define TID() (wave * 64 + lane_id_fresh())
    const int NH = (G == 256) ? 2 : 1, hh = NH == 2 ? (bx >> 3) & 1 : 0, lb = NH == 2 ? ((bx >> 4) << 3) | (bx & 7) : bx, GL = G / NH;
    const int vcl = (GL % 8 == 0) ? (lb % 8) * (GL / 8) + lb / 8 : lb, ML = MTOK / NH, BL = BATCH / NH;
    unsigned char* ws = args.ws;
    bf16_t* WB = (bf16_t*)(ws + WS_W);
    const size_t ro = (size_t)hh * ML;
    bf16_t* HB = (bf16_t*)(ws + WS_HB) + ro * 1024;
    bf16_t* B1 = (bf16_t*)(ws + WS_B1) + ro * 1024; bf16_t* B2 = (bf16_t*)(ws + WS_B2) + ro * 1024; bf16_t* B3 = (bf16_t*)(ws + WS_B3) + ro * 1024; bf16_t* B4 = (bf16_t*)(ws + WS_B4) + ro * 1024; bf16_t* YB = (bf16_t*)(ws + WS_Y) + ro * 1024;
    float* P = (float*)(ws + WS_P) + ro * 16; float* cumloc = (float*)(ws + WS_CUMLOC) + (size_t)hh * BL * NHEADS * SEQ; float* ctot = (float*)(ws + WS_CTOT) + (size_t)hh * (ML / 64) * 16;
    float* outp = args.out + ro * 1024;
    const int lo = args.ph_lo, hi = args.ph_hi;
#define IN(k) (lo <= (k) && (k) < hi)
    { const int t_ = TID(); if (t_ < 64) ((LAS unsigned*)(lds + MISC_OFF))[t_] = 0u; __syncthreads(); }
    XcdBarrier bar; bar.bar = (unsigned*)ws + hh * 4096; bar.x = 0; bar.st = nullptr; bar.gsz = 0;
    if (hi - lo > 1) bar = xcd_barrier_post((unsigned*)ws + hh * 4096, (volatile LAS unsigned*)(lds + MISC_OFF + 32), TID(), (unsigned)GL);
    if (lo < 0) cg::this_grid().sync();
#define SEAM(k) do { if (IN(k) && IN((k) + 1)) xcd_barrier(bar, TID()); } while (0)
    unsigned* const flg = (unsigned*)ws + 3 * 4096;
#define FLAG_WAIT(w) do { if (TID() == 0) { XB_SPIN(xb_ld(flg + (w)) == 0u, bar.bar); } } while (0)
#define FLAG_SET(w) do { if (lb == 0 && TID() == 0) __hip_atomic_store(flg + (w), 1u, __ATOMIC_RELAXED, __HIP_MEMORY_SCOPE_AGENT); } while (0)
    if (IN(0)) {
        if (NH == 2) { if (hh == 0) p0_prologue(args, lds, vcl, GL, TID(), 0, P0_I3072, false, 0, ML);
                       else { ssm_tables(args, lds, vcl, GL, TID()); p0_prologue(args, lds, vcl, GL, TID(), P0_I3072, P0_NITEMS, true, ML, 2 * ML); } }
        else { p0_prologue(args, lds, vcu, G, TID(), 0, P0_NITEMS, true, 0, MTOK); ssm_tables(args, lds, vcu, G, TID()); }
    }
    if (IN(0) && IN(1)) { if (NH == 2 && hh == 1) FLAG_WAIT(0); xcd_barrier(bar, TID()); if (NH == 2) FLAG_SET(64 * hh); }
    if (IN(1)) { pg8::EpiConvIn E{P, B1, B2}; run_gemm(lds, HB, WB + (size_t)W_C0IN * 1024, 3072, E, GL, TID(), ML, lb); } SEAM(1);
    if (IN(2)) { conv_phase(lds, B1, B2, args.in[3], args.in[4], args.in[5], args.in[6], YB, vcl, GL, TID(), ML); } if (NH == 2 && hh == 0 && IN(2) && IN(3)) FLAG_WAIT(64); SEAM(2);
    if (IN(3)) { pg8::EpiOut E{HB, P, outp, 0}; run_gemm(lds, YB, WB + (size_t)W_C0OUT * 1024, 1024, E, GL, TID(), ML, lb); } SEAM(3);
    if (IN(4)) { pg8::EpiFoxIn E{P, B1, B3, B4, B2, args.in[10], args.in[11]}; run_gemm(lds, HB, WB + (size_t)W_FIN * 1024, 4096, E, GL, TID(), ML, lb);
                 fcum_phase(lds, HB, WB + (size_t)W_FF * 1024, P, args.in[9], cumloc, ctot, vcl, GL, TID(), ML); } SEAM(4);
    if (IN(5)) { const attn_body::AttnTensors AT{(const attn_body::bf16*)B1, (const attn_body::bf16*)B3, (const attn_body::bf16*)B4, (const attn_body::bf16*)B2, (attn_body::bf16*)YB, cumloc, ctot, args.in[10], args.in[11]};
                 const attn_body::StaticOrder S(GL, lb, BL); attn_body::attn_phase<attn_body::StaticOrder>((char*)lds_raw, AT, S, TID()); } SEAM(5);
    if (IN(6)) { pg8::EpiOut E{HB, P, outp, 0}; run_gemm(lds, YB, WB + (size_t)W_FOUT * 1024, 1024, E, GL, TID(), ML, lb); } SEAM(6);
    if (IN(7)) { pg8::EpiSsmIn E{P, B1, B2}; run_gemm(lds, HB, WB + (size_t)W_SIN * 1024, 2048, E, GL, TID(), ML, lb); } SEAM(7);
    if (IN(8)) { ssm_phase(lds, ws, B1, args.in[21], B3, vcl, GL, TID(), BL * 4 / NWAVES); } SEAM(8);
    if (IN(10)) { pg8::EpiGlu E{B3, B2, args.in[23], YB}; run_gemm(lds, B3, WB + (size_t)W_SGLU * 1024, 1024, E, GL, TID(), ML, lb); } SEAM(10);
    if (IN(11)) { pg8::EpiOut E{HB, P, outp, 0}; run_gemm(lds, YB, WB + (size_t)W_SOUT * 1024, 1024, E, GL, TID(), ML, lb); } SEAM(11);
    if (IN(12)) { pg8::EpiConvIn E{P, B1, B2}; run_gemm(lds, HB, WB + (size_t)W_C1IN * 1024, 3072, E, GL, TID(), ML, lb); } SEAM(12);
    if (IN(13)) { conv_phase(lds, B1, B2, args.in[3] + (size_t)CONV_K * 1024, args.in[4] + 1024, args.in[5] + 1024, args.in[6] + 1024, YB, vcl, GL, TID(), ML); } SEAM(13);
    if (IN(14)) { pg8::EpiOut E{HB, P, outp, 1}; run_gemm(lds, YB, WB + (size_t)W_C1OUT * 1024, 1024, E, GL, TID(), ML, lb); }
#undef IN
#undef SEAM
}

#ifndef MK_ONE_LAUNCH
#define MK_ONE_LAUNCH 1
#endif
constexpr int N_PHASES = 15;
extern "C" void kernel_launch(void* const* d_in, const int* in_sizes, int n_in, void* d_out, int out_size, void* d_ws, size_t ws_size, hipStream_t stream) {
    static int grid = 0;
    if (grid == 0) {
        if (n_in != 25 || out_size != MTOK * DMODEL || ws_size < WS_END) { fprintf(stderr, "kernel_launch: unexpected shapes (n_in %d, out %d, ws %zu)\n", n_in, out_size, ws_size); grid = -1; return; }
        int dev = 0, cus = 0, per_cu = 0;
        if (hipGetDevice(&dev) != hipSuccess || hipDeviceGetAttribute(&cus, hipDeviceAttributeMultiprocessorCount, dev) != hipSuccess) { grid = -1; return; }
        if (hipFuncSetAttribute((const void*)mega_fwd, hipFuncAttributeMaxDynamicSharedMemorySize, LDS_BYTES) != hipSuccess) { fprintf(stderr, "kernel_launch: hipFuncSetAttribute failed\n"); grid = -1; return; }
        if (hipOccupancyMaxActiveBlocksPerMultiprocessor(&per_cu, (const void*)mega_fwd, NWAVES * 64, LDS_BYTES) != hipSuccess || per_cu < 1) { fprintf(stderr, "kernel_launch: occupancy query says %d blocks per CU\n", per_cu); grid = -1; (void)hipGetLastError(); return; }
        grid = cus;
    }
    if (grid < 0) return;
    if (hipMemsetAsync(d_ws, 0, 65536, stream) != hipSuccess) { fprintf(stderr, "kernel_launch: memset failed\n"); return; }
    Args a{};
    for (int i = 0; i < 25; ++i) a.in[i] = (const float*)d_in[i];
    a.out = (float*)d_out; a.ws = (unsigned char*)d_ws;
#if MK_ONE_LAUNCH
    a.ph_lo = 0; a.ph_hi = N_PHASES;
    void* kargs[] = {&a};
    const hipError_t e = hipLaunchCooperativeKernel((const void*)mega_fwd, dim3(grid), dim3(NWAVES * 64), kargs, LDS_BYTES, stream);
    if (e != hipSuccess) fprintf(stderr, "kernel_launch: cooperative launch failed: %s (grid %d)\n", hipGetErrorString(e), grid);
#else
    for (int p = 0; p < N_PHASES; ++p) { a.ph_lo = p; a.ph_hi = p + 1; hipLaunchKernelGGL(mega_fwd, dim3(grid), dim3(NWAVES * 64), LDS_BYTES, stream, a); }
#endif
}
```

```cpp
#include <hip/hip_runtime.h>
#include <hip/hip_cooperative_groups.h>
#include <cstdio>
#include <cstdint>
#include <cmath>
namespace cg = cooperative_groups;

constexpr int BATCH = 8, SEQ = 2048, DMODEL = 1024, MTOK = BATCH * SEQ;
constexpr int CONV_K = 31, NHEADS = 16, HDIM = 64, NGRP = 64, NST = 64, CGRP = 16;
constexpr float RMS_EPS = 1e-6f, LN_EPS = 1e-5f, LOG2E = 1.4426950408889634f;

namespace pg8 {
#define PG8_LAS __attribute__((address_space(3)))
typedef unsigned short bf16_t;
typedef short bf16x8 __attribute__((ext_vector_type(8)));
typedef float f32x4 __attribute__((ext_vector_type(4)));
typedef unsigned u32x4 __attribute__((ext_vector_type(4)));
constexpr int BM = 256, BK = 64, HALF = 128, HTB = HALF * BK * 2  , STAGE_BYTES = 8 * HTB, NXCD = 8, WGM = 8;

__host__ __device__ __forceinline__ int lds_byte(int r, int c) { const int st = (r >> 4) * 2 + (c >> 5), rr = r & 15, cc = c & 31, ob = rr * 64 + cc * 2; return st * 1024 + (ob ^ (((ob >> 9) & 1) << 5)); }
__host__ __device__ __forceinline__ void stage_rc(int b, int& R, int& C) { const int st = b / 1024, sb = b % 1024, swz = sb ^ (((sb >> 9) & 1) << 5); R = (st >> 1) * 16 + swz / 64; C = (st & 1) * 32 + (swz % 64) / 2; }
__host__ __device__ __forceinline__ int perm32(int rho) { const int n = rho >> 4, i = rho & 15; return 8 * (i >> 2) + 4 * n + (i & 3); }

struct Unit { int pm, pn; };
struct Gemm { const bf16_t* A; const bf16_t* Bt; int M, N, K; };

struct StaticOrder {
    int nM, nN, nwg, G, c;
    __host__ __device__ void init(int M, int N, int G_, int c_) { nM = M / BM; nN = N / BM; nwg = nM * nN; G = G_; c = c_; }
    __host__ __device__ bool next(int i, Unit& u) const {
        const long L = (long)i * G + c; if (L >= nwg) return false;
        int wgid = (int)L; { const int q = nwg / NXCD, r = nwg % NXCD, xcd = wgid % NXCD, off = wgid / NXCD; wgid = (xcd < r ? xcd * (q + 1) : r * (q + 1) + (xcd - r) * q) + off; }
        const int nig = WGM * nN, gid = wgid / nig, fm = gid * WGM, gsz = (nM - fm) < WGM ? (nM - fm) : WGM;
        u.pm = fm + ((wgid % nig) % gsz); u.pn = (wgid % nig) / gsz; return true;
    }
    __device__ __forceinline__ void a_ready(const Unit&) const {}
    __device__ __forceinline__ void done(const Unit&) const {}
};
__device__ __forceinline__ unsigned cvt_pk_bf16(float lo, float hi) { unsigned r; asm volatile("v_cvt_pk_bf16_f32 %0, %1, %2" : "=v"(r) : "v"(lo), "v"(hi)); return r; }
typedef float f32x2 __attribute__((ext_vector_type(2)));
typedef unsigned u32x2 __attribute__((ext_vector_type(2)));
__device__ __forceinline__ float sigm(float x) { return __builtin_amdgcn_rcpf(1.0f + __builtin_amdgcn_exp2f(-1.4426950408889634f * x)); }
__device__ __forceinline__ float silu(float x) { return x * sigm(x); }
__device__ __forceinline__ float bflo(unsigned w) { return __uint_as_float(w << 16); }
__device__ __forceinline__ float bfhi(unsigned w) { return __uint_as_float(w & 0xffff0000u); }
__device__ __forceinline__ void row_scales(float (&sc)[2][4], const float* P, int row0, int fq) {
#pragma unroll
    for (int ai = 0; ai < 2; ++ai)
#pragma unroll
        for (int m = 0; m < 4; ++m) { const f32x4 p = *(const f32x4*)(P + (size_t)(row0 + ai * HALF + m * 16) * 16 + 4 * fq);
            float s = (p[0] + p[1]) + (p[2] + p[3]); s += __shfl_xor(s, 16); s += __shfl_xor(s, 32);
            sc[ai][m] = rsqrtf(s * (1.0f / 1024.0f) + 1e-6f); }
}
struct EpiConvIn {
    static constexpr bool PERM = true, AFTER_DRAIN = false;
    const float* P; bf16_t* U; bf16_t* SG;
    __device__ __forceinline__ void operator()(const f32x4 (&acc)[2][2][4][2], const Unit& u, int wr, int wc, int fr, int fq) const {
        const int row0 = u.pm * BM + wr * 64 + fr; float sc[2][4]; row_scales(sc, P, row0, fq);
        if (u.pn < 8) {
            bf16_t* base = U + u.pn * 128 + wc * 32 + 8 * fq;
#pragma unroll
            for (int ai = 0; ai < 2; ++ai)
#pragma unroll
                for (int m = 0; m < 4; ++m) { const float s = sc[ai][m];
                    const f32x4 a0 = acc[ai][0][m][0] * s, a1 = acc[ai][0][m][1] * s, b0 = acc[ai][1][m][0] * s, b1 = acc[ai][1][m][1] * s; u32x4 w;
                    w.x = cvt_pk_bf16(a0[0] * sigm(b0[0]), a0[1] * sigm(b0[1])); w.y = cvt_pk_bf16(a0[2] * sigm(b0[2]), a0[3] * sigm(b0[3]));
                    w.z = cvt_pk_bf16(a1[0] * sigm(b1[0]), a1[1] * sigm(b1[1])); w.w = cvt_pk_bf16(a1[2] * sigm(b1[2]), a1[3] * sigm(b1[3]));
                    *(u32x4*)(base + (size_t)(row0 + ai * HALF + m * 16) * 1024) = w; }
        } else {
            bf16_t* base = SG + (u.pn - 8) * 256 + wc * 32 + 8 * fq;
#pragma unroll
            for (int ai = 0; ai < 2; ++ai)
#pragma unroll
                for (int m = 0; m < 4; ++m) { const float s = sc[ai][m];
#pragma unroll
                    for (int bj = 0; bj < 2; ++bj) { const f32x4 v0 = acc[ai][bj][m][0] * s, v1 = acc[ai][bj][m][1] * s; u32x4 w;
                        w.x = cvt_pk_bf16(silu(v0[0]), silu(v0[1])); w.y = cvt_pk_bf16(silu(v0[2]), silu(v0[3])); w.z = cvt_pk_bf16(silu(v1[0]), silu(v1[1])); w.w = cvt_pk_bf16(silu(v1[2]), silu(v1[3]));
                        *(u32x4*)(base + (size_t)(row0 + ai * HALF + m * 16) * 1024 + bj * HALF) = w; } }
        }
    }
};
struct EpiFoxIn {
    static constexpr bool PERM = true, AFTER_DRAIN = false;
    const float* P; bf16_t* Q; bf16_t* K; bf16_t* V; bf16_t* SG; const float* qg; const float* kg;
    __device__ __forceinline__ void operator()(const f32x4 (&acc)[2][2][4][2], const Unit& u, int wr, int wc, int fr, int fq) const {
        const int row0 = u.pm * BM + wr * 64 + fr; float sc[2][4]; row_scales(sc, P, row0, fq);
        const int sec = u.pn >> 2, colb = (4 * (u.pn & 3) + wc) * 64 + 8 * fq;
        if (sec < 2) {
            const float* g = sec == 0 ? qg : kg; bf16_t* dst = (sec == 0 ? Q : K) + colb; const float post = sec == 0 ? 0.125f * 1.4426950408889634f : 1.0f;
            f32x4 gv[2][2];
#pragma unroll
            for (int bj = 0; bj < 2; ++bj)
#pragma unroll
                for (int n = 0; n < 2; ++n) gv[bj][n] = *(const f32x4*)(g + 32 * bj + 8 * fq + 4 * n);
#pragma unroll
            for (int ai = 0; ai < 2; ++ai)
#pragma unroll
                for (int m = 0; m < 4; ++m) { const float s = sc[ai][m]; f32x4 x[2][2]; float ss = 0.f;
#pragma unroll
                    for (int bj = 0; bj < 2; ++bj)
#pragma unroll
                        for (int n = 0; n < 2; ++n) { x[bj][n] = acc[ai][bj][m][n] * s; ss += (x[bj][n][0] * x[bj][n][0] + x[bj][n][1] * x[bj][n][1]) + (x[bj][n][2] * x[bj][n][2] + x[bj][n][3] * x[bj][n][3]); }
                    ss += __shfl_xor(ss, 16); ss += __shfl_xor(ss, 32);
                    const float r = rsqrtf(ss * (1.0f / 64.0f) + 1e-6f) * post;
#pragma unroll
                    for (int bj = 0; bj < 2; ++bj) { const f32x4 y0 = x[bj][0] * gv[bj][0] * r, y1 = x[bj][1] * gv[bj][1] * r; u32x4 w;
                        w.x = cvt_pk_bf16(y0[0], y0[1]); w.y = cvt_pk_bf16(y0[2], y0[3]); w.z = cvt_pk_bf16(y1[0], y1[1]); w.w = cvt_pk_bf16(y1[2], y1[3]);
                        *(u32x4*)(dst + (size_t)(row0 + ai * HALF + m * 16) * 1024 + 32 * bj) = w; } }
        } else {
            bf16_t* dst = (sec == 2 ? V : SG) + colb;
#pragma unroll
            for (int ai = 0; ai < 2; ++ai)
#pragma unroll
                for (int m = 0; m < 4; ++m) { const float s = sc[ai][m];
#pragma unroll
                    for (int bj = 0; bj < 2; ++bj) { f32x4 v0 = acc[ai][bj][m][0] * s, v1 = acc[ai][bj][m][1] * s;
                        if (sec == 3) { v0 = (f32x4){silu(v0[0]), silu(v0[1]), silu(v0[2]), silu(v0[3])}; v1 = (f32x4){silu(v1[0]), silu(v1[1]), silu(v1[2]), silu(v1[3])}; }
                        u32x4 w; w.x = cvt_pk_bf16(v0[0], v0[1]); w.y = cvt_pk_bf16(v0[2], v0[3]); w.z = cvt_pk_bf16(v1[0], v1[1]); w.w = cvt_pk_bf16(v1[2], v1[3]);
                        *(u32x4*)(dst + (size_t)(row0 + ai * HALF + m * 16) * 1024 + 32 * bj) = w; } }
        }
    }
};
struct EpiSsmIn {
    static constexpr bool PERM = true, AFTER_DRAIN = false;
    const float* P; bf16_t* U; bf16_t* SG;
    __device__ __forceinline__ void operator()(const f32x4 (&acc)[2][2][4][2], const Unit& u, int wr, int wc, int fr, int fq) const {
        const int row0 = u.pm * BM + wr * 64 + fr; float sc[2][4]; row_scales(sc, P, row0, fq);
        const bool gate = u.pn >= 4; bf16_t* dst = (gate ? SG : U) + (u.pn & 3) * 256 + wc * 32 + 8 * fq;
#pragma unroll
        for (int ai = 0; ai < 2; ++ai)
#pragma unroll
            for (int m = 0; m < 4; ++m) { const float s = sc[ai][m];
#pragma unroll
                for (int bj = 0; bj < 2; ++bj) { f32x4 v0 = acc[ai][bj][m][0] * s, v1 = acc[ai][bj][m][1] * s;
                    if (gate) { v0 = (f32x4){silu(v0[0]), silu(v0[1]), silu(v0[2]), silu(v0[3])}; v1 = (f32x4){silu(v1[0]), silu(v1[1]), silu(v1[2]), silu(v1[3])}; }
                    u32x4 w; w.x = cvt_pk_bf16(v0[0], v0[1]); w.y = cvt_pk_bf16(v0[2], v0[3]); w.z = cvt_pk_bf16(v1[0], v1[1]); w.w = cvt_pk_bf16(v1[2], v1[3]);
                    *(u32x4*)(dst + (size_t)(row0 + ai * HALF + m * 16) * 1024 + bj * HALF) = w; } }
    }
};
struct EpiOut {
    static constexpr bool PERM = true, AFTER_DRAIN = false;
    bf16_t* hb; float* P; float* out; int last;
    __device__ __forceinline__ void operator()(const f32x4 (&acc)[2][2][4][2], const Unit& u, int wr, int wc, int fr, int fq) const {
        const int row0 = u.pm * BM + wr * 64 + fr, col0 = u.pn * BM + wc * 32 + 8 * fq;
#pragma unroll
        for (int ai = 0; ai < 2; ++ai)
#pragma unroll
            for (int m = 0; m < 4; ++m) { const int row = row0 + ai * HALF + m * 16; float ss = 0.f;
#pragma unroll
                for (int bj = 0; bj < 2; ++bj) { const size_t off = (size_t)row * 1024 + col0 + bj * HALF;
                    const u32x4 r = *(const u32x4*)(hb + off);
                    const f32x4 h0 = (f32x4){bflo(r.x), bfhi(r.x), bflo(r.y), bfhi(r.y)} + acc[ai][bj][m][0], h1 = (f32x4){bflo(r.z), bfhi(r.z), bflo(r.w), bfhi(r.w)} + acc[ai][bj][m][1];
                    if (last) { __builtin_nontemporal_store(h0, (f32x4*)(out + off)); __builtin_nontemporal_store(h1, (f32x4*)(out + off + 4)); }
                    else { ss += ((h0[0] * h0[0] + h0[1] * h0[1]) + (h0[2] * h0[2] + h0[3] * h0[3])) + ((h1[0] * h1[0] + h1[1] * h1[1]) + (h1[2] * h1[2] + h1[3] * h1[3]));
                        u32x4 w; w.x = cvt_pk_bf16(h0[0], h0[1]); w.y = cvt_pk_bf16(h0[2], h0[3]); w.z = cvt_pk_bf16(h1[0], h1[1]); w.w = cvt_pk_bf16(h1[2], h1[3]); *(u32x4*)(hb + off) = w; } }
                if (!last) { ss += __shfl_xor(ss, 16); ss += __shfl_xor(ss, 32); if (fq == 0) P[(size_t)row * 16 + 4 * u.pn + wc] = ss; } }
    }
};
struct EpiGlu {
    static constexpr bool PERM = true, AFTER_DRAIN = false;
    const bf16_t* G; const bf16_t* SG; const float* bias; bf16_t* Y;
    __device__ __forceinline__ void operator()(const f32x4 (&acc)[2][2][4][2], const Unit& u, int wr, int wc, int fr, int fq) const {
        const int row0 = u.pm * BM + wr * 64 + fr, col0 = u.pn * BM + wc * 32 + 8 * fq;
        f32x4 bv[2][2];
#pragma unroll
        for (int bj = 0; bj < 2; ++bj)
#pragma unroll
            for (int n = 0; n < 2; ++n) bv[bj][n] = *(const f32x4*)(bias + col0 + bj * HALF + 4 * n);
#pragma unroll
        for (int ai = 0; ai < 2; ++ai)
#pragma unroll
            for (int m = 0; m < 4; ++m)
#pragma unroll
                for (int bj = 0; bj < 2; ++bj) { const size_t off = (size_t)(row0 + ai * HALF + m * 16) * 1024 + col0 + bj * HALF;
                    const u32x4 gq = *(const u32x4*)(G + off), sq = *(const u32x4*)(SG + off);
                    const f32x4 t0 = acc[ai][bj][m][0] + bv[bj][0], t1 = acc[ai][bj][m][1] + bv[bj][1]; u32x4 w;
                    w.x = cvt_pk_bf16(bflo(gq.x) * sigm(t0[0]) * bflo(sq.x), bfhi(gq.x) * sigm(t0[1]) * bfhi(sq.x));
                    w.y = cvt_pk_bf16(bflo(gq.y) * sigm(t0[2]) * bflo(sq.y), bfhi(gq.y) * sigm(t0[3]) * bfhi(sq.y));
                    w.z = cvt_pk_bf16(bflo(gq.z) * sigm(t1[0]) * bflo(sq.z), bfhi(gq.z) * sigm(t1[1]) * bfhi(sq.z));
                    w.w = cvt_pk_bf16(bflo(gq.w) * sigm(t1[2]) * bflo(sq.w), bfhi(gq.w) * sigm(t1[3]) * bfhi(sq.w));
                    *(u32x4*)(Y + off) = w; }
    }
};

template <class Epi, class Sched, bool ALIGN_EPI = false, bool SP2 = false>
__device__ __forceinline__ void gemm_phase(PG8_LAS unsigned char* lds, const Gemm g, const Sched& S, const Epi& E, const int tid) {
    const int wid = __builtin_amdgcn_readfirstlane(tid >> 6), lane = tid & 63, wr = wid >> 2, wc = wid & 3, fr = lane & 15, fq = lane >> 4;
    const int K = g.K, nt = K / BK;
    unsigned voffA[2], voffB[2];
#pragma unroll
    for (int i = 0; i < 2; ++i) { int R, C; stage_rc(tid * 16 + i * 8192, R, C); const int Rb = Epi::PERM ? ((R & ~31) + perm32(R & 31)) : R;
        voffA[i] = (unsigned)(R * K + C) * 2u; voffB[i] = (unsigned)(Rb * K + C) * 2u; }
    const size_t kstep = (size_t)(BK * 2);
    const size_t hstep = (size_t)HALF * K * 2;
    const size_t tstep = 2 * hstep;
    const unsigned ldsw = (unsigned)wid * 1024u;
    const int aoff = lds_byte(wr * 64 + fr, fq * 8), boff = lds_byte(wc * 32 + fr, fq * 8);
#define PG8_SA(b, h) (((b) * 2 + (h)) * HTB)
#define PG8_SB(b, h) ((4 + (b) * 2 + (h)) * HTB)
#define PG8_STAGE(bufoff, gbase, voff) do { _Pragma("unroll") for (int _i = 0; _i < 2; ++_i) \
        __builtin_amdgcn_global_load_lds((const unsigned*)((const char*)(gbase) + (voff)[_i]), (PG8_LAS unsigned*)(lds + (bufoff) + ldsw + _i * 8192), 16, 0, 0); } while (0)
#define PG8_LDA(dst, b, h) do { _Pragma("unroll") for (int m = 0; m < 4; ++m) _Pragma("unroll") for (int k = 0; k < 2; ++k) dst[m][k] = *(const PG8_LAS bf16x8*)(lds + PG8_SA(b, h) + aoff + m * 2048 + k * 1024); } while (0)
#define PG8_LDB(dst, b, h) do { _Pragma("unroll") for (int n = 0; n < 2; ++n) _Pragma("unroll") for (int k = 0; k < 2; ++k) dst[n][k] = *(const PG8_LAS bf16x8*)(lds + PG8_SB(b, h) + boff + n * 2048 + k * 1024); } while (0)
#define PG8_MMA(ai, bj, At, Bt) do { __builtin_amdgcn_s_setprio(1); _Pragma("unroll") for (int m = 0; m < 4; ++m) _Pragma("unroll") for (int n = 0; n < 2; ++n) _Pragma("unroll") for (int k = 0; k < 2; ++k) \
        acc[ai][bj][m][n] = __builtin_amdgcn_mfma_f32_16x16x32_bf16(Bt[n][k], At[m][k], acc[ai][bj][m][n], 0, 0, 0); __builtin_amdgcn_s_setprio(0); } while (0)
#define PG8_WAIT_V(n) asm volatile("s_waitcnt vmcnt(" #n ")" ::: "memory")
#define PG8_WAIT_L(n) asm volatile("s_waitcnt lgkmcnt(" #n ")" ::: "memory")
#define PG8_BAR __builtin_amdgcn_s_barrier()
#define PG8_SCHED __builtin_amdgcn_sched_barrier(0)
    Unit cur, nxt; int ui = 0;
    if (!S.next(0, cur)) return;
    f32x4 acc[2][2][4][2];
#pragma unroll
    for (int a = 0; a < 2; ++a)
#pragma unroll
        for (int b = 0; b < 2; ++b)
#pragma unroll
            for (int m = 0; m < 4; ++m)
#pragma unroll
                for (int n = 0; n < 2; ++n) acc[a][b][m][n] = (f32x4){0.f, 0.f, 0.f, 0.f};
    bf16x8 At[4][2], B0[2][2], B1[2][2];
    const char* cA = (const char*)g.A + (size_t)cur.pm * tstep; const char* cB = (const char*)g.Bt + (size_t)cur.pn * tstep;
    S.a_ready(cur);
    if constexpr (SP2) {
        PG8_STAGE(PG8_SB(0, 0), cB, voffB); PG8_STAGE(PG8_SB(0, 1), cB + hstep, voffB); PG8_STAGE(PG8_SA(0, 0), cA, voffA); PG8_STAGE(PG8_SA(0, 1), cA + hstep, voffA);
        if (wr == 1) PG8_BAR;
        PG8_WAIT_V(2); PG8_BAR;
        PG8_STAGE(PG8_SB(1, 0), cB + kstep, voffB); PG8_STAGE(PG8_SA(1, 0), cA + kstep, voffA); PG8_STAGE(PG8_SB(1, 1), cB + hstep + kstep, voffB);
        PG8_WAIT_V(6); PG8_BAR;
    } else {
        PG8_STAGE(PG8_SB(0, 0), cB, voffB); PG8_STAGE(PG8_SA(0, 0), cA, voffA); PG8_STAGE(PG8_SB(0, 1), cB + hstep, voffB); PG8_STAGE(PG8_SA(0, 1), cA + hstep, voffA);
        if (wr == 1) PG8_BAR;
        PG8_WAIT_V(4); PG8_BAR;
        PG8_STAGE(PG8_SB(1, 0), cB + kstep, voffB); PG8_STAGE(PG8_SA(1, 0), cA + kstep, voffA); PG8_STAGE(PG8_SB(1, 1), cB + hstep + kstep, voffB);
        PG8_WAIT_V(6); PG8_BAR;
    }
    for (;;) {
        const bool has_next = S.next(ui + 1, nxt);
        const char* nA = has_next ? (const char*)g.A + (size_t)nxt.pm * tstep : cA; const char* nB = has_next ? (const char*)g.Bt + (size_t)nxt.pn * tstep : cB;
        for (int t = 0; t < nt; t += 2) {
            const bool last = (t == nt - 2);
            const char* a1 = cA + (size_t)(t + 1) * kstep;
            const char* a2 = last ? nA : cA + (size_t)(t + 2) * kstep; const char* b2 = last ? nB : cB + (size_t)(t + 2) * kstep;
            const char* a3 = a2 + kstep; const char* b3 = b2 + kstep;
            if (last && has_next) S.a_ready(nxt);
            if constexpr (SP2) {
            PG8_LDB(B0, 0, 0); PG8_LDB(B1, 0, 1); PG8_SCHED; PG8_LDA(At, 0, 0); PG8_STAGE(PG8_SA(1, 1), a1 + hstep, voffA);
            PG8_WAIT_V(8); PG8_WAIT_L(0); PG8_BAR; PG8_MMA(0, 0, At, B0); PG8_MMA(0, 1, At, B1); PG8_BAR; PG8_SCHED;
            PG8_LDA(At, 0, 1); PG8_STAGE(PG8_SB(0, 0), b2, voffB); PG8_STAGE(PG8_SB(0, 1), b2 + hstep, voffB); PG8_STAGE(PG8_SA(0, 0), a2, voffA);
            PG8_WAIT_V(8); PG8_WAIT_L(0); PG8_BAR; PG8_MMA(1, 0, At, B0); PG8_MMA(1, 1, At, B1); PG8_BAR; PG8_SCHED;
            PG8_LDB(B0, 1, 0); PG8_LDB(B1, 1, 1); PG8_SCHED; PG8_LDA(At, 1, 0); PG8_STAGE(PG8_SA(0, 1), a2 + hstep, voffA);
            PG8_WAIT_V(8); PG8_WAIT_L(0); PG8_BAR; PG8_MMA(0, 0, At, B0); PG8_MMA(0, 1, At, B1); PG8_BAR; PG8_SCHED;
            PG8_LDA(At, 1, 1); PG8_STAGE(PG8_SB(1, 0), b3, voffB); PG8_STAGE(PG8_SB(1, 1), b3 + hstep, voffB); PG8_STAGE(PG8_SA(1, 0), a3, voffA);
            PG8_WAIT_V(8); PG8_WAIT_L(0); PG8_BAR; PG8_MMA(1, 0, At, B0); PG8_MMA(1, 1, At, B1); PG8_BAR; PG8_SCHED;
            } else {
            PG8_LDB(B0, 0, 0); PG8_SCHED; PG8_LDA(At, 0, 0); PG8_STAGE(PG8_SA(1, 1), a1 + hstep, voffA);
            PG8_WAIT_L(8); PG8_BAR; PG8_WAIT_L(0); PG8_MMA(0, 0, At, B0); PG8_BAR; PG8_SCHED;
            PG8_LDB(B1, 0, 1); PG8_STAGE(PG8_SB(0, 0), b2, voffB);
            PG8_BAR; PG8_WAIT_L(0); PG8_MMA(0, 1, At, B1); PG8_BAR;
            PG8_LDA(At, 0, 1); PG8_STAGE(PG8_SA(0, 0), a2, voffA);
            PG8_BAR; PG8_WAIT_L(0); PG8_MMA(1, 0, At, B0); PG8_BAR; PG8_SCHED;
            PG8_STAGE(PG8_SB(0, 1), b2 + hstep, voffB);
            PG8_WAIT_V(6); PG8_BAR; PG8_MMA(1, 1, At, B1); PG8_BAR;
            PG8_LDB(B0, 1, 0); PG8_SCHED; PG8_LDA(At, 1, 0); PG8_STAGE(PG8_SA(0, 1), a2 + hstep, voffA);
            PG8_WAIT_L(8); PG8_BAR; PG8_WAIT_L(0); PG8_MMA(0, 0, At, B0); PG8_BAR; PG8_SCHED;
            PG8_LDB(B1, 1, 1); PG8_STAGE(PG8_SB(1, 0), b3, voffB);
            PG8_BAR; PG8_WAIT_L(0); PG8_MMA(0, 1, At, B1); PG8_BAR;
            PG8_LDA(At, 1, 1); PG8_STAGE(PG8_SA(1, 0), a3, voffA);
            PG8_BAR; PG8_WAIT_L(0); PG8_MMA(1, 0, At, B0); PG8_BAR; PG8_SCHED;
            PG8_STAGE(PG8_SB(1, 1), b3 + hstep, voffB);
            PG8_WAIT_V(6); PG8_BAR; PG8_MMA(1, 1, At, B1); PG8_BAR;
            }
        }
        if constexpr (ALIGN_EPI) { if (wr == 0) PG8_BAR; }
        if constexpr (!Epi::AFTER_DRAIN) { E(acc, cur, wr, wc, fr, fq); S.done(cur); }
        if (!has_next) break;
#pragma unroll
        for (int a = 0; a < 2; ++a)
#pragma unroll
            for (int b = 0; b < 2; ++b)
#pragma unroll
                for (int m = 0; m < 4; ++m)
#pragma unroll
                    for (int n = 0; n < 2; ++n) acc[a][b][m][n] = (f32x4){0.f, 0.f, 0.f, 0.f};
        cur = nxt; cA = nA; cB = nB; ++ui;
        if constexpr (ALIGN_EPI) { if (wr == 1) PG8_BAR; }
    }
    PG8_WAIT_V(0);
    if constexpr (!ALIGN_EPI) { if (wr == 0) PG8_BAR; }
    PG8_BAR;
    if constexpr (Epi::AFTER_DRAIN) { E.fused(acc, cur, wr, wc, fr, fq, lds, wid, lane); S.done(cur); }
#undef PG8_SA
#undef PG8_SB
#undef PG8_STAGE
#undef PG8_LDA
#undef PG8_LDB
#undef PG8_MMA
#undef PG8_WAIT_V
#undef PG8_WAIT_L
#undef PG8_BAR
#undef PG8_SCHED
}
}
#include <hip/hip_bf16.h>
#include <cmath>
namespace attn_body {
using bf16=__hip_bfloat16;
using bf16x8=__attribute__((ext_vector_type(8)))short;
using s16x4=__attribute__((ext_vector_type(4)))short;
using f32x16=__attribute__((ext_vector_type(16)))float;
using u32x4=__attribute__((ext_vector_type(4)))unsigned;
constexpr int BATCH=8,NHEAD=16,SEQ=2048,D=64,DM=NHEAD*D;
constexpr int NW=8,QBLK=32,QB=QBLK*NW,KVBLK=64,NQB=SEQ/QB;
constexpr int ATTN_PITCH=DM, ATTN_UNIT_ROWS=QB;
__device__ __forceinline__ int crow(int r,int hi){return (r&3)+8*(r>>2)+4*hi;}
#define SBAR() __builtin_amdgcn_sched_barrier(0)
__device__ __forceinline__ void cmask(f32x16&p0,f32x16&p1,int jb,int qrel,int hi){
  const float NEG=-INFINITY; int kb=64*jb+4*hi;
  #pragma unroll
  for(int r=0;r<16;++r){int kv=kb+(r&3)+8*(r>>2); if(kv>qrel)p0[r]=NEG; if(kv+32>qrel)p1[r]=NEG;}
}

constexpr int NSLOT=3, SLOTB=8192;
constexpr int LDS_K=0, LDS_V=NSLOT*SLOTB, LDS_WS=2*NSLOT*SLOTB, LDS_OST=LDS_WS+NW*64*4, LDS_CK=LDS_OST+NW*4096, LDS_BYTES=LDS_CK+SEQ*8;
constexpr float C2=0.125f*1.4426950408889634f;
__device__ __forceinline__ void glds16(const void*gsrc,unsigned lds_dst){unsigned keep;
  asm volatile("s_mov_b32 %0, m0\n\ts_mov_b32 m0, %2\n\ts_nop 0\n\tglobal_load_lds_dwordx4 %1, off\n\ts_mov_b32 m0, %0":"=&s"(keep):"v"(gsrc),"s"(lds_dst):"memory");}
__device__ __forceinline__ float max3f(float a,float b,float c){float r;asm("v_max3_f32 %0, %1, %2, %3":"=v"(r):"v"(a),"v"(b),"v"(c));return r;}
__device__ __forceinline__ float max2f(float a,float b){float r;asm("v_max_f32_e32 %0, %1, %2":"=v"(r):"v"(a),"v"(b));return r;}
__device__ __forceinline__ float fadd_s(float a,float b){float r;asm("v_add_f32_e32 %0, %1, %2":"=v"(r):"v"(a),"v"(b));return r;}
__device__ __forceinline__ float fsub_s(float a,float b){float r;asm("v_sub_f32_e32 %0, %1, %2":"=v"(r):"v"(a),"v"(b));return r;}
typedef float f32x2_t __attribute__((ext_vector_type(2))); typedef __bf16 bf16x2_t __attribute__((ext_vector_type(2)));
__device__ __forceinline__ unsigned cvtpk_s(float lo,float hi){f32x2_t v={lo,hi};bf16x2_t b=__builtin_convertvector(v,bf16x2_t);return __builtin_bit_cast(unsigned,b);}
#define WAIT_BAR(N) asm volatile("s_waitcnt vmcnt(" #N ") lgkmcnt(0)\n\ts_barrier":::"memory")

__device__ __forceinline__ void qkt(f32x16&p0,f32x16&p1,const char*Kslot,const bf16x8*qr,int r32,int hi){
  const char*kb=Kslot+hi*1024+r32*16;
  #pragma unroll
  for(int d0=0;d0<4;++d0){
    const bf16x8 b0=*reinterpret_cast<const bf16x8*>(kb+d0*2048);
    const bf16x8 b1=*reinterpret_cast<const bf16x8*>(kb+d0*2048+512);
    p0=__builtin_amdgcn_mfma_f32_32x32x16_bf16(b0,qr[d0],p0,0,0,0);p1=__builtin_amdgcn_mfma_f32_32x32x16_bf16(b1,qr[d0],p1,0,0,0);}
}
typedef __attribute__((address_space(3))) const char* lds_cptr;
typedef short v4i16_t __attribute__((ext_vector_type(4)));
__device__ __forceinline__ void kload8(bf16x8*kf,lds_cptr kp){
  kf[0]=*(const __attribute__((address_space(3))) bf16x8*)(kp);      kf[1]=*(const __attribute__((address_space(3))) bf16x8*)(kp+512);
  kf[2]=*(const __attribute__((address_space(3))) bf16x8*)(kp+2048); kf[3]=*(const __attribute__((address_space(3))) bf16x8*)(kp+2560);
  kf[4]=*(const __attribute__((address_space(3))) bf16x8*)(kp+4096); kf[5]=*(const __attribute__((address_space(3))) bf16x8*)(kp+4608);
  kf[6]=*(const __attribute__((address_space(3))) bf16x8*)(kp+6144); kf[7]=*(const __attribute__((address_space(3))) bf16x8*)(kp+6656);
}
__device__ __forceinline__ void kload2(bf16x8*kf,lds_cptr kp,int j){ kf[2*j]=*(const __attribute__((address_space(3))) bf16x8*)(kp+j*2048); kf[2*j+1]=*(const __attribute__((address_space(3))) bf16x8*)(kp+j*2048+512); }
__device__ __forceinline__ s16x4 vtr(lds_cptr p){ return __builtin_bit_cast(s16x4,__builtin_amdgcn_ds_read_tr16_b64_v4i16((__attribute__((address_space(3))) v4i16_t*)p)); }
__device__ __forceinline__ float rowmax(const f32x16&p0,const f32x16&p1){
  float a=max3f(p0[0],p0[1],p1[0]),b=max3f(p0[2],p0[3],p1[1]);a=max3f(a,p1[2],p1[3]);
  #pragma unroll
  for(int r=4;r<16;r+=4){a=max3f(a,p0[r],p0[r+1]);b=max3f(b,p0[r+2],p0[r+3]);a=max3f(a,p1[r],p1[r+1]);b=max3f(b,p1[r+2],p1[r+3]);}
  const float m=max2f(a,b);
  auto rr=__builtin_amdgcn_permlane32_swap(__float_as_uint(m),__float_as_uint(m),false,false);
  return max2f(__uint_as_float(rr[0]),__uint_as_float(rr[1]));
}
__device__ __forceinline__ void pv(f32x16*o,int vb,bf16x8 pa0,bf16x8 pa1,bf16x8 pa2,bf16x8 pa3){
  #pragma unroll
  for(int d0=0;d0<2;++d0){s16x4 lo[4],hi[4];
    #pragma unroll
    for(int ks=0;ks<4;++ks){
      asm volatile("ds_read_b64_tr_b16 %0,%1 offset:%c2":"=&v"(lo[ks]):"v"(vb),"i"(d0*4096+ks*1024):"memory");
      asm volatile("ds_read_b64_tr_b16 %0,%1 offset:%c2":"=&v"(hi[ks]):"v"(vb),"i"(d0*4096+ks*1024+512):"memory");}
    asm volatile("s_waitcnt lgkmcnt(0)":::"memory");SBAR();
    #define PK(k) (bf16x8){lo[k][0],lo[k][1],lo[k][2],lo[k][3],hi[k][0],hi[k][1],hi[k][2],hi[k][3]}
    o[d0]=__builtin_amdgcn_mfma_f32_32x32x16_bf16(pa0,PK(0),o[d0],0,0,0);
    o[d0]=__builtin_amdgcn_mfma_f32_32x32x16_bf16(pa1,PK(1),o[d0],0,0,0);
    o[d0]=__builtin_amdgcn_mfma_f32_32x32x16_bf16(pa2,PK(2),o[d0],0,0,0);
    o[d0]=__builtin_amdgcn_mfma_f32_32x32x16_bf16(pa3,PK(3),o[d0],0,0,0);
    #undef PK
  }
}

typedef __attribute__((address_space(3))) const float* lds_fptr;
typedef float f32x4_t __attribute__((ext_vector_type(4)));
typedef unsigned u32x2_t __attribute__((ext_vector_type(2)));
__device__ __forceinline__ unsigned bfr(float f){ const unsigned u=__float_as_uint(f); return (u+0x7fffu+((u>>16)&1u))>>16; }
__device__ __forceinline__ void split3(float v,unsigned&h,unsigned&m,unsigned&l){ h=bfr(v); const float r=v-__uint_as_float(h<<16); m=bfr(r); const float r2=r-__uint_as_float(m<<16); l=bfr(r2); }
__device__ __forceinline__ bf16x8 kxfrag(lds_cptr p){ const u32x2_t w=*(const __attribute__((address_space(3))) u32x2_t*)p; const u32x4 f={w[0],w[1],0xBF80BF80u,0u}; return __builtin_bit_cast(bf16x8,f); }
__device__ __forceinline__ bf16x8 mkqx(float mh,int hi){ unsigned h,m,l; split3(mh,h,m,l); u32x4 f={0x3F803F80u,0x3F80u|(h<<16),m|(l<<16),0u}; if(hi)f=u32x4{0u,0u,0u,0u}; return __builtin_bit_cast(bf16x8,f); }
#ifndef ATTN_STORE16
#define ATTN_STORE16(p,v) (*(u32x4*)(p)=(v))
#endif
template<int THRL> __device__ __forceinline__ void attn_unit(int b,int h,int qb,const bf16*Q,const bf16*__restrict__ K,const bf16*__restrict__ V,const bf16*__restrict__ SG,bf16*O,char*shm,const int tid_in,const bool pre,const bool nxt,const float bref){
  int tid=tid_in; asm volatile("":"+v"(tid));
  const int lane=tid&63,r32=lane&31,hi=lane>>5; const int wid=__builtin_amdgcn_readfirstlane(tid>>6);
  const long rowbase=(long)b*SEQ; const int q0=qb*QB;
  const bf16*Qw=Q+(rowbase+q0+wid*QBLK)*DM+h*D;
  const bf16*Kh=K+rowbase*DM+h*D,*Vh=V+rowbase*DM+h*D;
  const unsigned lds0=(unsigned)(uintptr_t)shm;
  float*wsf=(float*)(shm+LDS_WS)+wid*64;
  const bf16*ksrc=Kh+(long)lane*DM+wid*8;
  const bf16*vsrc=Vh+(long)(16*(wid&3)+(lane>>2))*DM+(wid>>2)*32+(lane&3)*8;
  const unsigned kdst=lds0+LDS_K+wid*1024, vdst=lds0+LDS_V+wid*1024;
  #define DMA_K(t,slot) glds16(ksrc+(long)(t)*KVBLK*DM,(unsigned)__builtin_amdgcn_readfirstlane(kdst+(slot)))
  #define DMA_V(t,slot) glds16(vsrc+(long)(t)*KVBLK*DM,(unsigned)__builtin_amdgcn_readfirstlane(vdst+(slot)))
  const int vb0=(int)(lds0+LDS_V)+((lane>>4)&1)*32+(lane&3)*8+(4*hi+((lane&15)>>2))*64;
  const char*Kbase=shm+LDS_K; bf16x8 kf[8];
  const lds_cptr shm3=(lds_cptr)shm; const lds_cptr kxp=shm3+LDS_CK+r32*8; const lds_cptr kp0=shm3+LDS_K+hi*1024+r32*16; const lds_cptr vp0=shm3+LDS_V+((lane>>4)&1)*32+(lane&3)*8+(4*hi+((lane&15)>>2))*64;
  const int NT=(q0+QB)/KVBLK;
  if(!pre){DMA_K(0,0);DMA_V(0,0);DMA_K(1,SLOTB);}
  bf16x8 qr[4];
  #pragma unroll
  for(int d0=0;d0<4;++d0)qr[d0]=*reinterpret_cast<const bf16x8*>(&Qw[(long)r32*DM+d0*16+hi*8]);
  float l_reg=0.f;f32x16 o[2];o[0]=f32x16{};o[1]=f32x16{};
  const int qrel=wid*QBLK+r32;
  #define CMASK(P0,P1,t) do{int jb_=(t)-(NT-4); if(jb_>=0)cmask(P0,P1,jb_,qrel,hi);}while(0)
  f32x16 pA0,pA1,pB0,pB1;
  int sl_prev=0,sl_cur=0,sl_next=SLOTB;
  #define ROT() do{sl_prev=sl_cur;sl_cur=sl_next;sl_next=(sl_next==(NSLOT-1)*SLOTB)?0:sl_next+SLOTB;}while(0)
  if(!pre){DMA_K(2,2*SLOTB);}
  WAIT_BAR(3);
  float mref; { const u32x2_t w=*(const __attribute__((address_space(3))) u32x2_t*)(shm3+LDS_CK+(q0+wid*QBLK+r32)*8); mref=(__uint_as_float(w[0]<<16)+__uint_as_float(w[0]&0xffff0000u))+__uint_as_float(w[1]<<16)+bref; }
  const bf16x8 qx=mkqx(mref,hi); const f32x16 zero16=f32x16{};
  pA0=__builtin_amdgcn_mfma_f32_32x32x16_bf16(kxfrag(kxp),qx,zero16,0,0,0); pA1=__builtin_amdgcn_mfma_f32_32x32x16_bf16(kxfrag(kxp+256),qx,zero16,0,0,0);
  qkt(pA0,pA1,Kbase,qr,r32,hi);asm volatile("s_nop 15\n\ts_nop 7":"+v"(pA0),"+v"(pA1));CMASK(pA0,pA1,0);
  _Pragma("unroll") for(int r=0;r<16;++r){pA0[r]=__builtin_amdgcn_exp2f(pA0[r]);pA1[r]=__builtin_amdgcn_exp2f(pA1[r]);}
  WAIT_BAR(0);
  DMA_K(3,0);DMA_V(1,SLOTB);
  ROT();
  kload8(kf,kp0+sl_cur);
  WAIT_BAR(2);
  s16x4 vlo[8],vhi[8]; u32x4 pw0,pw1,pw2,pw3;
  #define PKW(P,B) cvtpk_s(P[B],P[B+1])
  #define PAF(k) __builtin_bit_cast(bf16x8,pw##k)
  #define VFR(i) (bf16x8){vlo[i][0],vlo[i][1],vlo[i][2],vlo[i][3],vhi[i][0],vhi[i][1],vhi[i][2],vhi[i][3]}
  #define PIN(x) asm volatile("":"+v"(x))
  #define MX3(a,b,c) __builtin_fmaxf(__builtin_fmaxf((a),(b)),(c))
  #define GAPA(MF,A0,A1,A2,A3,W0,W1,PW) do{ MF; sacc+=A0; sacc+=A1; sacc+=A2; sacc+=A3; PIN(sacc); W0; W1; PIN(PW); SBAR(); }while(0)
  #define EX(v) __builtin_amdgcn_exp2f(v)
  #define GAPB(MF,X,B) do{ MF; X[B]=EX(X[B]); X[B+1]=EX(X[B+1]); X[B+2]=EX(X[B+2]); X[B+3]=EX(X[B+3]); PIN(X); SBAR(); }while(0)
  #define VRD(i) do{ vlo[i]=vtr(vp_+(((i)>>2)*4096+((i)&3)*1024)); vhi[i]=vtr(vp_+(((i)>>2)*4096+((i)&3)*1024+512)); }while(0)
  #define KRD(G,j) do{ if(G){ kload2(kf,kp0+sl_next,j); SBAR(); } }while(0)
  #define STEP(C0,C1,P0,P1,t,GK,GV,GL) do{ SBAR(); \
    const lds_cptr vp_=vp0+sl_prev; \
    C0=__builtin_amdgcn_mfma_f32_32x32x16_bf16(kxfrag(kxp+(t)*512),qx,zero16,0,0,0); C1=__builtin_amdgcn_mfma_f32_32x32x16_bf16(kxfrag(kxp+(t)*512+256),qx,zero16,0,0,0); SBAR(); \
    VRD(0); SBAR(); float sacc=(P0[0]+P0[1]); \
    GAPA(C0=__builtin_amdgcn_mfma_f32_32x32x16_bf16(kf[0],qr[0],C0,0,0,0), P0[2],P0[3],P0[4],P0[5],     pw0[0]=PKW(P0,0), pw0[1]=PKW(P0,2), pw0); \
    VRD(4); SBAR(); GAPA(C1=__builtin_amdgcn_mfma_f32_32x32x16_bf16(kf[1],qr[0],C1,0,0,0), P0[6],P0[7],P0[8],P0[9],     pw0[2]=PKW(P0,4), pw0[3]=PKW(P0,6), pw0); \
    VRD(1); SBAR(); GAPA(C0=__builtin_amdgcn_mfma_f32_32x32x16_bf16(kf[2],qr[1],C0,0,0,0),   P0[10],P0[11],P0[12],P0[13], pw1[0]=PKW(P0,8), pw1[1]=PKW(P0,10), pw1); \
    VRD(5); SBAR(); GAPA(C1=__builtin_amdgcn_mfma_f32_32x32x16_bf16(kf[3],qr[1],C1,0,0,0),   P0[14],P0[15],P1[0],P1[1],   pw1[2]=PKW(P0,12),pw1[3]=PKW(P0,14), pw1); \
    VRD(2); SBAR(); GAPA(C0=__builtin_amdgcn_mfma_f32_32x32x16_bf16(kf[4],qr[2],C0,0,0,0),   P1[2],P1[3],P1[4],P1[5],     pw2[0]=PKW(P1,0), pw2[1]=PKW(P1,2), pw2); \
    VRD(6); SBAR(); GAPA(C1=__builtin_amdgcn_mfma_f32_32x32x16_bf16(kf[5],qr[2],C1,0,0,0),   P1[6],P1[7],P1[8],P1[9],     pw2[2]=PKW(P1,4), pw2[3]=PKW(P1,6), pw2); \
    VRD(3); SBAR(); GAPA(C0=__builtin_amdgcn_mfma_f32_32x32x16_bf16(kf[6],qr[3],C0,0,0,0),   P1[10],P1[11],P1[12],P1[13], pw3[0]=PKW(P1,8), pw3[1]=PKW(P1,10), pw3); \
    VRD(7); SBAR(); GAPA(C1=__builtin_amdgcn_mfma_f32_32x32x16_bf16(kf[7],qr[3],C1,0,0,0),   P1[14],P1[15],0.f,0.f,       pw3[2]=PKW(P1,12),pw3[3]=PKW(P1,14), pw3); \
    l_reg+=sacc; \
    if(GK){DMA_K((t)+3,sl_cur);} if(GV){DMA_V((t)+1,sl_next);} \
    CMASK(C0,C1,t); \
    SBAR(); \
    GAPB(o[0]=__builtin_amdgcn_mfma_f32_32x32x16_bf16(PAF(0),VFR(0),o[0],0,0,0), C0,0); \
    GAPB(o[1]=__builtin_amdgcn_mfma_f32_32x32x16_bf16(PAF(0),VFR(4),o[1],0,0,0), C0,4); \
    KRD(GL,0); GAPB(o[0]=__builtin_amdgcn_mfma_f32_32x32x16_bf16(PAF(1),VFR(1),o[0],0,0,0), C0,8); \
    KRD(GL,1); GAPB(o[1]=__builtin_amdgcn_mfma_f32_32x32x16_bf16(PAF(1),VFR(5),o[1],0,0,0), C0,12); \
    KRD(GL,2); GAPB(o[0]=__builtin_amdgcn_mfma_f32_32x32x16_bf16(PAF(2),VFR(2),o[0],0,0,0), C1,0); \
    KRD(GL,3); GAPB(o[1]=__builtin_amdgcn_mfma_f32_32x32x16_bf16(PAF(2),VFR(6),o[1],0,0,0), C1,4); \
    GAPB(o[0]=__builtin_amdgcn_mfma_f32_32x32x16_bf16(PAF(3),VFR(3),o[0],0,0,0), C1,8); \
    GAPB(o[1]=__builtin_amdgcn_mfma_f32_32x32x16_bf16(PAF(3),VFR(7),o[1],0,0,0), C1,12); \
    }while(0)
  int t=1;
  #undef CMASK
  #define CMASK(P0,P1,t) do{}while(0)
  for(;t+5<NT;t+=2){
    STEP(pB0,pB1,pA0,pA1,t,true,true,true);     WAIT_BAR(2); ROT();
    STEP(pA0,pA1,pB0,pB1,t+1,true,true,true);   WAIT_BAR(2); ROT();
  }
  #undef CMASK
  #define CMASK(P0,P1,t) do{int jb_=(t)-(NT-4); if(jb_>=0)cmask(P0,P1,jb_,qrel,hi);}while(0)
  #define ENDW(tt) do{ if((tt)+3<NT){WAIT_BAR(2);} else if((tt)+2<NT){WAIT_BAR(1);} else {WAIT_BAR(0);} }while(0)
  for(;t+1<NT;t+=2){
    STEP(pB0,pB1,pA0,pA1,t,(t+3<NT),(t+1<NT),(t+1<NT));       ENDW(t);   ROT();
    STEP(pA0,pA1,pB0,pB1,t+1,(t+4<NT),(t+2<NT),(t+2<NT));     ENDW(t+1); ROT();
  }
  STEP(pB0,pB1,pA0,pA1,NT-1,false,false,false);
  u32x4 sgv[4]; { const bf16*SGw=SG+(rowbase+q0+wid*QBLK)*DM+h*D;
    #pragma unroll
    for(int i=0;i<4;++i) sgv[i]=*(const u32x4*)(SGw+(long)(i*8+(lane>>3))*DM+(lane&7)*8); }
  SBAR();
  { float sacc=pB0[0]+pB0[1]; _Pragma("unroll") for(int r=2;r<16;++r)sacc+=pB0[r]; _Pragma("unroll") for(int r=0;r<16;++r)sacc+=pB1[r]; l_reg+=sacc;
    pw0=(u32x4){PKW(pB0,0),PKW(pB0,2),PKW(pB0,4),PKW(pB0,6)};pw1=(u32x4){PKW(pB0,8),PKW(pB0,10),PKW(pB0,12),PKW(pB0,14)};pw2=(u32x4){PKW(pB1,0),PKW(pB1,2),PKW(pB1,4),PKW(pB1,6)};pw3=(u32x4){PKW(pB1,8),PKW(pB1,10),PKW(pB1,12),PKW(pB1,14)};
    SBAR(); pv(o,vb0+sl_cur,PAF(0),PAF(1),PAF(2),PAF(3)); }
  asm volatile("s_waitcnt lgkmcnt(0)\n\ts_barrier":::"memory");
  if(nxt){DMA_K(0,0);DMA_V(0,0);DMA_K(1,SLOTB);DMA_K(2,2*SLOTB);}
  #undef PKW
  #undef PAF
  #undef VFR
  #undef PIN
  #undef MX3
  #undef GAPA
  #undef GAPB
  #undef EX
  #undef VRD
  #undef KRD
  #undef STEP
  #undef ENDW
  {auto rr=__builtin_amdgcn_permlane32_swap(__float_as_uint(l_reg),__float_as_uint(l_reg),false,false);l_reg=__uint_as_float(rr[0])+__uint_as_float(rr[1]);}
  if(hi==0)wsf[32+r32]=l_reg;asm volatile("s_waitcnt lgkmcnt(0)":::"memory");
  float rli[16];
  #pragma unroll
  for(int r=0;r<16;++r)rli[r]=__builtin_amdgcn_rcpf(wsf[32+crow(r,hi)]);
  bf16*Ow=O+(rowbase+q0+wid*QBLK)*DM+h*D;
  { bf16*stg=(bf16*)(shm+LDS_OST)+wid*2048;
    #pragma unroll
    for(int r=0;r<16;++r){const int orow=crow(r,hi);
      #pragma unroll
      for(int d0=0;d0<2;++d0)stg[orow*64+d0*32+r32]=__float2bfloat16(o[d0][r]*rli[r]);}
    asm volatile("s_waitcnt lgkmcnt(0)":::"memory");
    #pragma unroll
    for(int i=0;i<4;++i){const int row=i*8+(lane>>3),ch=lane&7; u32x4 v=*(const u32x4*)(stg+row*64+ch*8); const u32x4 g=sgv[i];
      #pragma unroll
      for(int e=0;e<4;++e){ const float lo=__uint_as_float(v[e]<<16)*__uint_as_float(g[e]<<16), hh=__uint_as_float(v[e]&0xffff0000u)*__uint_as_float(g[e]&0xffff0000u); v[e]=cvtpk_s(lo,hh); }
      ATTN_STORE16(Ow+(long)row*DM+ch*8,v);} }
  asm volatile("s_waitcnt lgkmcnt(0)":::"memory");
  #undef DMA_K
  #undef DMA_V
  #undef CMASK
  #undef ROT
}
constexpr int ATTN_LDS_BYTES=LDS_BYTES;
struct AttnTensors { const bf16* Q; const bf16* K; const bf16* V; const bf16* SG; bf16* O; const float* cumloc; const float* ctot; const float* qg; const float* kg; };
struct AttnUnit { int bh; int qb; };
struct StaticOrder {
  int vcu, G, nb;
  __device__ __forceinline__ explicit StaticOrder(int grid,int block,int nbatch):vcu((grid%8==0)?(block%8)*(grid/8)+block/8:block),G(grid),nb(nbatch){}
  __device__ __forceinline__ bool next(int i,AttnUnit&u)const{
    if(G==2*nb*NHEAD){ if(i>=4)return false; const int s=vcu&1; u.bh=vcu>>1; u.qb=(i==0)?s:(i==1)?7-s:(i==2)?3-s:4+s; return true; }
    const int id=vcu+i*G; if(id>=nb*NHEAD*NQB)return false; u.bh=id/NQB; u.qb=id%NQB; return true; }
  __device__ __forceinline__ void a_ready(const AttnUnit&)const{}
  __device__ __forceinline__ void done(const AttnUnit&)const{}
};
template<class Sched,int THRL=8> __device__ __forceinline__ void attn_phase(char*lds,const AttnTensors&T,const Sched&S,const int tid){
  AttnUnit u,un; int cur_bh=-1; bool pre=false; bool has=S.next(0,u);
  float bref; { float gq=fabsf(T.qg[tid&63]),gk=fabsf(T.kg[tid&63]);
    #pragma unroll
    for(int o=1;o<64;o<<=1){ gq=fmaxf(gq,__shfl_xor(gq,o)); gk=fmaxf(gk,__shfl_xor(gk,o)); }
    bref=8.0f*1.4426950408889634f*gq*gk+1.0f; }
  for(int i=0;has;++i){ S.a_ready(u); const bool hasn=S.next(i+1,un); const bool nxt=hasn&&un.bh==u.bh;
    if(u.bh!=cur_bh){ cur_bh=u.bh;
      int tq=tid; asm volatile("":"+v"(tq));
      const int b_=u.bh/NHEAD,h_=u.bh%NHEAD,l_=tq&31,c_=tq>>4;
      float v=T.ctot[(size_t)(b_*(SEQ/64)+l_)*16+h_];
      #pragma unroll
      for(int o=1;o<32;o<<=1){ const float nn=__shfl_up(v,o,32); if(l_>=o)v+=nn; }
      const float pre=__shfl(v,(c_+31)&31,32); const float base=(c_==0)?0.f:pre;
      const f32x4_t cl=*(const f32x4_t*)(T.cumloc+((size_t)u.bh)*SEQ+4*tq);
      { u32x4 w0,w1; unsigned h_,m_,l_;
        split3(-(cl[0]+base),h_,m_,l_); w0[0]=h_|(m_<<16); w0[1]=l_|0xBF800000u; split3(-(cl[1]+base),h_,m_,l_); w0[2]=h_|(m_<<16); w0[3]=l_|0xBF800000u;
        split3(-(cl[2]+base),h_,m_,l_); w1[0]=h_|(m_<<16); w1[1]=l_|0xBF800000u; split3(-(cl[3]+base),h_,m_,l_); w1[2]=h_|(m_<<16); w1[3]=l_|0xBF800000u;
        *(u32x4*)(lds+LDS_CK+32*tq)=w0; *(u32x4*)(lds+LDS_CK+32*tq+16)=w1; }
      asm volatile("s_waitcnt vmcnt(0) lgkmcnt(0)\n\ts_barrier":::"memory"); }
    attn_unit<THRL>(u.bh/NHEAD,u.bh%NHEAD,u.qb,T.Q,T.K,T.V,T.SG,T.O,lds,tid,pre,nxt,bref); S.done(u); pre=nxt; u=un; has=hasn; }
}
#undef SBAR
#undef WAIT_BAR
}
#define LAS __attribute__((address_space(3)))
typedef unsigned short bf16_t;
typedef short bf16x8_t __attribute__((ext_vector_type(8)));
typedef float f32x4 __attribute__((ext_vector_type(4)));
typedef float f32x2 __attribute__((ext_vector_type(2)));
typedef unsigned u32x4 __attribute__((ext_vector_type(4)));
constexpr int NWAVES = 8;
constexpr int RING_BYTES = 131072, LDS_BYTES = 147456, MISC_OFF = LDS_BYTES - 256;
static_assert(attn_body::LDS_BYTES <= RING_BYTES, "attention scratch must fit the ring region");
constexpr size_t MiB = 1u << 20;
constexpr size_t WS_P = 1 * MiB, WS_CUMLOC = 2 * MiB, WS_CTOT = 3 * MiB, WS_SSM = 4 * MiB, WS_W = 16 * MiB, WS_HB = 52 * MiB;
constexpr size_t WS_B1 = 84 * MiB, WS_B2 = 116 * MiB, WS_B3 = 148 * MiB, WS_B4 = 180 * MiB, WS_Y = 212 * MiB, WS_END = 244 * MiB;
constexpr int W_C0IN = 0, W_C0OUT = 3072, W_FIN = 4096, W_FF = 8192, W_FOUT = 8448, W_SIN = 9472, W_SGLU = 11520, W_SOUT = 12544, W_C1IN = 13568, W_C1OUT = 16640, W_ROWS = 17664;
static_assert(WS_W + (size_t)W_ROWS * 2048 <= WS_HB, "weights fit");

__device__ __forceinline__ unsigned f2bf_(float f) { unsigned u = __builtin_bit_cast(unsigned, f); return (u + 0x7fffu + ((u >> 16) & 1u)) >> 16; }
__device__ __forceinline__ unsigned pk2(float lo, float hi) { return f2bf_(lo) | (f2bf_(hi) << 16); }
__device__ __forceinline__ float wave_sum(float v) {
#pragma unroll
    for (int o = 1; o < 64; o <<= 1) v += __shfl_xor(v, o);
    return v;
}
#define GAS __attribute__((address_space(1)))
#define RLX_AGENT __ATOMIC_RELAXED, __HIP_MEMORY_SCOPE_AGENT
#define LDS_WAIT() asm volatile("s_waitcnt lgkmcnt(0)" ::: "memory")
#define VM_WAIT() asm volatile("s_waitcnt vmcnt(0)" ::: "memory")
#define XB_TMO      128
#define XB_XCNT(j)  (256  + 64 * (j))
#define XB_XSUB(j)  (1280 + 64 * (j))
#define XB_XGEN(j)  (2304 + 64 * (j))
#define XB_TOP      3328
#define XB_TOPGEN   3392
#define XCD_BAR_WORDS 3456
#define XB_SPIN_CAP (1u << 18)

__device__ __forceinline__ unsigned xb_ld(unsigned* p)              { return __hip_atomic_load(p, __ATOMIC_RELAXED, __HIP_MEMORY_SCOPE_AGENT); }
__device__ __forceinline__ unsigned xb_add(unsigned* p, unsigned v) { return __hip_atomic_fetch_add(p, v, __ATOMIC_RELAXED, __HIP_MEMORY_SCOPE_AGENT); }
__device__ __forceinline__ unsigned xb_xcc_id() { return (unsigned)__builtin_amdgcn_s_getreg((3 << 11) | 20) & 0xFu; }
#define XB_SPIN(cond, bar) do { unsigned _sp = 0; while (cond) { __builtin_amdgcn_s_sleep(1); \
    if ((++_sp & 255u) == 0u) { if (xb_ld(&(bar)[XB_TMO])) break; if (_sp > XB_SPIN_CAP) { atomicAdd(&(bar)[XB_TMO], 1u); break; } } } } while (0)

struct XcdBarrier {
    unsigned* bar; unsigned x; unsigned gsz;
    volatile LAS unsigned* st;
};

__device__ __forceinline__ XcdBarrier xcd_barrier_post(unsigned* bar, volatile LAS unsigned* st, const int tid, unsigned gsz) {
    XcdBarrier b; b.bar = bar; b.x = xb_xcc_id(); b.st = st; b.gsz = gsz;
    if (tid == 0) (void)xb_add(&bar[XB_XCNT(b.x)], 1u);
    return b;
}
__device__ __forceinline__ void xcd_barrier_complete(unsigned* bar, unsigned x, unsigned& nloc, unsigned& nx, const unsigned G) {
    unsigned sum, cnt, mine, sp = 0u;
    for (;;) {
        sum = 0u; cnt = 0u; mine = 0u;
#pragma unroll
        for (unsigned j = 0; j < 16; ++j) { const unsigned c = xb_ld(&bar[XB_XCNT(j)]); sum += c; cnt += (c > 0u) ? 1u : 0u; mine = (j == x) ? c : mine; }
        if (sum == G) break;
        __builtin_amdgcn_s_sleep(1);
        if ((++sp & 255u) == 0u) { if (xb_ld(&bar[XB_TMO])) break; if (sp > XB_SPIN_CAP) { atomicAdd(&bar[XB_TMO], 1u); break; } }
    }
    nloc = mine > 0u ? mine : 1u; nx = cnt > 0u ? cnt : 1u;
}

__device__ __forceinline__ void xcd_barrier(const XcdBarrier& b, const int tid) {
    asm volatile("s_waitcnt vmcnt(0)" ::: "memory");
    __syncthreads();
    if (tid == 0) {
        unsigned* bar = b.bar;
        __builtin_amdgcn_s_waitcnt(0);
        unsigned nloc = b.st[0], nx = b.st[1];
        if (nloc == 0u) { xcd_barrier_complete(bar, b.x, nloc, nx, b.gsz); b.st[0] = nloc; b.st[1] = nx; }
        const unsigned old = xb_add(&bar[XB_XSUB(b.x)], 1u);
        const unsigned gen = old / nloc;
        if (old + 1u == (gen + 1u) * nloc) {
            __builtin_amdgcn_fence(__ATOMIC_RELEASE, "agent");
            asm volatile("s_waitcnt vmcnt(0)" ::: "memory");
            const unsigned og = xb_add(&bar[XB_TOP], 1u);
            const unsigned tg = og / nx;
            if (og + 1u == (tg + 1u) * nx) xb_add(&bar[XB_TOPGEN], 1u);
            else XB_SPIN(xb_ld(&bar[XB_TOPGEN]) == tg, bar);
            __builtin_amdgcn_fence(__ATOMIC_ACQUIRE, "agent");
            xb_add(&bar[XB_XGEN(b.x)], 1u);
            asm volatile("s_waitcnt vmcnt(0)" ::: "memory");
        } else {
            XB_SPIN(xb_ld(&bar[XB_XGEN(b.x)]) == gen, bar);
            __builtin_amdgcn_fence(__ATOMIC_ACQUIRE, "agent");
            asm volatile("s_waitcnt vmcnt(0)" ::: "memory");
        }
    }
    __syncthreads();
}

__device__ __forceinline__ int lane_id_fresh() { int r; asm volatile("v_mbcnt_lo_u32_b32 %0, -1, 0\n\tv_mbcnt_hi_u32_b32 %0, -1, %0" : "=v"(r)); return r; }
struct Args { const float* in[25]; float* out; unsigned char* ws; int ph_lo, ph_hi; };

__device__ __forceinline__ int dst_row32(int s, int mode) {
    if (mode == 1) { if (s < 1024) return 256 * (s >> 7) + (s & 127); if (s < 2048) { const int t = s - 1024; return 256 * (t >> 7) + 128 + (t & 127); } return s; }
    if (mode == 2) { const int sec = s >> 10, hd = (s & 1023) >> 6, bj = (s & 63) >> 5, e = s & 31; return 1024 * sec + 256 * (hd >> 2) + 128 * bj + 32 * (hd & 3) + e; }
    return s;
}
__device__ __forceinline__ void p0_transpose_item(const float* W, int ldw, int N, const float* gain, bf16_t* WT, int mode, int item, int lane) {
    const int nblk = N / 64, kb = item / nblk, nb = item % nblk, k0 = 64 * kb, n0 = 64 * nb, q = lane >> 4, nn = lane & 15;
    f32x4 v[16]; f32x4 gk[4];
    const float* src = W + (size_t)(k0 + 16 * q) * ldw + n0 + 4 * nn;
#pragma unroll
    for (int i = 0; i < 16; ++i) v[i] = __builtin_nontemporal_load((const f32x4*)(src + (size_t)i * ldw));
#pragma unroll
    for (int i = 0; i < 4; ++i) gk[i] = (f32x4){1.f, 1.f, 1.f, 1.f};
    if (gain) {
#pragma unroll
        for (int i = 0; i < 4; ++i) gk[i] = *(const f32x4*)(gain + k0 + 16 * q + 4 * i);
    }
#pragma unroll
    for (int i = 0; i < 16; ++i) v[i] = v[i] * gk[i >> 2][i & 3];
#pragma unroll
    for (int e = 0; e < 4; ++e) { const int n = 4 * nn + e, r = dst_row32(n0 + (n & 32), mode) + (n & 31); bf16_t* d = WT + (size_t)r * 1024 + k0 + 16 * q;
#pragma unroll
        for (int h = 0; h < 2; ++h) { u32x4 o; o.x = pk2(v[8 * h][e], v[8 * h + 1][e]); o.y = pk2(v[8 * h + 2][e], v[8 * h + 3][e]); o.z = pk2(v[8 * h + 4][e], v[8 * h + 5][e]); o.w = pk2(v[8 * h + 6][e], v[8 * h + 7][e]);
            *(u32x4*)(d + 8 * h) = o; } }
}
constexpr int P0_I3072 = 16 * 3072 / 64, P0_NITEMS = 2 * (16 * 3072 / 64) + 5 * (16 * 1024 / 64) + 16 * 4096 / 64 + 16 * 2048 / 64;
__device__ __forceinline__ void p0_prologue(const Args& a, LAS unsigned char* lds, int vcu, int G, const int tid, const int item_lo, const int item_hi, const bool do_wf, const int row_lo, const int row_hi) {
    const int lane = tid & 63, wave = __builtin_amdgcn_readfirstlane(tid >> 6);
    const int gw = vcu * NWAVES + wave, NGW = G * NWAVES;
    bf16_t* WB = (bf16_t*)(a.ws + WS_W);
    const float* ng = a.in[1];
    constexpr int I3072 = 16 * 3072 / 64, I1024 = 16 * 1024 / 64, I4096 = 16 * 4096 / 64, I2048 = 16 * 2048 / 64;
    const int NITEMS = item_hi - item_lo;
    const int nfull = NITEMS / NGW, nloop = nfull + ((NITEMS - nfull * NGW) + G * NWAVES - 1) / (G * NWAVES);
    for (int k = 0; k < nloop; ++k) {
        const int it = k < nfull ? k * NGW + gw : nfull * NGW + (k - nfull) * NGW + vcu + G * wave;
        if (it >= NITEMS) continue;
        int r = it + item_lo;
        if (r < I3072) { p0_transpose_item(a.in[2], 3072, 3072, ng, WB + (size_t)W_C0IN * 1024, 1, r, lane); continue; } r -= I3072;
        if (r < I1024) { p0_transpose_item(a.in[7], 1024, 1024, nullptr, WB + (size_t)W_C0OUT * 1024, 0, r, lane); continue; } r -= I1024;
        if (r < I4096) { p0_transpose_item(a.in[8], 4112, 4096, ng + 1024, WB + (size_t)W_FIN * 1024, 2, r, lane); continue; } r -= I4096;
        if (r < I1024) { p0_transpose_item(a.in[12], 1024, 1024, nullptr, WB + (size_t)W_FOUT * 1024, 0, r, lane); continue; } r -= I1024;
        if (r < I2048) { p0_transpose_item(a.in[13], 2048, 2048, ng + 2048, WB + (size_t)W_SIN * 1024, 0, r, lane); continue; } r -= I2048;
        if (r < I1024) { p0_transpose_item(a.in[22], 1024, 1024, nullptr, WB + (size_t)W_SGLU * 1024, 0, r, lane); continue; } r -= I1024;
        if (r < I1024) { p0_transpose_item(a.in[24], 1024, 1024, nullptr, WB + (size_t)W_SOUT * 1024, 0, r, lane); continue; } r -= I1024;
        if (r < I3072) { p0_transpose_item(a.in[2] + (size_t)1024 * 3072, 3072, 3072, ng + 3072, WB + (size_t)W_C1IN * 1024, 1, r, lane); continue; } r -= I3072;
        p0_transpose_item(a.in[7] + (size_t)1024 * 1024, 1024, 1024, nullptr, WB + (size_t)W_C1OUT * 1024, 0, r, lane);
    }
    if (do_wf) for (int e = vcu * 512 + tid; e < 16 * 1024; e += G * 512) { const int n = e >> 10, k = e & 1023; WB[(size_t)(W_FF + n) * 1024 + k] = (bf16_t)f2bf_(a.in[8][(size_t)k * 4112 + 4096 + n] * ng[1024 + k]); }
    bf16_t* hb = (bf16_t*)(a.ws + WS_HB); float* P = (float*)(a.ws + WS_P);
    for (int m0 = row_lo + 4 * gw; m0 < row_hi; m0 += 4 * NGW) {
        f32x4 v[4][4];
#pragma unroll
        for (int r = 0; r < 4; ++r)
#pragma unroll
            for (int j = 0; j < 4; ++j) v[r][j] = __builtin_nontemporal_load(((const f32x4*)(a.in[0] + (size_t)(m0 + r) * 1024)) + lane + 64 * j);
#pragma unroll
        for (int r = 0; r < 4; ++r) { float s = 0.f; unsigned long long* o8 = (unsigned long long*)(hb + (size_t)(m0 + r) * 1024) + lane;
#pragma unroll
            for (int j = 0; j < 4; ++j) { const f32x4 x = v[r][j]; s += (x[0] * x[0] + x[1] * x[1]) + (x[2] * x[2] + x[3] * x[3]);
                o8[64 * j] = (unsigned long long)pk2(x[0], x[1]) | ((unsigned long long)pk2(x[2], x[3]) << 32); }
            s = wave_sum(s);
            if (lane < 4) ((f32x4*)(P + (size_t)(m0 + r) * 16))[lane] = (f32x4){lane == 0 ? s : 0.f, 0.f, 0.f, 0.f}; }
    }
}
__device__ __forceinline__ void conv_phase(LAS unsigned char* lds, const bf16_t* U, const bf16_t* SG, const float* cw, const float* cb, const float* lg, const float* lb, bf16_t* Y, int vcu, int G, const int tid, const int mtok) {
    const int lane = tid & 63, wave = __builtin_amdgcn_readfirstlane(tid >> 6);
    f32x2 w[CONV_K];
#pragma unroll
    for (int j = 0; j < CONV_K; ++j) w[j] = *(const f32x2*)(cw + (size_t)j * 1024 + 2 * tid);
    const f32x2 bias = *(const f32x2*)(cb + 2 * tid);
    LAS float* tile = (LAS float*)lds;
    for (int unit = vcu; unit < mtok / 32; unit += G) {
        const int t0 = unit * 32, seq0 = t0 & ~(SEQ - 1);

        f32x2 out[32];
#pragma unroll
        for (int tt = 0; tt < 32; ++tt) out[tt] = bias;
#pragma unroll
        for (int i = 0; i < 62; ++i) {
            const int row = t0 - 30 + i, rowc = row < seq0 ? seq0 : row;
            const unsigned raw = *(const unsigned*)(U + (size_t)rowc * 1024 + 2 * tid);
            f32x2 uv; uv.x = __uint_as_float(raw << 16); uv.y = __uint_as_float(raw & 0xffff0000u);
            if (row < seq0) uv = (f32x2){0.f, 0.f};
#pragma unroll
            for (int tt = (i > 30 ? i - 30 : 0); tt <= (i < 31 ? i : 31); ++tt) out[tt] += w[i - tt] * uv;
        }
#pragma unroll
        for (int tt = 0; tt < 32; ++tt) *(LAS f32x2*)(tile + tt * 1024 + 2 * tid) = out[tt];
        __syncthreads();
        {
            u32x4 sgv[4][2]; f32x4 gg[4], bbv[4];
#pragma unroll
            for (int q = 0; q < 4; ++q)
#pragma unroll
                for (int hf = 0; hf < 2; ++hf) sgv[q][hf] = __builtin_nontemporal_load((const u32x4*)(SG + (size_t)(t0 + wave * 4 + q) * 1024 + 8 * lane + 512 * hf));
#pragma unroll
            for (int hf = 0; hf < 2; ++hf) { gg[2 * hf] = *(const f32x4*)(lg + 8 * lane + 512 * hf); gg[2 * hf + 1] = *(const f32x4*)(lg + 8 * lane + 512 * hf + 4);
                bbv[2 * hf] = *(const f32x4*)(lb + 8 * lane + 512 * hf); bbv[2 * hf + 1] = *(const f32x4*)(lb + 8 * lane + 512 * hf + 4); }
            f32x4 v[4][4]; float s1[4], s2[4];
#pragma unroll
            for (int q = 0; q < 4; ++q) { const LAS float* tr = tile + (wave * 4 + q) * 1024 + 8 * lane;
                v[q][0] = *(const LAS f32x4*)(tr); v[q][1] = *(const LAS f32x4*)(tr + 4); v[q][2] = *(const LAS f32x4*)(tr + 512); v[q][3] = *(const LAS f32x4*)(tr + 516);
                s1[q] = 0.f; s2[q] = 0.f;
#pragma unroll
                for (int j = 0; j < 4; ++j) { s1[q] += (v[q][j][0] + v[q][j][1]) + (v[q][j][2] + v[q][j][3]); s2[q] += (v[q][j][0] * v[q][j][0] + v[q][j][1] * v[q][j][1]) + (v[q][j][2] * v[q][j][2] + v[q][j][3] * v[q][j][3]); } }
#pragma unroll
            for (int o = 1; o < 64; o <<= 1)
#pragma unroll
                for (int q = 0; q < 4; ++q) { s1[q] += __shfl_xor(s1[q], o); s2[q] += __shfl_xor(s2[q], o); }
#pragma unroll
            for (int q = 0; q < 4; ++q) {
                const float mu = s1[q] * (1.0f / 1024.0f), var = fmaxf(s2[q] * (1.0f / 1024.0f) - mu * mu, 0.f), rstd = rsqrtf(var + LN_EPS);
                const size_t off = (size_t)(t0 + wave * 4 + q) * 1024 + 8 * lane;
#pragma unroll
                for (int hf = 0; hf < 2; ++hf) { const u32x4 sg = sgv[q][hf];
                    const f32x4 y0 = (v[q][2 * hf] - mu) * rstd * gg[2 * hf] + bbv[2 * hf], y1 = (v[q][2 * hf + 1] - mu) * rstd * gg[2 * hf + 1] + bbv[2 * hf + 1]; u32x4 o;
                    o.x = pg8::cvt_pk_bf16(pg8::silu(y0[0]) * pg8::bflo(sg.x), pg8::silu(y0[1]) * pg8::bfhi(sg.x));
                    o.y = pg8::cvt_pk_bf16(pg8::silu(y0[2]) * pg8::bflo(sg.y), pg8::silu(y0[3]) * pg8::bfhi(sg.y));
                    o.z = pg8::cvt_pk_bf16(pg8::silu(y1[0]) * pg8::bflo(sg.z), pg8::silu(y1[1]) * pg8::bfhi(sg.z));
                    o.w = pg8::cvt_pk_bf16(pg8::silu(y1[2]) * pg8::bflo(sg.w), pg8::silu(y1[3]) * pg8::bfhi(sg.w));
                    *(u32x4*)(Y + off + 512 * hf) = o; }
            }
        }
        __syncthreads();
    }
}
__device__ __forceinline__ void fcum_phase(LAS unsigned char* lds, const bf16_t* hb, const bf16_t* Wf, const float* P, const float* fbias, float* cumloc, float* ctot, int vcu, int G, const int tid, const int mtok) {
    const int lane = tid & 63, wave = __builtin_amdgcn_readfirstlane(tid >> 6);
    LAS float* part = (LAS float*)lds;
    LAS float* lf = part + 2 * 64 * 17;
    for (int ch = vcu; ch < mtok / 64; ch += G) {
        f32x4 pq[2][4];
#pragma unroll
        for (int e = 0; e < 2; ++e) { const f32x4* pp = (const f32x4*)(P + (size_t)(ch * 64 + ((tid + 512 * e) >> 4)) * 16); pq[e][0] = pp[0]; pq[e][1] = pp[1]; pq[e][2] = pp[2]; pq[e][3] = pp[3]; }
        {
            const int tg = wave & 3, kh = wave >> 2, tok0 = ch * 64 + tg * 16;
            const bf16_t* ap = hb + (size_t)(tok0 + (lane & 15)) * 1024 + kh * 512 + 8 * (lane >> 4);
            const bf16_t* bp = Wf + (size_t)(lane & 15) * 1024 + kh * 512 + 8 * (lane >> 4);
            bf16x8_t av[16], bv[16];
#pragma unroll
            for (int ks = 0; ks < 16; ++ks) { av[ks] = *(const bf16x8_t*)(ap + ks * 32); bv[ks] = *(const bf16x8_t*)(bp + ks * 32); }
            f32x4 acc = (f32x4){0.f, 0.f, 0.f, 0.f};
#pragma unroll
            for (int ks = 0; ks < 16; ++ks) acc = __builtin_amdgcn_mfma_f32_16x16x32_bf16(av[ks], bv[ks], acc, 0, 0, 0);
#pragma unroll
            for (int r = 0; r < 4; ++r) part[(kh * 64 + tg * 16 + 4 * (lane >> 4) + r) * 17 + (lane & 15)] = acc[r];
        }
        __syncthreads();
#pragma unroll
        for (int e = 0; e < 2; ++e) {
            const int idx = tid + 512 * e, tl = idx >> 4, h = idx & 15;
            const f32x4 p0 = pq[e][0], p1 = pq[e][1], p2 = pq[e][2], p3 = pq[e][3];
            const float ss = ((p0[0] + p0[1]) + (p0[2] + p0[3])) + ((p1[0] + p1[1]) + (p1[2] + p1[3])) + ((p2[0] + p2[1]) + (p2[2] + p2[3])) + ((p3[0] + p3[1]) + (p3[2] + p3[3]));
            const float x = (part[tl * 17 + h] + part[(64 + tl) * 17 + h]) * rsqrtf(ss * (1.0f / 1024.0f) + RMS_EPS) + fbias[h];
            lf[tl * 17 + h] = (fminf(x, 0.f) - log1pf(__expf(-fabsf(x)))) * LOG2E; }
        __syncthreads();
#pragma unroll
        for (int e = 0; e < 2; ++e) {
            const int h = 2 * wave + e; float c = lf[lane * 17 + h];
#pragma unroll
            for (int o = 1; o < 64; o <<= 1) { const float nn = __shfl_up(c, o); if (lane >= o) c += nn; }
            const int b = ch / (SEQ / 64), cc = ch % (SEQ / 64);
            cumloc[((size_t)(b * NHEADS + h)) * SEQ + cc * 64 + lane] = c;
            if (lane == 63) ctot[(size_t)ch * 16 + h] = c; }
        __syncthreads();
    }
}
constexpr int SSM_OFF_BM = 0, SSM_OFF_PW = 65536, SSM_OFF_KT = SSM_OFF_PW + 2560, SSM_OFF_CM = SSM_OFF_KT + 8704, SSM_GS = SSM_OFF_CM + 65536;
constexpr size_t WS_SSM_PN = 13 * MiB;
static_assert(WS_SSM + (size_t)NGRP * SSM_GS <= WS_SSM_PN && SSM_GS <= MISC_OFF, "ssm tables");

__device__ __forceinline__ f32x4 cmul2(const f32x4 a, const f32x4 x) { return (f32x4){a[0] * x[0] - a[1] * x[1], a[0] * x[1] + a[1] * x[0], a[2] * x[2] - a[3] * x[3], a[2] * x[3] + a[3] * x[2]}; }
template <int CTRL> __device__ __forceinline__ float dpp_f(float v) { return __builtin_bit_cast(float, __builtin_amdgcn_update_dpp(0, __builtin_bit_cast(int, v), CTRL, 0xf, 0xf, true)); }
template <int CTRL> __device__ __forceinline__ f32x4 dpp4(const f32x4 v) { return (f32x4){dpp_f<CTRL>(v[0]), dpp_f<CTRL>(v[1]), dpp_f<CTRL>(v[2]), dpp_f<CTRL>(v[3])}; }

__device__ __forceinline__ void ssm_tables(const Args& a, LAS unsigned char* lds, int vcu, int G, const int tid) {
    const float* log_dt = a.in[14]; const float* a_re = a.in[15]; const float* a_im = a.in[16]; const float* b_re = a.in[17]; const float* b_im = a.in[18];
    const float* c_re = a.in[19]; const float* c_im = a.in[20];
    LAS float* pw = (LAS float*)lds;
    LAS float* bb = pw + 17 * 64 * 2;
    LAS float* big = bb + 64 * 17 * 2;
    LAS float* cc = big + 21 * 64 * 2;
    LAS float* zz = cc + 16 * 65 * 2;
    for (int unit = vcu; unit < 4 * NGRP; unit += G) {
        const int g = unit >> 2, sub = unit & 3;
        __syncthreads();
        if (tid < 64) {
            const int p = tid; const double dt = exp((double)log_dt[g]);
            const float are = a_re[g * 64 + p], aim = a_im[g * 64 + p], x = are * (float)dt;
            double ang = (double)aim * dt; ang -= 6.283185307179586 * rint(ang * 0.15915494309189535);
            float sn, cs, sh, ch; sincosf((float)ang, &sn, &cs); sincosf(0.5f * (float)ang, &sh, &ch);
            const float em1 = expm1f(x), mag = em1 + 1.0f, abr = mag * cs, abi = mag * sn;
            const float nr = em1 * cs - 2.0f * sh * sh, ni = mag * sn, den = are * are + aim * aim;
            zz[p * 2] = (nr * are + ni * aim) / den; zz[p * 2 + 1] = (ni * are - nr * aim) / den;
            float pr = 1.0f, pi = 0.0f;
#pragma unroll
            for (int l = 0; l <= 16; ++l) { pw[(l * 64 + p) * 2] = pr; pw[(l * 64 + p) * 2 + 1] = pi; const float t = pr * abr - pi * abi; pi = pr * abi + pi * abr; pr = t; }
            float qr = pw[(16 * 64 + p) * 2], qi = pw[(16 * 64 + p) * 2 + 1]; const float ar16 = qr, ai16 = qi;
#pragma unroll
            for (int d = 0; d < 5; ++d) { big[(d * 64 + p) * 2] = qr; big[(d * 64 + p) * 2 + 1] = qi; const float t = qr * qr - qi * qi; qi = 2.0f * qr * qi; qr = t; }
            qr = 1.0f; qi = 0.0f;
#pragma unroll
            for (int n = 0; n < 16; ++n) { big[((5 + n) * 64 + p) * 2] = qr; big[((5 + n) * 64 + p) * 2 + 1] = qi; const float t = qr * ar16 - qi * ai16; qi = qr * ai16 + qi * ar16; qr = t; }
        } else {
            for (int job = tid - 64; job < 1024; job += 448) { const int c = job >> 6, p = job & 63; cc[(c * 65 + p) * 2] = c_re[(size_t)g * 1024 + job]; cc[(c * 65 + p) * 2 + 1] = c_im[(size_t)g * 1024 + job]; }
        }
        __syncthreads();
        for (int job = tid; job < 1024; job += 512) { const int p = job >> 4, c = job & 15; const float zr = zz[p * 2], zi = zz[p * 2 + 1];
            const float br = b_re[(size_t)g * 1024 + job], bi = b_im[(size_t)g * 1024 + job];
            bb[(p * 17 + c) * 2] = zr * br - zi * bi; bb[(p * 17 + c) * 2 + 1] = zr * bi + zi * br; }
        __syncthreads();
        unsigned char* gb = a.ws + WS_SSM + (size_t)g * SSM_GS;
        for (int job = tid; job < 1024; job += 512) {
            const int fl = job >> 6, l = job & 63, rt = 2 * sub + (fl >> 3), s = fl & 7, R = 16 * rt + (l & 15), p = R >> 1, part = R & 1, j = 2 * s + (l >> 5), c0 = 8 * ((l >> 4) & 1);
            const float pr = pw[((15 - j) * 64 + p) * 2], pi = pw[((15 - j) * 64 + p) * 2 + 1]; float v[8];
#pragma unroll
            for (int e = 0; e < 8; ++e) { const float xr = bb[(p * 17 + c0 + e) * 2], xi = bb[(p * 17 + c0 + e) * 2 + 1]; v[e] = part ? (pr * xi + pi * xr) : (pr * xr - pi * xi); }
            *(u32x4*)(gb + SSM_OFF_BM + ((rt * 8 + s) * 64 + l) * 16) = (u32x4){pk2(v[0], v[1]), pk2(v[2], v[3]), pk2(v[4], v[5]), pk2(v[6], v[7])}; }
        for (int job = tid; job < 1024; job += 512) {
            const int fl = job >> 6, l = job & 63, i = 4 * sub + (fl >> 2), s = fl & 3, c = l & 15, q = l >> 4; float v[8];
#pragma unroll
            for (int e = 0; e < 8; ++e) { const int R = 16 * (2 * s + (e >> 2)) + 4 * q + (e & 3), p = R >> 1, part = R & 1;
                const float cr = cc[(c * 65 + p) * 2], ci = cc[(c * 65 + p) * 2 + 1], pr = pw[((i + 1) * 64 + p) * 2], pi = pw[((i + 1) * 64 + p) * 2 + 1];
                v[e] = part ? -(cr * pi + ci * pr) : (cr * pr - ci * pi); }
            *(u32x4*)(gb + SSM_OFF_CM + ((i * 4 + s) * 64 + l) * 16) = (u32x4){pk2(v[0], v[1]), pk2(v[2], v[3]), pk2(v[4], v[5]), pk2(v[6], v[7])}; }
        for (int idx = sub + 4 * tid; idx < 17 * 256; idx += 2048) {
            const int lagi = idx >> 8, c = (idx >> 4) & 15, c2 = idx & 15; float acc = 0.f;
            if (lagi > 0) {
#pragma unroll 16
                for (int p = 0; p < 64; ++p) { const float cr = cc[(c * 65 + p) * 2], ci = cc[(c * 65 + p) * 2 + 1], pr = pw[((lagi - 1) * 64 + p) * 2], pi = pw[((lagi - 1) * 64 + p) * 2 + 1];
                    const float tr = cr * pr - ci * pi, ti = cr * pi + ci * pr; acc += tr * bb[(p * 17 + c2) * 2] - ti * bb[(p * 17 + c2) * 2 + 1]; }
            }
            *(bf16_t*)(gb + SSM_OFF_KT + idx * 2) = (bf16_t)f2bf_(acc); }
        if (sub == 0) for (int job = tid; job < 21 * 32; job += 512) {
            const int d = job >> 5, rt = (job >> 2) & 7, q = job & 3, p0 = 8 * rt + 2 * q;
            const f32x4 v = (f32x4){big[(d * 64 + p0) * 2], big[(d * 64 + p0) * 2 + 1], big[(d * 64 + p0 + 1) * 2], big[(d * 64 + p0 + 1) * 2 + 1]};
            if (d < 5) *(f32x4*)(gb + SSM_OFF_PW + ((d * 8 + rt) * 4 + q) * 16) = v;
            else *(f32x4*)(a.ws + WS_SSM_PN + ((((size_t)g * 8 + rt) * 16 + (d - 5)) * 4 + q) * 16) = v; }
    }
}
constexpr int SSM_OFF_EX = SSM_GS;
static_assert(SSM_OFF_EX + 8 * 128 * 4 <= MISC_OFF, "ssm exchange area");
__device__ __forceinline__ void ssm_phase(LAS unsigned char* lds, unsigned char* ws, const bf16_t* U, const float* dsk, bf16_t* GO, int vcu, int G, const int tid, const int nsub) {
    const int lane = tid & 63, wave = __builtin_amdgcn_readfirstlane(tid >> 6), n = lane & 15, q = lane >> 4;
    for (int unit = vcu; unit < nsub * NGRP; unit += G) {
        const int g = unit / nsub, sub = unit % nsub;
        __syncthreads();
        { const unsigned char* gb = ws + WS_SSM + (size_t)g * SSM_GS;
          constexpr int NFULL = SSM_GS / 8192, TAIL = SSM_GS - NFULL * 8192; u32x4 tv[NFULL + 1];
#pragma unroll
          for (int it = 0; it < NFULL; ++it) tv[it] = ((const u32x4*)(gb + it * 8192))[tid];
          tv[NFULL] = ((const u32x4*)(gb + NFULL * 8192))[tid < TAIL / 16 ? tid : 0];
#pragma unroll
          for (int it = 0; it < NFULL; ++it) ((LAS u32x4*)(lds + it * 8192))[tid] = tv[it];
          if (tid < TAIL / 16) ((LAS u32x4*)(lds + NFULL * 8192))[tid] = tv[NFULL]; }
        __syncthreads();
        const int pair = sub * 8 + wave, b = pair >> 2, seg = pair & 3;
        const LAS f32x4* PW = (const LAS f32x4*)(lds + SSM_OFF_PW);
        const f32x4* PN = (const f32x4*)(ws + WS_SSM_PN) + (size_t)g * 8 * 16 * 4;
#define A16(rt) (PW[(4 * 8 + (rt)) * 4 + QQ])
#define QQ q
        const int tokb = b * SEQ + seg * 512;
        const bf16_t* Ub = U + (size_t)tokb * 1024 + g * 16; bf16_t* Gb = GO + (size_t)tokb * 1024 + g * 16;
        unsigned uoff = (unsigned)((16 * n + (lane >> 5)) * 1024 + 8 * ((lane >> 4) & 1)), eoff = (unsigned)(16 * n * 1024 + 4 * q);
        f32x4 I0[8], I1[8];
        {
            bf16x8_t uf[8];
#pragma unroll
            for (int s = 0; s < 8; ++s) uf[s] = *(const bf16x8_t*)((Ub + (2 * s) * 1024) + uoff);
            bf16x8_t fa[2][8];
#pragma unroll
            for (int s = 0; s < 8; ++s) fa[0][s] = *(const LAS bf16x8_t*)(lds + SSM_OFF_BM + ((0 * 8 + s) * 64 + lane) * 16);
#pragma unroll
            for (int rt = 0; rt < 8; ++rt) { I0[rt] = (f32x4){0.f, 0.f, 0.f, 0.f};
                if (rt < 7) {
#pragma unroll
                    for (int s = 0; s < 8; ++s) fa[(rt + 1) & 1][s] = *(const LAS bf16x8_t*)(lds + SSM_OFF_BM + (((rt + 1) * 8 + s) * 64 + lane) * 16);
                }
                __builtin_amdgcn_sched_barrier(0);
#pragma unroll
                for (int s = 0; s < 8; ++s) I0[rt] = __builtin_amdgcn_mfma_f32_16x16x32_bf16(fa[rt & 1][s], uf[s], I0[rt], 0, 0, 0);
                __builtin_amdgcn_sched_barrier(0); }
#pragma unroll
            for (int s = 0; s < 8; ++s) uf[s] = *(const bf16x8_t*)((Ub + (256 + 2 * s) * 1024) + uoff);
#pragma unroll
            for (int s = 0; s < 8; ++s) fa[0][s] = *(const LAS bf16x8_t*)(lds + SSM_OFF_BM + ((0 * 8 + s) * 64 + lane) * 16);
#pragma unroll
            for (int rt = 0; rt < 8; ++rt) { I1[rt] = (f32x4){0.f, 0.f, 0.f, 0.f};
                if (rt < 7) {
#pragma unroll
                    for (int s = 0; s < 8; ++s) fa[(rt + 1) & 1][s] = *(const LAS bf16x8_t*)(lds + SSM_OFF_BM + (((rt + 1) * 8 + s) * 64 + lane) * 16);
                }
                __builtin_amdgcn_sched_barrier(0);
#pragma unroll
                for (int s = 0; s < 8; ++s) I1[rt] = __builtin_amdgcn_mfma_f32_16x16x32_bf16(fa[rt & 1][s], uf[s], I1[rt], 0, 0, 0);
                __builtin_amdgcn_sched_barrier(0); }
        }
#pragma unroll
        for (int rt = 0; rt < 8; ++rt) { const f32x4 an = PN[(rt * 16 + (15 - n)) * 4 + q];
            f32x4 t0 = cmul2(an, I0[rt]), t1 = cmul2(an, I1[rt]);
            t0 = t0 + dpp4<0x128>(t0); t0 = t0 + dpp4<0x124>(t0); t0 = t0 + dpp4<0x122>(t0); t0 = t0 + dpp4<0x121>(t0);
            t1 = t1 + dpp4<0x128>(t1); t1 = t1 + dpp4<0x124>(t1); t1 = t1 + dpp4<0x122>(t1); t1 = t1 + dpp4<0x121>(t1);
            const f32x4 e = cmul2(A16(rt), t0) + t1;
            if (n == 0) *(LAS f32x4*)(lds + SSM_OFF_EX + wave * 512 + (rt * 4 + q) * 16) = e; }
        __syncthreads();
#undef QQ
#define QQ qb_
        int tqb = tid; asm volatile("" : "+v"(tqb));
        const int laneb = tqb & 63, nb_ = laneb & 15, qb_ = laneb >> 4;
        unsigned uoffb = (unsigned)((16 * nb_ + (laneb >> 5)) * 1024 + 8 * ((laneb >> 4) & 1)), eoffb = (unsigned)(16 * nb_ * 1024 + 4 * qb_);
        f32x4 carry[8];
#pragma unroll
        for (int rt = 0; rt < 8; ++rt) carry[rt] = (f32x4){0.f, 0.f, 0.f, 0.f};
        for (int m = 0; m < seg; ++m) {
#pragma unroll
            for (int rt = 0; rt < 8; ++rt) { const f32x4 a16 = A16(rt); const f32x4 a32 = cmul2(a16, a16); const f32x4 e = *(const LAS f32x4*)(lds + SSM_OFF_EX + (wave - seg + m) * 512 + (rt * 4 + qb_) * 16);
                carry[rt] = cmul2(a32, carry[rt]) + e; }
        }
        __syncthreads();
        const f32x4 dv = *(const f32x4*)(dsk + g * 16 + 4 * qb_);
#pragma unroll
        for (int rt = 0; rt < 8; ++rt) *(LAS f32x4*)(lds + SSM_OFF_BM + wave * 8192 + (rt * 64 + laneb) * 16) = I1[rt];
#pragma unroll
        for (int batch = 0; batch < 2; ++batch) {
            f32x4 (&I)[8] = I0;
            asm volatile("" : "+v"(uoffb), "+v"(eoffb));
            if (batch == 1) {
#pragma unroll
                for (int rt = 0; rt < 8; ++rt) { I0[rt] = *(const LAS f32x4*)(lds + SSM_OFF_BM + wave * 8192 + (rt * 64 + laneb) * 16); carry[rt] = *(const LAS f32x4*)(lds + SSM_OFF_EX + wave * 512 + (rt * 4 + qb_) * 16); }
            }
#pragma unroll
            for (int rt = 0; rt < 8; ++rt) I[rt] = I[rt] + cmul2(PW[(0 * 8 + rt) * 4 + qb_], dpp4<0x111>(I[rt]));
#pragma unroll
            for (int rt = 0; rt < 8; ++rt) I[rt] = I[rt] + cmul2(PW[(1 * 8 + rt) * 4 + qb_], dpp4<0x112>(I[rt]));
#pragma unroll
            for (int rt = 0; rt < 8; ++rt) I[rt] = I[rt] + cmul2(PW[(2 * 8 + rt) * 4 + qb_], dpp4<0x114>(I[rt]));
#pragma unroll
            for (int rt = 0; rt < 8; ++rt) I[rt] = I[rt] + cmul2(PW[(3 * 8 + rt) * 4 + qb_], dpp4<0x118>(I[rt]));
            bf16x8_t sf[4];
#pragma unroll
            for (int s = 0; s < 4; ++s) {
                const f32x4 p0 = dpp4<0x111>(I[2 * s]) + cmul2(PN[((2 * s) * 16 + nb_) * 4 + qb_], carry[2 * s]);
                const f32x4 p1 = dpp4<0x111>(I[2 * s + 1]) + cmul2(PN[((2 * s + 1) * 16 + nb_) * 4 + qb_], carry[2 * s + 1]);
                const u32x4 w = (u32x4){pg8::cvt_pk_bf16(p0[0], p0[1]), pg8::cvt_pk_bf16(p0[2], p0[3]), pg8::cvt_pk_bf16(p1[0], p1[1]), pg8::cvt_pk_bf16(p1[2], p1[3])};
                sf[s] = __builtin_bit_cast(bf16x8_t, w);
            }
            if (batch == 0) {
#pragma unroll
                for (int rt = 0; rt < 8; ++rt) { const f32x4 last = (f32x4){__shfl(I[rt][0], 15, 16), __shfl(I[rt][1], 15, 16), __shfl(I[rt][2], 15, 16), __shfl(I[rt][3], 15, 16)};
                    const f32x4 cn = cmul2(A16(rt), carry[rt]) + last; if (nb_ == 0) *(LAS f32x4*)(lds + SSM_OFF_EX + wave * 512 + (rt * 4 + qb_) * 16) = cn; }
            }
            bf16x8_t uf[8];
#pragma unroll
            for (int s = 0; s < 8; ++s) uf[s] = *(const bf16x8_t*)((Ub + (batch * 256 + 2 * s) * 1024) + uoffb);
            uint2 uwv[16]; bf16x8_t fc[4], kt[16];
#define SSM_LDC(ii) do { _Pragma("unroll") for (int s = 0; s < 4; ++s) fc[s] = *(const LAS bf16x8_t*)(lds + SSM_OFF_CM + (((ii) * 4 + s) * 64 + laneb) * 16); } while (0)
#define SSM_LDK(f) (*(const LAS bf16x8_t*)(lds + SSM_OFF_KT + (((f) + 1 - (laneb >> 5)) * 256 + (laneb & 15) * 16 + 8 * ((laneb >> 4) & 1)) * 2))
#pragma unroll
            for (int i = 0; i < 4; ++i) uwv[i] = *(const uint2*)((Ub + (batch * 256 + i) * 1024) + eoffb);
            SSM_LDC(0); kt[0] = SSM_LDK(0);
#pragma unroll
            for (int i = 0; i < 16; ++i) {
                __builtin_amdgcn_sched_barrier(0);
                f32x4 acc = (f32x4){0.f, 0.f, 0.f, 0.f};
#pragma unroll
                for (int s = 0; s < 4; ++s) acc = __builtin_amdgcn_mfma_f32_16x16x32_bf16(fc[s], sf[s], acc, 0, 0, 0);
                __builtin_amdgcn_sched_barrier(0);
                if (i + 1 < 16) { SSM_LDC(i + 1); kt[i + 1] = SSM_LDK(i + 1); }
                if (i + 4 < 16) uwv[i + 4] = *(const uint2*)((Ub + (batch * 256 + i + 4) * 1024) + eoffb);
                __builtin_amdgcn_sched_barrier(0);
#pragma unroll
                for (int s = 0; s <= i / 2; ++s) acc = __builtin_amdgcn_mfma_f32_16x16x32_bf16(kt[i - 2 * s], uf[s], acc, 0, 0, 0);
                const uint2 uw = uwv[i];
                const float y[4] = {acc[0] + dv[0] * pg8::bflo(uw.x), acc[1] + dv[1] * pg8::bfhi(uw.x), acc[2] + dv[2] * pg8::bflo(uw.y), acc[3] + dv[3] * pg8::bfhi(uw.y)};
                float ge[4];
#pragma unroll
                for (int r = 0; r < 4; ++r) ge[r] = y[r] * pg8::sigm(1.5957691216057308f * (y[r] + 0.044715f * y[r] * y[r] * y[r]));
                *(uint2*)((Gb + (batch * 256 + i) * 1024) + eoffb) = make_uint2(pg8::cvt_pk_bf16(ge[0], ge[1]), pg8::cvt_pk_bf16(ge[2], ge[3]));
                __builtin_amdgcn_sched_barrier(0);
            }
#undef SSM_LDC
#undef SSM_LDK
        }
#undef A16
#undef QQ
    }
}

template <class Epi> __device__ __forceinline__ void run_gemm(LAS unsigned char* lds, const bf16_t* A, const bf16_t* Bt, int N, const Epi& E, int G, const int tid, const int mtok, const int lb) {
    pg8::Gemm g{A, Bt, mtok, N, 1024}; pg8::StaticOrder S; S.init(mtok, N, G, lb);
    pg8::gemm_phase<Epi, pg8::StaticOrder, true, true>(lds, g, S, E, tid);
}
__global__ void __launch_bounds__(NWAVES * 64, 2) mega_fwd(Args args) {
    extern __shared__ __attribute__((aligned(16))) unsigned char lds_raw[];
    LAS unsigned char* lds = (LAS unsigned char*)lds_raw;
    const int G = gridDim.x, bx = blockIdx.x, vcu = (G % 8 == 0) ? (bx % 8) * (G / 8) + bx / 8 : bx;
    const int wave = __builtin_amdgcn_readfirstlane((int)threadIdx.x >> 6);
#define TID() (wave * 64 + lane_id_fresh())
    const int NH = (G == 256) ? 2 : 1, hh = NH == 2 ? (bx >> 7) & 1 : 0, lb = NH == 2 ? (bx & 127) : bx, GL = G / NH;
    const int vcl = (GL % 8 == 0) ? (lb % 8) * (GL / 8) + lb / 8 : lb, ML = MTOK / NH, BL = BATCH / NH;
    unsigned char* ws = args.ws;
    bf16_t* WB = (bf16_t*)(ws + WS_W);
    const size_t ro = (size_t)hh * ML;
    bf16_t* HB = (bf16_t*)(ws + WS_HB) + ro * 1024;
    bf16_t* B1 = (bf16_t*)(ws + WS_B1) + ro * 1024; bf16_t* B2 = (bf16_t*)(ws + WS_B2) + ro * 1024; bf16_t* B3 = (bf16_t*)(ws + WS_B3) + ro * 1024; bf16_t* B4 = (bf16_t*)(ws + WS_B4) + ro * 1024; bf16_t* YB = (bf16_t*)(ws + WS_Y) + ro * 1024;
    float* P = (float*)(ws + WS_P) + ro * 16; float* cumloc = (float*)(ws + WS_CUMLOC) + (size_t)hh * BL * NHEADS * SEQ; float* ctot = (float*)(ws + WS_CTOT) + (size_t)hh * (ML / 64) * 16;
    float* outp = args.out + ro * 1024;
    const int lo = args.ph_lo, hi = args.ph_hi;
#define IN(k) (lo <= (k) && (k) < hi)
    { const int t_ = TID(); if (t_ < 64) ((LAS unsigned*)(lds + MISC_OFF))[t_] = 0u; __syncthreads(); }
    XcdBarrier bar; bar.bar = (unsigned*)ws + hh * 4096; bar.x = 0; bar.st = nullptr; bar.gsz = 0;
    if (hi - lo > 1) bar = xcd_barrier_post((unsigned*)ws + hh * 4096, (volatile LAS unsigned*)(lds + MISC_OFF + 32), TID(), (unsigned)GL);
    if (lo < 0) cg::this_grid().sync();
#define SEAM(k) do { if (IN(k) && IN((k) + 1)) xcd_barrier(bar, TID()); } while (0)
    unsigned* const flg = (unsigned*)ws + 3 * 4096;
#define FLAG_WAIT(w) do { if (TID() == 0) { XB_SPIN(xb_ld(flg + (w)) == 0u, bar.bar); } } while (0)
#define FLAG_SET(w) do { if (lb == 0 && TID() == 0) __hip_atomic_store(flg + (w), 1u, __ATOMIC_RELAXED, __HIP_MEMORY_SCOPE_AGENT); } while (0)
    if (IN(0)) {
        if (NH == 2) { if (hh == 0) p0_prologue(args, lds, vcl, GL, TID(), 0, P0_I3072, false, 0, ML);
                       else { ssm_tables(args, lds, vcl, GL, TID()); p0_prologue(args, lds, vcl, GL, TID(), P0_I3072, P0_NITEMS, true, ML, 2 * ML); } }
        else { p0_prologue(args, lds, vcu, G, TID(), 0, P0_NITEMS, true, 0, MTOK); ssm_tables(args, lds, vcu, G, TID()); }
    }
    if (IN(0) && IN(1)) { if (NH == 2 && hh == 1) FLAG_WAIT(0); xcd_barrier(bar, TID()); if (NH == 2) FLAG_SET(64 * hh); }
    if (IN(1)) { pg8::EpiConvIn E{P, B1, B2}; run_gemm(lds, HB, WB + (size_t)W_C0IN * 1024, 3072, E, GL, TID(), ML, lb); } SEAM(1);
    if (IN(2)) { conv_phase(lds, B1, B2, args.in[3], args.in[4], args.in[5], args.in[6], YB, vcl, GL, TID(), ML); } if (NH == 2 && hh == 0 && IN(2) && IN(3)) FLAG_WAIT(64); SEAM(2);
    if (IN(3)) { pg8::EpiOut E{HB, P, outp, 0}; run_gemm(lds, YB, WB + (size_t)W_C0OUT * 1024, 1024, E, GL, TID(), ML, lb); } SEAM(3);
    if (IN(4)) { pg8::EpiFoxIn E{P, B1, B3, B4, B2, args.in[10], args.in[11]}; run_gemm(lds, HB, WB + (size_t)W_FIN * 1024, 4096, E, GL, TID(), ML, lb);
                 fcum_phase(lds, HB, WB + (size_t)W_FF * 1024, P, args.in[9], cumloc, ctot, vcl, GL, TID(), ML); } SEAM(4);
    if (IN(5)) { const attn_body::AttnTensors AT{(const attn_body::bf16*)B1, (const attn_body::bf16*)B3, (const attn_body::bf16*)B4, (const attn_body::bf16*)B2, (attn_body::bf16*)YB, cumloc, ctot, args.in[10], args.in[11]};
                 const attn_body::StaticOrder S(GL, lb, BL); attn_body::attn_phase<attn_body::StaticOrder>((char*)lds_raw, AT, S, TID()); } SEAM(5);
    if (IN(6)) { pg8::EpiOut E{HB, P, outp, 0}; run_gemm(lds, YB, WB + (size_t)W_FOUT * 1024, 1024, E, GL, TID(), ML, lb); } SEAM(6);
    if (IN(7)) { pg8::EpiSsmIn E{P, B1, B2}; run_gemm(lds, HB, WB + (size_t)W_SIN * 1024, 2048, E, GL, TID(), ML, lb); } SEAM(7);
    if (IN(8)) { ssm_phase(lds, ws, B1, args.in[21], B3, vcl, GL, TID(), BL * 4 / NWAVES); } SEAM(8);
    if (IN(10)) { pg8::EpiGlu E{B3, B2, args.in[23], YB}; run_gemm(lds, B3, WB + (size_t)W_SGLU * 1024, 1024, E, GL, TID(), ML, lb); } SEAM(10);
    if (IN(11)) { pg8::EpiOut E{HB, P, outp, 0}; run_gemm(lds, YB, WB + (size_t)W_SOUT * 1024, 1024, E, GL, TID(), ML, lb); } SEAM(11);
    if (IN(12)) { pg8::EpiConvIn E{P, B1, B2}; run_gemm(lds, HB, WB + (size_t)W_C1IN * 1024, 3072, E, GL, TID(), ML, lb); } SEAM(12);
    if (IN(13)) { conv_phase(lds, B1, B2, args.in[3] + (size_t)CONV_K * 1024, args.in[4] + 1024, args.in[5] + 1024, args.in[6] + 1024, YB, vcl, GL, TID(), ML); } SEAM(13);
    if (IN(14)) { pg8::EpiOut E{HB, P, outp, 1}; run_gemm(lds, YB, WB + (size_t)W_C1OUT * 1024, 1024, E, GL, TID(), ML, lb); }
#undef IN
#undef SEAM
}

#ifndef MK_ONE_LAUNCH
#define MK_ONE_LAUNCH 1
#endif
constexpr int N_PHASES = 15;
extern "C" void kernel_launch(void* const* d_in, const int* in_sizes, int n_in, void* d_out, int out_size, void* d_ws, size_t ws_size, hipStream_t stream) {
    static int grid = 0;
    if (grid == 0) {
        if (n_in != 25 || out_size != MTOK * DMODEL || ws_size < WS_END) { fprintf(stderr, "kernel_launch: unexpected shapes (n_in %d, out %d, ws %zu)\n", n_in, out_size, ws_size); grid = -1; return; }
        int dev = 0, cus = 0, per_cu = 0;
        if (hipGetDevice(&dev) != hipSuccess || hipDeviceGetAttribute(&cus, hipDeviceAttributeMultiprocessorCount, dev) != hipSuccess) { grid = -1; return; }
        if (hipFuncSetAttribute((const void*)mega_fwd, hipFuncAttributeMaxDynamicSharedMemorySize, LDS_BYTES) != hipSuccess) { fprintf(stderr, "kernel_launch: hipFuncSetAttribute failed\n"); grid = -1; return; }
        if (hipOccupancyMaxActiveBlocksPerMultiprocessor(&per_cu, (const void*)mega_fwd, NWAVES * 64, LDS_BYTES) != hipSuccess || per_cu < 1) { fprintf(stderr, "kernel_launch: occupancy query says %d blocks per CU\n", per_cu); grid = -1; (void)hipGetLastError(); return; }
        grid = cus;
    }
    if (grid < 0) return;
    if (hipMemsetAsync(d_ws, 0, 65536, stream) != hipSuccess) { fprintf(stderr, "kernel_launch: memset failed\n"); return; }
    Args a{};
    for (int i = 0; i < 25; ++i) a.in[i] = (const float*)d_in[i];
    a.out = (float*)d_out; a.ws = (unsigned char*)d_ws;
#if MK_ONE_LAUNCH
    a.ph_lo = 0; a.ph_hi = N_PHASES;
    void* kargs[] = {&a};
    const hipError_t e = hipLaunchCooperativeKernel((const void*)mega_fwd, dim3(grid), dim3(NWAVES * 64), kargs, LDS_BYTES, stream);
    if (e != hipSuccess) fprintf(stderr, "kernel_launch: cooperative launch failed: %s (grid %d)\n", hipGetErrorString(e), grid);
#else
    for (int p = 0; p < N_PHASES; ++p) { a.ph_lo = p; a.ph_hi = p + 1; hipLaunchKernelGGL(mega_fwd, dim3(grid), dim3(NWAVES * 64), LDS_BYTES, stream, a); }
#endif
}
```

```cpp
#include <hip/hip_runtime.h>
#include <hip/hip_cooperative_groups.h>
#include <cstdio>
#include <cstdint>
#include <cmath>
namespace cg = cooperative_groups;

constexpr int BATCH = 8, SEQ = 2048, DMODEL = 1024, MTOK = BATCH * SEQ;
constexpr int CONV_K = 31, NHEADS = 16, HDIM = 64, NGRP = 64, NST = 64, CGRP = 16;
constexpr float RMS_EPS = 1e-6f, LN_EPS = 1e-5f, LOG2E = 1.4426950408889634f;

namespace pg8 {
#define PG8_LAS __attribute__((address_space(3)))
typedef unsigned short bf16_t;
typedef short bf16x8 __attribute__((ext_vector_type(8)));
typedef float f32x4 __attribute__((ext_vector_type(4)));
typedef unsigned u32x4 __attribute__((ext_vector_type(4)));
constexpr int BM = 256, BK = 64, HALF = 128, HTB = HALF * BK * 2  , STAGE_BYTES = 8 * HTB, NXCD = 8, WGM = 4;

__host__ __device__ __forceinline__ int lds_byte(int r, int c) { const int st = (r >> 4) * 2 + (c >> 5), rr = r & 15, cc = c & 31, ob = rr * 64 + cc * 2; return st * 1024 + (ob ^ (((ob >> 9) & 1) << 5)); }
__host__ __device__ __forceinline__ void stage_rc(int b, int& R, int& C) { const int st = b / 1024, sb = b % 1024, swz = sb ^ (((sb >> 9) & 1) << 5); R = (st >> 1) * 16 + swz / 64; C = (st & 1) * 32 + (swz % 64) / 2; }
__host__ __device__ __forceinline__ int perm32(int rho) { const int n = rho >> 4, i = rho & 15; return 8 * (i >> 2) + 4 * n + (i & 3); }

struct Unit { int pm, pn; };
struct Gemm { const bf16_t* A; const bf16_t* Bt; int M, N, K; };

struct StaticOrder {
    int nM, nN, nwg, G, c;
    __host__ __device__ void init(int M, int N, int G_, int c_) { nM = M / BM; nN = N / BM; nwg = nM * nN; G = G_; c = c_; }
    __host__ __device__ bool next(int i, Unit& u) const {
        const long L = (long)i * G + c; if (L >= nwg) return false;
        int wgid = (int)L; { const int q = nwg / NXCD, r = nwg % NXCD, xcd = wgid % NXCD, off = wgid / NXCD; wgid = (xcd < r ? xcd * (q + 1) : r * (q + 1) + (xcd - r) * q) + off; }
        const int nig = WGM * nN, gid = wgid / nig, fm = gid * WGM, gsz = (nM - fm) < WGM ? (nM - fm) : WGM;
        u.pm = fm + ((wgid % nig) % gsz); u.pn = (wgid % nig) / gsz; return true;
    }
    __device__ __forceinline__ void a_ready(const Unit&) const {}
    __device__ __forceinline__ void done(const Unit&) const {}
};
__device__ __forceinline__ unsigned cvt_pk_bf16(float lo, float hi) { unsigned r; asm volatile("v_cvt_pk_bf16_f32 %0, %1, %2" : "=v"(r) : "v"(lo), "v"(hi)); return r; }
typedef float f32x2 __attribute__((ext_vector_type(2)));
typedef unsigned u32x2 __attribute__((ext_vector_type(2)));
__device__ __forceinline__ float sigm(float x) { return __builtin_amdgcn_rcpf(1.0f + __builtin_amdgcn_exp2f(-1.4426950408889634f * x)); }
__device__ __forceinline__ float silu(float x) { return x * sigm(x); }
__device__ __forceinline__ f32x4 sigm4(f32x4 x) { const f32x4 t = x * -1.4426950408889634f;
    const f32x4 d = (f32x4){__builtin_amdgcn_exp2f(t[0]), __builtin_amdgcn_exp2f(t[1]), __builtin_amdgcn_exp2f(t[2]), __builtin_amdgcn_exp2f(t[3])} + 1.0f;
    return (f32x4){__builtin_amdgcn_rcpf(d[0]), __builtin_amdgcn_rcpf(d[1]), __builtin_amdgcn_rcpf(d[2]), __builtin_amdgcn_rcpf(d[3])}; }
__device__ __forceinline__ f32x4 silu4(f32x4 x) { return x * sigm4(x); }
__device__ __forceinline__ float bflo(unsigned w) { return __uint_as_float(w << 16); }
__device__ __forceinline__ float bfhi(unsigned w) { return __uint_as_float(w & 0xffff0000u); }
__device__ __forceinline__ void row_scales(float (&sc)[2][4], const float* P, int row0, int fq) {
#pragma unroll
    for (int ai = 0; ai < 2; ++ai)
#pragma unroll
        for (int m = 0; m < 4; ++m) { const f32x4 p = *(const f32x4*)(P + (size_t)(row0 + ai * HALF + m * 16) * 16 + 4 * fq);
            float s = (p[0] + p[1]) + (p[2] + p[3]); s += __shfl_xor(s, 16); s += __shfl_xor(s, 32);
            sc[ai][m] = rsqrtf(s * (1.0f / 1024.0f) + 1e-6f); }
}
struct RowScaleState { PG8_LAS float* sl; int pm; };
struct EpiConvIn {
    static constexpr bool PERM = true, AFTER_DRAIN = false;
    const float* P; bf16_t* U; bf16_t* SG;
    __device__ __forceinline__ void operator()(const f32x4 (&acc)[2][2][4][2], const Unit& u, int wr, int wc, int fr, int fq, RowScaleState& st) const {
        const int row0 = u.pm * BM + wr * 64 + fr; float sc[2][4];
        {
            PG8_LAS f32x4* sl = (PG8_LAS f32x4*)(st.sl + ((wr * 64 + fq * 16 + fr) * 8));
            if (u.pm != st.pm) { row_scales(sc, P, row0, fq); st.pm = u.pm;
                if (wc == 0) { sl[0] = (f32x4){sc[0][0], sc[0][1], sc[0][2], sc[0][3]}; sl[1] = (f32x4){sc[1][0], sc[1][1], sc[1][2], sc[1][3]}; } }
            else { const f32x4 s0 = sl[0], s1 = sl[1];
#pragma unroll
                for (int m = 0; m < 4; ++m) { sc[0][m] = s0[m]; sc[1][m] = s1[m]; } }
        }
        if (u.pn < 8) {
            bf16_t* base = U + u.pn * 128 + wc * 32 + 8 * fq;
#pragma unroll
            for (int ai = 0; ai < 2; ++ai)
#pragma unroll
                for (int m = 0; m < 4; ++m) { const float s = sc[ai][m];
                    const f32x4 a0 = acc[ai][0][m][0] * s, a1 = acc[ai][0][m][1] * s, b0 = acc[ai][1][m][0] * s, b1 = acc[ai][1][m][1] * s; u32x4 w;
                    const f32x4 y0 = a0 * sigm4(b0), y1 = a1 * sigm4(b1);
                    w.x = cvt_pk_bf16(y0[0], y0[1]); w.y = cvt_pk_bf16(y0[2], y0[3]); w.z = cvt_pk_bf16(y1[0], y1[1]); w.w = cvt_pk_bf16(y1[2], y1[3]);
                    *(u32x4*)(base + (size_t)(row0 + ai * HALF + m * 16) * 1024) = w; }
        } else {
            bf16_t* base = SG + (u.pn - 8) * 256 + wc * 32 + 8 * fq;
#pragma unroll
            for (int ai = 0; ai < 2; ++ai)
#pragma unroll
                for (int m = 0; m < 4; ++m) { const float s = sc[ai][m];
#pragma unroll
                    for (int bj = 0; bj < 2; ++bj) { const f32x4 v0 = silu4(acc[ai][bj][m][0] * s), v1 = silu4(acc[ai][bj][m][1] * s); u32x4 w;
                        w.x = cvt_pk_bf16(v0[0], v0[1]); w.y = cvt_pk_bf16(v0[2], v0[3]); w.z = cvt_pk_bf16(v1[0], v1[1]); w.w = cvt_pk_bf16(v1[2], v1[3]);
                        *(u32x4*)(base + (size_t)(row0 + ai * HALF + m * 16) * 1024 + bj * HALF) = w; } }
        }
    }
};
struct EpiFoxIn {
    static constexpr bool PERM = true, AFTER_DRAIN = false;
    const float* P; bf16_t* Q; bf16_t* K; bf16_t* V; bf16_t* SG; const float* qg; const float* kg;
    __device__ __forceinline__ void operator()(const f32x4 (&acc)[2][2][4][2], const Unit& u, int wr, int wc, int fr, int fq, RowScaleState& st) const {
        const int row0 = u.pm * BM + wr * 64 + fr; float sc[2][4];
        {
            PG8_LAS f32x4* sl = (PG8_LAS f32x4*)(st.sl + ((wr * 64 + fq * 16 + fr) * 8));
            if (u.pm != st.pm) { row_scales(sc, P, row0, fq); st.pm = u.pm;
                if (wc == 0) { sl[0] = (f32x4){sc[0][0], sc[0][1], sc[0][2], sc[0][3]}; sl[1] = (f32x4){sc[1][0], sc[1][1], sc[1][2], sc[1][3]}; } }
            else { const f32x4 s0 = sl[0], s1 = sl[1];
#pragma unroll
                for (int m = 0; m < 4; ++m) { sc[0][m] = s0[m]; sc[1][m] = s1[m]; } }
        }
        const int sec = u.pn >> 2, colb = (4 * (u.pn & 3) + wc) * 64 + 8 * fq;
        if (sec < 2) {
            const float* g = sec == 0 ? qg : kg; bf16_t* dst = (sec == 0 ? Q : K) + colb; const float post = sec == 0 ? 0.125f * 1.4426950408889634f : 1.0f;
            f32x4 gv[2][2];
#pragma unroll
            for (int bj = 0; bj < 2; ++bj)
#pragma unroll
                for (int n = 0; n < 2; ++n) gv[bj][n] = *(const f32x4*)(g + 32 * bj + 8 * fq + 4 * n);
#pragma unroll
            for (int ai = 0; ai < 2; ++ai)
#pragma unroll
                for (int m = 0; m < 4; ++m) { const float s = sc[ai][m]; f32x4 x[2][2]; float ss = 0.f;
#pragma unroll
                    for (int bj = 0; bj < 2; ++bj)
#pragma unroll
                        for (int n = 0; n < 2; ++n) { x[bj][n] = acc[ai][bj][m][n] * s; ss += (x[bj][n][0] * x[bj][n][0] + x[bj][n][1] * x[bj][n][1]) + (x[bj][n][2] * x[bj][n][2] + x[bj][n][3] * x[bj][n][3]); }
                    ss += __shfl_xor(ss, 16); ss += __shfl_xor(ss, 32);
                    const float r = rsqrtf(ss * (1.0f / 64.0f) + 1e-6f) * post;
#pragma unroll
                    for (int bj = 0; bj < 2; ++bj) { const f32x4 y0 = x[bj][0] * gv[bj][0] * r, y1 = x[bj][1] * gv[bj][1] * r; u32x4 w;
                        w.x = cvt_pk_bf16(y0[0], y0[1]); w.y = cvt_pk_bf16(y0[2], y0[3]); w.z = cvt_pk_bf16(y1[0], y1[1]); w.w = cvt_pk_bf16(y1[2], y1[3]);
                        *(u32x4*)(dst + (size_t)(row0 + ai * HALF + m * 16) * 1024 + 32 * bj) = w; } }
        } else {
            bf16_t* dst = (sec == 2 ? V : SG) + colb;
#pragma unroll
            for (int ai = 0; ai < 2; ++ai)
#pragma unroll
                for (int m = 0; m < 4; ++m) { const float s = sc[ai][m];
#pragma unroll
                    for (int bj = 0; bj < 2; ++bj) { f32x4 v0 = acc[ai][bj][m][0] * s, v1 = acc[ai][bj][m][1] * s;
                        if (sec == 3) { v0 = silu4(v0); v1 = silu4(v1); }
                        u32x4 w; w.x = cvt_pk_bf16(v0[0], v0[1]); w.y = cvt_pk_bf16(v0[2], v0[3]); w.z = cvt_pk_bf16(v1[0], v1[1]); w.w = cvt_pk_bf16(v1[2], v1[3]);
                        *(u32x4*)(dst + (size_t)(row0 + ai * HALF + m * 16) * 1024 + 32 * bj) = w; } }
        }
    }
};
struct EpiSsmIn {
    static constexpr bool PERM = true, AFTER_DRAIN = false;
    const float* P; bf16_t* U; bf16_t* SG;
    __device__ __forceinline__ void operator()(const f32x4 (&acc)[2][2][4][2], const Unit& u, int wr, int wc, int fr, int fq, RowScaleState& st) const {
        const int row0 = u.pm * BM + wr * 64 + fr; float sc[2][4];
        {
            PG8_LAS f32x4* sl = (PG8_LAS f32x4*)(st.sl + ((wr * 64 + fq * 16 + fr) * 8));
            if (u.pm != st.pm) { row_scales(sc, P, row0, fq); st.pm = u.pm;
                if (wc == 0) { sl[0] = (f32x4){sc[0][0], sc[0][1], sc[0][2], sc[0][3]}; sl[1] = (f32x4){sc[1][0], sc[1][1], sc[1][2], sc[1][3]}; } }
            else { const f32x4 s0 = sl[0], s1 = sl[1];
#pragma unroll
                for (int m = 0; m < 4; ++m) { sc[0][m] = s0[m]; sc[1][m] = s1[m]; } }
        }
        const bool gate = u.pn >= 4; bf16_t* dst = (gate ? SG : U) + (u.pn & 3) * 256 + wc * 32 + 8 * fq;
#pragma unroll
        for (int ai = 0; ai < 2; ++ai)
#pragma unroll
            for (int m = 0; m < 4; ++m) { const float s = sc[ai][m];
#pragma unroll
                for (int bj = 0; bj < 2; ++bj) { f32x4 v0 = acc[ai][bj][m][0] * s, v1 = acc[ai][bj][m][1] * s;
                    if (gate) { v0 = silu4(v0); v1 = silu4(v1); }
                    u32x4 w; w.x = cvt_pk_bf16(v0[0], v0[1]); w.y = cvt_pk_bf16(v0[2], v0[3]); w.z = cvt_pk_bf16(v1[0], v1[1]); w.w = cvt_pk_bf16(v1[2], v1[3]);
                    *(u32x4*)(dst + (size_t)(row0 + ai * HALF + m * 16) * 1024 + bj * HALF) = w; } }
    }
};
struct EpiOut {
    static constexpr bool PERM = true, AFTER_DRAIN = false;
    bf16_t* hb; float* P; float* out; int last;
    __device__ __forceinline__ void operator()(const f32x4 (&acc)[2][2][4][2], const Unit& u, int wr, int wc, int fr, int fq, RowScaleState& st) const {
        const int row0 = u.pm * BM + wr * 64 + fr, col0 = u.pn * BM + wc * 32 + 8 * fq;
#pragma unroll
        for (int ai = 0; ai < 2; ++ai)
#pragma unroll
            for (int m = 0; m < 4; ++m) { const int row = row0 + ai * HALF + m * 16; float ss = 0.f;
#pragma unroll
                for (int bj = 0; bj < 2; ++bj) { const size_t off = (size_t)row * 1024 + col0 + bj * HALF;
                    const u32x4 r = *(const u32x4*)(hb + off);
                    const f32x4 h0 = (f32x4){bflo(r.x), bfhi(r.x), bflo(r.y), bfhi(r.y)} + acc[ai][bj][m][0], h1 = (f32x4){bflo(r.z), bfhi(r.z), bflo(r.w), bfhi(r.w)} + acc[ai][bj][m][1];
                    if (last) { __builtin_nontemporal_store(h0, (f32x4*)(out + off)); __builtin_nontemporal_store(h1, (f32x4*)(out + off + 4)); }
                    else { ss += ((h0[0] * h0[0] + h0[1] * h0[1]) + (h0[2] * h0[2] + h0[3] * h0[3])) + ((h1[0] * h1[0] + h1[1] * h1[1]) + (h1[2] * h1[2] + h1[3] * h1[3]));
                        u32x4 w; w.x = cvt_pk_bf16(h0[0], h0[1]); w.y = cvt_pk_bf16(h0[2], h0[3]); w.z = cvt_pk_bf16(h1[0], h1[1]); w.w = cvt_pk_bf16(h1[2], h1[3]); *(u32x4*)(hb + off) = w; } }
                if (!last) { ss += __shfl_xor(ss, 16); ss += __shfl_xor(ss, 32); if (fq == 0) P[(size_t)row * 16 + 4 * u.pn + wc] = ss; } }
    }
};
struct EpiGlu {
    static constexpr bool PERM = true, AFTER_DRAIN = false;
    const bf16_t* G; const bf16_t* SG; const float* bias; bf16_t* Y;
    __device__ __forceinline__ void operator()(const f32x4 (&acc)[2][2][4][2], const Unit& u, int wr, int wc, int fr, int fq, RowScaleState& st) const {
        const int row0 = u.pm * BM + wr * 64 + fr, col0 = u.pn * BM + wc * 32 + 8 * fq;
        f32x4 bv[2][2];
#pragma unroll
        for (int bj = 0; bj < 2; ++bj)
#pragma unroll
            for (int n = 0; n < 2; ++n) bv[bj][n] = *(const f32x4*)(bias + col0 + bj * HALF + 4 * n);
#pragma unroll
        for (int ai = 0; ai < 2; ++ai)
#pragma unroll
            for (int m = 0; m < 4; ++m)
#pragma unroll
                for (int bj = 0; bj < 2; ++bj) { const size_t off = (size_t)(row0 + ai * HALF + m * 16) * 1024 + col0 + bj * HALF;
                    const u32x4 gq = *(const u32x4*)(G + off), sq = *(const u32x4*)(SG + off);
                    const f32x4 t0 = acc[ai][bj][m][0] + bv[bj][0], t1 = acc[ai][bj][m][1] + bv[bj][1]; u32x4 w;
                    const f32x4 g0 = (f32x4){bflo(gq.x), bfhi(gq.x), bflo(gq.y), bfhi(gq.y)}, g1 = (f32x4){bflo(gq.z), bfhi(gq.z), bflo(gq.w), bfhi(gq.w)};
                    const f32x4 s0 = (f32x4){bflo(sq.x), bfhi(sq.x), bflo(sq.y), bfhi(sq.y)}, s1 = (f32x4){bflo(sq.z), bfhi(sq.z), bflo(sq.w), bfhi(sq.w)};
                    const f32x4 y0 = g0 * sigm4(t0) * s0, y1 = g1 * sigm4(t1) * s1;
                    w.x = cvt_pk_bf16(y0[0], y0[1]); w.y = cvt_pk_bf16(y0[2], y0[3]); w.z = cvt_pk_bf16(y1[0], y1[1]); w.w = cvt_pk_bf16(y1[2], y1[3]);
                    *(u32x4*)(Y + off) = w; }
    }
};

template <bool PERM> __device__ __forceinline__ void gemm_prefetch_b(PG8_LAS unsigned char* lds, const bf16_t* Bt, int M, int N, int K, int G, int c, const int tid) {
    StaticOrder S; S.init(M, N, G, c); Unit u; if (!S.next(0, u)) return;
    const int wid = __builtin_amdgcn_readfirstlane(tid >> 6), lane = tid & 63;
    const size_t hstep = (size_t)HALF * K * 2;
    const char* cB = (const char*)Bt + (size_t)u.pn * 2 * hstep;
#pragma unroll
    for (int e = 0; e < 2; ++e) {
        if (e == 1 && wid != 1) break;
        const int w = e ? 0 : wid, t = w * 64 + lane;
#pragma unroll
        for (int h = 0; h < 2; ++h)
#pragma unroll
            for (int i = 0; i < 2; ++i) { int R, C; stage_rc(t * 16 + i * 8192, R, C); const int Rb = PERM ? ((R & ~31) + perm32(R & 31)) : R;
                __builtin_amdgcn_global_load_lds((const unsigned*)(cB + h * hstep + (size_t)(unsigned)(Rb * K + C) * 2u), (PG8_LAS unsigned*)(lds + (4 + h) * HTB + w * 1024 + i * 8192), 16, 0, 0); }
    }
}
template <class Epi, class Sched, bool ALIGN_EPI = false, bool SP2 = false>
__device__ __forceinline__ void gemm_phase(PG8_LAS unsigned char* lds, const Gemm g, const Sched& S, const Epi& E, const int tid, const bool bpre = false) {
    const int wid = __builtin_amdgcn_readfirstlane(tid >> 6), lane = tid & 63, wr = wid >> 2, wc = wid & 3, fr = lane & 15, fq = lane >> 4;
    const int K = g.K, nt = K / BK;
    unsigned voffA[2], voffB[2];
#pragma unroll
    for (int i = 0; i < 2; ++i) { int R, C; stage_rc(tid * 16 + i * 8192, R, C); const int Rb = Epi::PERM ? ((R & ~31) + perm32(R & 31)) : R;
        voffA[i] = (unsigned)(R * K + C) * 2u; voffB[i] = (unsigned)(Rb * K + C) * 2u; }
    const size_t kstep = (size_t)(BK * 2);
    const size_t hstep = (size_t)HALF * K * 2;
    const size_t tstep = 2 * hstep;
    const unsigned ldsw = (unsigned)wid * 1024u;
    const int aoff = lds_byte(wr * 64 + fr, fq * 8), boff = lds_byte(wc * 32 + fr, fq * 8);
#define PG8_SA(b, h) (((b) * 2 + (h)) * HTB)
#define PG8_SB(b, h) ((4 + (b) * 2 + (h)) * HTB)
#define PG8_STAGE(bufoff, gbase, voff) do { _Pragma("unroll") for (int _i = 0; _i < 2; ++_i) \
        __builtin_amdgcn_global_load_lds((const unsigned*)((const char*)(gbase) + (voff)[_i]), (PG8_LAS unsigned*)(lds + (bufoff) + ldsw + _i * 8192), 16, 0, 0); } while (0)
#define PG8_LDA(dst, b, h) do { _Pragma("unroll") for (int m = 0; m < 4; ++m) _Pragma("unroll") for (int k = 0; k < 2; ++k) dst[m][k] = *(const PG8_LAS bf16x8*)(lds + PG8_SA(b, h) + aoff + m * 2048 + k * 1024); } while (0)
#define PG8_LDB(dst, b, h) do { _Pragma("unroll") for (int n = 0; n < 2; ++n) _Pragma("unroll") for (int k = 0; k < 2; ++k) dst[n][k] = *(const PG8_LAS bf16x8*)(lds + PG8_SB(b, h) + boff + n * 2048 + k * 1024); } while (0)
#define PG8_MMA(ai, bj, At, Bt) do { __builtin_amdgcn_s_setprio(1); _Pragma("unroll") for (int m = 0; m < 4; ++m) _Pragma("unroll") for (int n = 0; n < 2; ++n) _Pragma("unroll") for (int k = 0; k < 2; ++k) \
        acc[ai][bj][m][n] = __builtin_amdgcn_mfma_f32_16x16x32_bf16(Bt[n][k], At[m][k], acc[ai][bj][m][n], 0, 0, 0); __builtin_amdgcn_s_setprio(0); } while (0)
#define PG8_WAIT_V(n) asm volatile("s_waitcnt vmcnt(" #n ")" ::: "memory")
#define PG8_WAIT_L(n) asm volatile("s_waitcnt lgkmcnt(" #n ")" ::: "memory")
#define PG8_BAR __builtin_amdgcn_s_barrier()
#define PG8_SCHED __builtin_amdgcn_sched_barrier(0)
    Unit cur, nxt; int ui = 0; RowScaleState rss; rss.sl = (PG8_LAS float*)(lds + STAGE_BYTES); rss.pm = -1;
    if (!S.next(0, cur)) return;
    f32x4 acc[2][2][4][2];
#pragma unroll
    for (int a = 0; a < 2; ++a)
#pragma unroll
        for (int b = 0; b < 2; ++b)
#pragma unroll
            for (int m = 0; m < 4; ++m)
#pragma unroll
                for (int n = 0; n < 2; ++n) acc[a][b][m][n] = (f32x4){0.f, 0.f, 0.f, 0.f};
    bf16x8 At[4][2], B0[2][2], B1[2][2];
    const char* cA = (const char*)g.A + (size_t)cur.pm * tstep; const char* cB = (const char*)g.Bt + (size_t)cur.pn * tstep;
    S.a_ready(cur);
    if constexpr (SP2) {
        if (!bpre) { PG8_STAGE(PG8_SB(0, 0), cB, voffB); PG8_STAGE(PG8_SB(0, 1), cB + hstep, voffB); }
        PG8_STAGE(PG8_SA(0, 0), cA, voffA); PG8_STAGE(PG8_SA(0, 1), cA + hstep, voffA);
        if (wr == 1) PG8_BAR;
        PG8_WAIT_V(2); PG8_BAR;
        PG8_STAGE(PG8_SB(1, 0), cB + kstep, voffB); PG8_STAGE(PG8_SA(1, 0), cA + kstep, voffA); PG8_STAGE(PG8_SB(1, 1), cB + hstep + kstep, voffB);
        PG8_WAIT_V(6); PG8_BAR;
    } else {
        PG8_STAGE(PG8_SB(0, 0), cB, voffB); PG8_STAGE(PG8_SA(0, 0), cA, voffA); PG8_STAGE(PG8_SB(0, 1), cB + hstep, voffB); PG8_STAGE(PG8_SA(0, 1), cA + hstep, voffA);
        if (wr == 1) PG8_BAR;
        PG8_WAIT_V(4); PG8_BAR;
        PG8_STAGE(PG8_SB(1, 0), cB + kstep, voffB); PG8_STAGE(PG8_SA(1, 0), cA + kstep, voffA); PG8_STAGE(PG8_SB(1, 1), cB + hstep + kstep, voffB);
        PG8_WAIT_V(6); PG8_BAR;
    }
    for (;;) {
        const bool has_next = S.next(ui + 1, nxt);
        const char* nA = has_next ? (const char*)g.A + (size_t)nxt.pm * tstep : cA; const char* nB = has_next ? (const char*)g.Bt + (size_t)nxt.pn * tstep : cB;
        for (int t = 0; t < nt; t += 2) {
            const bool last = (t == nt - 2);
            const char* a1 = cA + (size_t)(t + 1) * kstep;
            const char* a2 = last ? nA : cA + (size_t)(t + 2) * kstep; const char* b2 = last ? nB : cB + (size_t)(t + 2) * kstep;
            const char* a3 = a2 + kstep; const char* b3 = b2 + kstep;
            if (last && has_next) S.a_ready(nxt);
            if constexpr (SP2) {
            PG8_LDB(B0, 0, 0); PG8_LDB(B1, 0, 1); PG8_SCHED; PG8_LDA(At, 0, 0); PG8_STAGE(PG8_SA(1, 1), a1 + hstep, voffA);
            PG8_WAIT_V(8); PG8_WAIT_L(0); PG8_BAR; PG8_MMA(0, 0, At, B0); PG8_MMA(0, 1, At, B1); PG8_BAR; PG8_SCHED;
            PG8_LDA(At, 0, 1); PG8_STAGE(PG8_SB(0, 0), b2, voffB); PG8_STAGE(PG8_SB(0, 1), b2 + hstep, voffB); PG8_STAGE(PG8_SA(0, 0), a2, voffA);
            PG8_WAIT_V(8); PG8_WAIT_L(0); PG8_BAR; PG8_MMA(1, 0, At, B0); PG8_MMA(1, 1, At, B1); PG8_BAR; PG8_SCHED;
            PG8_LDB(B0, 1, 0); PG8_LDB(B1, 1, 1); PG8_SCHED; PG8_LDA(At, 1, 0); PG8_STAGE(PG8_SA(0, 1), a2 + hstep, voffA);
            PG8_WAIT_V(8); PG8_WAIT_L(0); PG8_BAR; PG8_MMA(0, 0, At, B0); PG8_MMA(0, 1, At, B1); PG8_BAR; PG8_SCHED;
            PG8_LDA(At, 1, 1); PG8_STAGE(PG8_SB(1, 0), b3, voffB); PG8_STAGE(PG8_SB(1, 1), b3 + hstep, voffB); PG8_STAGE(PG8_SA(1, 0), a3, voffA);
            PG8_WAIT_V(8); PG8_WAIT_L(0); PG8_BAR; PG8_MMA(1, 0, At, B0); PG8_MMA(1, 1, At, B1); PG8_BAR; PG8_SCHED;
            } else {
            PG8_LDB(B0, 0, 0); PG8_SCHED; PG8_LDA(At, 0, 0); PG8_STAGE(PG8_SA(1, 1), a1 + hstep, voffA);
            PG8_WAIT_L(8); PG8_BAR; PG8_WAIT_L(0); PG8_MMA(0, 0, At, B0); PG8_BAR; PG8_SCHED;
            PG8_LDB(B1, 0, 1); PG8_STAGE(PG8_SB(0, 0), b2, voffB);
            PG8_BAR; PG8_WAIT_L(0); PG8_MMA(0, 1, At, B1); PG8_BAR;
            PG8_LDA(At, 0, 1); PG8_STAGE(PG8_SA(0, 0), a2, voffA);
            PG8_BAR; PG8_WAIT_L(0); PG8_MMA(1, 0, At, B0); PG8_BAR; PG8_SCHED;
            PG8_STAGE(PG8_SB(0, 1), b2 + hstep, voffB);
            PG8_WAIT_V(6); PG8_BAR; PG8_MMA(1, 1, At, B1); PG8_BAR;
            PG8_LDB(B0, 1, 0); PG8_SCHED; PG8_LDA(At, 1, 0); PG8_STAGE(PG8_SA(0, 1), a2 + hstep, voffA);
            PG8_WAIT_L(8); PG8_BAR; PG8_WAIT_L(0); PG8_MMA(0, 0, At, B0); PG8_BAR; PG8_SCHED;
            PG8_LDB(B1, 1, 1); PG8_STAGE(PG8_SB(1, 0), b3, voffB);
            PG8_BAR; PG8_WAIT_L(0); PG8_MMA(0, 1, At, B1); PG8_BAR;
            PG8_LDA(At, 1, 1); PG8_STAGE(PG8_SA(1, 0), a3, voffA);
            PG8_BAR; PG8_WAIT_L(0); PG8_MMA(1, 0, At, B0); PG8_BAR; PG8_SCHED;
            PG8_STAGE(PG8_SB(1, 1), b3 + hstep, voffB);
            PG8_WAIT_V(6); PG8_BAR; PG8_MMA(1, 1, At, B1); PG8_BAR;
            }
        }
        if constexpr (ALIGN_EPI) { if (wr == 0) PG8_BAR; }
        if constexpr (!Epi::AFTER_DRAIN) { E(acc, cur, wr, wc, fr, fq, rss); S.done(cur); }
        if (!has_next) break;
#pragma unroll
        for (int a = 0; a < 2; ++a)
#pragma unroll
            for (int b = 0; b < 2; ++b)
#pragma unroll
                for (int m = 0; m < 4; ++m)
#pragma unroll
                    for (int n = 0; n < 2; ++n) acc[a][b][m][n] = (f32x4){0.f, 0.f, 0.f, 0.f};
        cur = nxt; cA = nA; cB = nB; ++ui;
        if constexpr (ALIGN_EPI) { if (wr == 1) PG8_BAR; }
    }
    PG8_WAIT_V(0);
    if constexpr (!ALIGN_EPI) { if (wr == 0) PG8_BAR; }
    PG8_BAR;
    if constexpr (Epi::AFTER_DRAIN) { E.fused(acc, cur, wr, wc, fr, fq, lds, wid, lane); S.done(cur); }
#undef PG8_SA
#undef PG8_SB
#undef PG8_STAGE
#undef PG8_LDA
#undef PG8_LDB
#undef PG8_MMA
#undef PG8_WAIT_V
#undef PG8_WAIT_L
#undef PG8_BAR
#undef PG8_SCHED
}
}
#include <hip/hip_bf16.h>
#include <cmath>
namespace attn_body {
using bf16=__hip_bfloat16;
using bf16x8=__attribute__((ext_vector_type(8)))short;
using s16x4=__attribute__((ext_vector_type(4)))short;
using f32x16=__attribute__((ext_vector_type(16)))float;
using u32x4=__attribute__((ext_vector_type(4)))unsigned;
constexpr int BATCH=8,NHEAD=16,SEQ=2048,D=64,DM=NHEAD*D;
constexpr int NW=8,QBLK=32,QB=QBLK*NW,KVBLK=64,NQB=SEQ/QB;
constexpr int ATTN_PITCH=DM, ATTN_UNIT_ROWS=QB;
__device__ __forceinline__ int crow(int r,int hi){return (r&3)+8*(r>>2)+4*hi;}
#define SBAR() __builtin_amdgcn_sched_barrier(0)
__device__ __forceinline__ void cmask(f32x16&p0,f32x16&p1,int jb,int qrel,int hi){
  const float NEG=-INFINITY; int kb=64*jb+4*hi;
  #pragma unroll
  for(int r=0;r<16;++r){int kv=kb+(r&3)+8*(r>>2); if(kv>qrel)p0[r]=NEG; if(kv+32>qrel)p1[r]=NEG;}
}

constexpr int NSLOT=3, SLOTB=8192;
constexpr int LDS_K=0, LDS_V=NSLOT*SLOTB, LDS_WS=2*NSLOT*SLOTB, LDS_OST=LDS_WS+NW*64*4, LDS_CK=LDS_OST+NW*4096, LDS_BYTES=LDS_CK+SEQ*8;
constexpr float C2=0.125f*1.4426950408889634f;
__device__ __forceinline__ void glds16(const void*gsrc,unsigned lds_dst){unsigned keep;
  asm volatile("s_mov_b32 %0, m0\n\ts_mov_b32 m0, %2\n\ts_nop 0\n\tglobal_load_lds_dwordx4 %1, off\n\ts_mov_b32 m0, %0":"=&s"(keep):"v"(gsrc),"s"(lds_dst):"memory");}
__device__ __forceinline__ float max3f(float a,float b,float c){float r;asm("v_max3_f32 %0, %1, %2, %3":"=v"(r):"v"(a),"v"(b),"v"(c));return r;}
__device__ __forceinline__ float max2f(float a,float b){float r;asm("v_max_f32_e32 %0, %1, %2":"=v"(r):"v"(a),"v"(b));return r;}
__device__ __forceinline__ float fadd_s(float a,float b){float r;asm("v_add_f32_e32 %0, %1, %2":"=v"(r):"v"(a),"v"(b));return r;}
__device__ __forceinline__ float fsub_s(float a,float b){float r;asm("v_sub_f32_e32 %0, %1, %2":"=v"(r):"v"(a),"v"(b));return r;}
typedef float f32x2_t __attribute__((ext_vector_type(2))); typedef __bf16 bf16x2_t __attribute__((ext_vector_type(2)));
__device__ __forceinline__ unsigned cvtpk_s(float lo,float hi){f32x2_t v={lo,hi};bf16x2_t b=__builtin_convertvector(v,bf16x2_t);return __builtin_bit_cast(unsigned,b);}
#define WAIT_BAR(N) asm volatile("s_waitcnt vmcnt(" #N ") lgkmcnt(0)\n\ts_barrier":::"memory")

__device__ __forceinline__ void qkt(f32x16&p0,f32x16&p1,const char*Kslot,const bf16x8*qr,int r32,int hi){
  const char*kb=Kslot+hi*1024+r32*16;
  #pragma unroll
  for(int d0=0;d0<4;++d0){
    const bf16x8 b0=*reinterpret_cast<const bf16x8*>(kb+d0*2048);
    const bf16x8 b1=*reinterpret_cast<const bf16x8*>(kb+d0*2048+512);
    p0=__builtin_amdgcn_mfma_f32_32x32x16_bf16(b0,qr[d0],p0,0,0,0);p1=__builtin_amdgcn_mfma_f32_32x32x16_bf16(b1,qr[d0],p1,0,0,0);}
}
typedef __attribute__((address_space(3))) const char* lds_cptr;
typedef short v4i16_t __attribute__((ext_vector_type(4)));
__device__ __forceinline__ void kload8(bf16x8*kf,lds_cptr kp){
  kf[0]=*(const __attribute__((address_space(3))) bf16x8*)(kp);      kf[1]=*(const __attribute__((address_space(3))) bf16x8*)(kp+512);
  kf[2]=*(const __attribute__((address_space(3))) bf16x8*)(kp+2048); kf[3]=*(const __attribute__((address_space(3))) bf16x8*)(kp+2560);
  kf[4]=*(const __attribute__((address_space(3))) bf16x8*)(kp+4096); kf[5]=*(const __attribute__((address_space(3))) bf16x8*)(kp+4608);
  kf[6]=*(const __attribute__((address_space(3))) bf16x8*)(kp+6144); kf[7]=*(const __attribute__((address_space(3))) bf16x8*)(kp+6656);
}
__device__ __forceinline__ void kload2(bf16x8*kf,lds_cptr kp,int j){ kf[2*j]=*(const __attribute__((address_space(3))) bf16x8*)(kp+j*2048); kf[2*j+1]=*(const __attribute__((address_space(3))) bf16x8*)(kp+j*2048+512); }
__device__ __forceinline__ s16x4 vtr(lds_cptr p){ return __builtin_bit_cast(s16x4,__builtin_amdgcn_ds_read_tr16_b64_v4i16((__attribute__((address_space(3))) v4i16_t*)p)); }
__device__ __forceinline__ float rowmax(const f32x16&p0,const f32x16&p1){
  float a=max3f(p0[0],p0[1],p1[0]),b=max3f(p0[2],p0[3],p1[1]);a=max3f(a,p1[2],p1[3]);
  #pragma unroll
  for(int r=4;r<16;r+=4){a=max3f(a,p0[r],p0[r+1]);b=max3f(b,p0[r+2],p0[r+3]);a=max3f(a,p1[r],p1[r+1]);b=max3f(b,p1[r+2],p1[r+3]);}
  const float m=max2f(a,b);
  auto rr=__builtin_amdgcn_permlane32_swap(__float_as_uint(m),__float_as_uint(m),false,false);
  return max2f(__uint_as_float(rr[0]),__uint_as_float(rr[1]));
}
__device__ __forceinline__ void pv(f32x16*o,int vb,bf16x8 pa0,bf16x8 pa1,bf16x8 pa2,bf16x8 pa3){
  #pragma unroll
  for(int d0=0;d0<2;++d0){s16x4 lo[4],hi[4];
    #pragma unroll
    for(int ks=0;ks<4;++ks){
      asm volatile("ds_read_b64_tr_b16 %0,%1 offset:%c2":"=&v"(lo[ks]):"v"(vb),"i"(d0*4096+ks*1024):"memory");
      asm volatile("ds_read_b64_tr_b16 %0,%1 offset:%c2":"=&v"(hi[ks]):"v"(vb),"i"(d0*4096+ks*1024+512):"memory");}
    asm volatile("s_waitcnt lgkmcnt(0)":::"memory");SBAR();
    #define PK(k) (bf16x8){lo[k][0],lo[k][1],lo[k][2],lo[k][3],hi[k][0],hi[k][1],hi[k][2],hi[k][3]}
    o[d0]=__builtin_amdgcn_mfma_f32_32x32x16_bf16(pa0,PK(0),o[d0],0,0,0);
    o[d0]=__builtin_amdgcn_mfma_f32_32x32x16_bf16(pa1,PK(1),o[d0],0,0,0);
    o[d0]=__builtin_amdgcn_mfma_f32_32x32x16_bf16(pa2,PK(2),o[d0],0,0,0);
    o[d0]=__builtin_amdgcn_mfma_f32_32x32x16_bf16(pa3,PK(3),o[d0],0,0,0);
    #undef PK
  }
}

typedef __attribute__((address_space(3))) const float* lds_fptr;
typedef float f32x4_t __attribute__((ext_vector_type(4)));
typedef unsigned u32x2_t __attribute__((ext_vector_type(2)));
__device__ __forceinline__ unsigned bfr(float f){ const unsigned u=__float_as_uint(f); return (u+0x7fffu+((u>>16)&1u))>>16; }
__device__ __forceinline__ void split3(float v,unsigned&h,unsigned&m,unsigned&l){ h=bfr(v); const float r=v-__uint_as_float(h<<16); m=bfr(r); const float r2=r-__uint_as_float(m<<16); l=bfr(r2); }
__device__ __forceinline__ bf16x8 kxfrag(lds_cptr p){ const u32x2_t w=*(const __attribute__((address_space(3))) u32x2_t*)p; const u32x4 f={w[0],w[1],0xBF80BF80u,0u}; return __builtin_bit_cast(bf16x8,f); }
__device__ __forceinline__ bf16x8 mkqx(float mh,int hi){ unsigned h,m,l; split3(mh,h,m,l); u32x4 f={0x3F803F80u,0x3F80u|(h<<16),m|(l<<16),0u}; if(hi)f=u32x4{0u,0u,0u,0u}; return __builtin_bit_cast(bf16x8,f); }
#ifndef ATTN_STORE16
#define ATTN_STORE16(p,v) (*(u32x4*)(p)=(v))
#endif
template<int THRL> __device__ __forceinline__ void attn_unit(int b,int h,int qb,const bf16*Q,const bf16*__restrict__ K,const bf16*__restrict__ V,const bf16*__restrict__ SG,bf16*O,char*shm,const int tid_in,const bool pre,const bool nxt,const float bref){
  int tid=tid_in; asm volatile("":"+v"(tid));
  const int lane=tid&63,r32=lane&31,hi=lane>>5; const int wid=__builtin_amdgcn_readfirstlane(tid>>6);
  const long rowbase=(long)b*SEQ; const int q0=qb*QB;
  const bf16*Qw=Q+(rowbase+q0+wid*QBLK)*DM+h*D;
  const bf16*Kh=K+rowbase*DM+h*D,*Vh=V+rowbase*DM+h*D;
  const unsigned lds0=(unsigned)(uintptr_t)shm;
  float*wsf=(float*)(shm+LDS_WS)+wid*64;
  const bf16*ksrc=Kh+(long)lane*DM+wid*8;
  const bf16*vsrc=Vh+(long)(16*(wid&3)+(lane>>2))*DM+(wid>>2)*32+(lane&3)*8;
  const unsigned kdst=lds0+LDS_K+wid*1024, vdst=lds0+LDS_V+wid*1024;
  #define DMA_K(t,slot) glds16(ksrc+(long)(t)*KVBLK*DM,(unsigned)__builtin_amdgcn_readfirstlane(kdst+(slot)))
  #define DMA_V(t,slot) glds16(vsrc+(long)(t)*KVBLK*DM,(unsigned)__builtin_amdgcn_readfirstlane(vdst+(slot)))
  const int vb0=(int)(lds0+LDS_V)+((lane>>4)&1)*32+(lane&3)*8+(4*hi+((lane&15)>>2))*64;
  const char*Kbase=shm+LDS_K; bf16x8 kf[8];
  const lds_cptr shm3=(lds_cptr)shm; const lds_cptr kxp=shm3+LDS_CK+r32*8; const lds_cptr kp0=shm3+LDS_K+hi*1024+r32*16; const lds_cptr vp0=shm3+LDS_V+((lane>>4)&1)*32+(lane&3)*8+(4*hi+((lane&15)>>2))*64;
  const int NT=(q0+QB)/KVBLK;
  if(!pre){DMA_K(0,0);DMA_V(0,0);DMA_K(1,SLOTB);}
  bf16x8 qr[4];
  #pragma unroll
  for(int d0=0;d0<4;++d0)qr[d0]=*reinterpret_cast<const bf16x8*>(&Qw[(long)r32*DM+d0*16+hi*8]);
  float l_reg=0.f;f32x16 o[2];o[0]=f32x16{};o[1]=f32x16{};
  const int qrel=wid*QBLK+r32;
  #define CMASK(P0,P1,t) do{int jb_=(t)-(NT-4); if(jb_>=0)cmask(P0,P1,jb_,qrel,hi);}while(0)
  f32x16 pA0,pA1,pB0,pB1;
  int sl_prev=0,sl_cur=0,sl_next=SLOTB;
  #define ROT() do{sl_prev=sl_cur;sl_cur=sl_next;sl_next=(sl_next==(NSLOT-1)*SLOTB)?0:sl_next+SLOTB;}while(0)
  if(!pre){DMA_K(2,2*SLOTB);}
  WAIT_BAR(3);
  float mref; { const u32x2_t w=*(const __attribute__((address_space(3))) u32x2_t*)(shm3+LDS_CK+(q0+wid*QBLK+r32)*8); mref=(__uint_as_float(w[0]<<16)+__uint_as_float(w[0]&0xffff0000u))+__uint_as_float(w[1]<<16)+bref; }
  const bf16x8 qx=mkqx(mref,hi); const f32x16 zero16=f32x16{};
  pA0=__builtin_amdgcn_mfma_f32_32x32x16_bf16(kxfrag(kxp),qx,zero16,0,0,0); pA1=__builtin_amdgcn_mfma_f32_32x32x16_bf16(kxfrag(kxp+256),qx,zero16,0,0,0);
  qkt(pA0,pA1,Kbase,qr,r32,hi);asm volatile("s_nop 15\n\ts_nop 7":"+v"(pA0),"+v"(pA1));CMASK(pA0,pA1,0);
  _Pragma("unroll") for(int r=0;r<16;++r){pA0[r]=__builtin_amdgcn_exp2f(pA0[r]);pA1[r]=__builtin_amdgcn_exp2f(pA1[r]);}
  WAIT_BAR(0);
  DMA_K(3,0);DMA_V(1,SLOTB);
  ROT();
  kload8(kf,kp0+sl_cur);
  WAIT_BAR(2);
  s16x4 vlo[8],vhi[8]; u32x4 pw0,pw1,pw2,pw3;
  #define PKW(P,B) cvtpk_s(P[B],P[B+1])
  #define PAF(k) __builtin_bit_cast(bf16x8,pw##k)
  #define VFR(i) (bf16x8){vlo[i][0],vlo[i][1],vlo[i][2],vlo[i][3],vhi[i][0],vhi[i][1],vhi[i][2],vhi[i][3]}
  #define PIN(x) asm volatile("":"+v"(x))
  #define MX3(a,b,c) __builtin_fmaxf(__builtin_fmaxf((a),(b)),(c))
  #define GAPA(MF,A0,A1,A2,A3,W0,W1,PW) do{ MF; sacc+=A0; sacc+=A1; sacc+=A2; sacc+=A3; PIN(sacc); W0; W1; PIN(PW); SBAR(); }while(0)
  #define EX(v) __builtin_amdgcn_exp2f(v)
  #define GAPB(MF,X,B) do{ MF; X[B]=EX(X[B]); X[B+1]=EX(X[B+1]); X[B+2]=EX(X[B+2]); X[B+3]=EX(X[B+3]); PIN(X); SBAR(); }while(0)
  #define VRD(i) do{ vlo[i]=vtr(vp_+(((i)>>2)*4096+((i)&3)*1024)); vhi[i]=vtr(vp_+(((i)>>2)*4096+((i)&3)*1024+512)); }while(0)
  #define KRD(G,j) do{ if(G){ kload2(kf,kp0+sl_next,j); SBAR(); } }while(0)
  #define STEP(C0,C1,P0,P1,t,GK,GV,GL) do{ SBAR(); \
    const lds_cptr vp_=vp0+sl_prev; \
    C0=__builtin_amdgcn_mfma_f32_32x32x16_bf16(kxfrag(kxp+(t)*512),qx,zero16,0,0,0); C1=__builtin_amdgcn_mfma_f32_32x32x16_bf16(kxfrag(kxp+(t)*512+256),qx,zero16,0,0,0); SBAR(); \
    VRD(0); SBAR(); float sacc=(P0[0]+P0[1]); \
    GAPA(C0=__builtin_amdgcn_mfma_f32_32x32x16_bf16(kf[0],qr[0],C0,0,0,0), P0[2],P0[3],P0[4],P0[5],     pw0[0]=PKW(P0,0), pw0[1]=PKW(P0,2), pw0); \
    VRD(4); SBAR(); GAPA(C1=__builtin_amdgcn_mfma_f32_32x32x16_bf16(kf[1],qr[0],C1,0,0,0), P0[6],P0[7],P0[8],P0[9],     pw0[2]=PKW(P0,4), pw0[3]=PKW(P0,6), pw0); \
    VRD(1); SBAR(); GAPA(C0=__builtin_amdgcn_mfma_f32_32x32x16_bf16(kf[2],qr[1],C0,0,0,0),   P0[10],P0[11],P0[12],P0[13], pw1[0]=PKW(P0,8), pw1[1]=PKW(P0,10), pw1); \
    VRD(5); SBAR(); GAPA(C1=__builtin_amdgcn_mfma_f32_32x32x16_bf16(kf[3],qr[1],C1,0,0,0),   P0[14],P0[15],P1[0],P1[1],   pw1[2]=PKW(P0,12),pw1[3]=PKW(P0,14), pw1); \
    VRD(2); SBAR(); GAPA(C0=__builtin_amdgcn_mfma_f32_32x32x16_bf16(kf[4],qr[2],C0,0,0,0),   P1[2],P1[3],P1[4],P1[5],     pw2[0]=PKW(P1,0), pw2[1]=PKW(P1,2), pw2); \
    VRD(6); SBAR(); GAPA(C1=__builtin_amdgcn_mfma_f32_32x32x16_bf16(kf[5],qr[2],C1,0,0,0),   P1[6],P1[7],P1[8],P1[9],     pw2[2]=PKW(P1,4), pw2[3]=PKW(P1,6), pw2); \
    VRD(3); SBAR(); GAPA(C0=__builtin_amdgcn_mfma_f32_32x32x16_bf16(kf[6],qr[3],C0,0,0,0),   P1[10],P1[11],P1[12],P1[13], pw3[0]=PKW(P1,8), pw3[1]=PKW(P1,10), pw3); \
    VRD(7); SBAR(); GAPA(C1=__builtin_amdgcn_mfma_f32_32x32x16_bf16(kf[7],qr[3],C1,0,0,0),   P1[14],P1[15],0.f,0.f,       pw3[2]=PKW(P1,12),pw3[3]=PKW(P1,14), pw3); \
    l_reg+=sacc; \
    if(GK){DMA_K((t)+3,sl_cur);} if(GV){DMA_V((t)+1,sl_next);} \
    CMASK(C0,C1,t); \
    SBAR(); \
    GAPB(o[0]=__builtin_amdgcn_mfma_f32_32x32x16_bf16(PAF(0),VFR(0),o[0],0,0,0), C0,0); \
    GAPB(o[1]=__builtin_amdgcn_mfma_f32_32x32x16_bf16(PAF(0),VFR(4),o[1],0,0,0), C0,4); \
    KRD(GL,0); GAPB(o[0]=__builtin_amdgcn_mfma_f32_32x32x16_bf16(PAF(1),VFR(1),o[0],0,0,0), C0,8); \
    KRD(GL,1); GAPB(o[1]=__builtin_amdgcn_mfma_f32_32x32x16_bf16(PAF(1),VFR(5),o[1],0,0,0), C0,12); \
    KRD(GL,2); GAPB(o[0]=__builtin_amdgcn_mfma_f32_32x32x16_bf16(PAF(2),VFR(2),o[0],0,0,0), C1,0); \
    KRD(GL,3); GAPB(o[1]=__builtin_amdgcn_mfma_f32_32x32x16_bf16(PAF(2),VFR(6),o[1],0,0,0), C1,4); \
    GAPB(o[0]=__builtin_amdgcn_mfma_f32_32x32x16_bf16(PAF(3),VFR(3),o[0],0,0,0), C1,8); \
    GAPB(o[1]=__builtin_amdgcn_mfma_f32_32x32x16_bf16(PAF(3),VFR(7),o[1],0,0,0), C1,12); \
    }while(0)
  int t=1;
  #undef CMASK
  #define CMASK(P0,P1,t) do{}while(0)
  for(;t+5<NT;t+=2){
    STEP(pB0,pB1,pA0,pA1,t,true,true,true);     WAIT_BAR(2); ROT();
    STEP(pA0,pA1,pB0,pB1,t+1,true,true,true);   WAIT_BAR(2); ROT();
  }
  #undef CMASK
  #define CMASK(P0,P1,t) do{int jb_=(t)-(NT-4); if(jb_>=0)cmask(P0,P1,jb_,qrel,hi);}while(0)
  #define ENDW(tt) do{ if((tt)+3<NT){WAIT_BAR(2);} else if((tt)+2<NT){WAIT_BAR(1);} else {WAIT_BAR(0);} }while(0)
  for(;t+1<NT;t+=2){
    STEP(pB0,pB1,pA0,pA1,t,(t+3<NT),(t+1<NT),(t+1<NT));       ENDW(t);   ROT();
    STEP(pA0,pA1,pB0,pB1,t+1,(t+4<NT),(t+2<NT),(t+2<NT));     ENDW(t+1); ROT();
  }
  STEP(pB0,pB1,pA0,pA1,NT-1,false,false,false);
  u32x4 sgv[4]; { const bf16*SGw=SG+(rowbase+q0+wid*QBLK)*DM+h*D;
    #pragma unroll
    for(int i=0;i<4;++i) sgv[i]=*(const u32x4*)(SGw+(long)(i*8+(lane>>3))*DM+(lane&7)*8); }
  SBAR();
  { float sacc=pB0[0]+pB0[1]; _Pragma("unroll") for(int r=2;r<16;++r)sacc+=pB0[r]; _Pragma("unroll") for(int r=0;r<16;++r)sacc+=pB1[r]; l_reg+=sacc;
    pw0=(u32x4){PKW(pB0,0),PKW(pB0,2),PKW(pB0,4),PKW(pB0,6)};pw1=(u32x4){PKW(pB0,8),PKW(pB0,10),PKW(pB0,12),PKW(pB0,14)};pw2=(u32x4){PKW(pB1,0),PKW(pB1,2),PKW(pB1,4),PKW(pB1,6)};pw3=(u32x4){PKW(pB1,8),PKW(pB1,10),PKW(pB1,12),PKW(pB1,14)};
    SBAR(); pv(o,vb0+sl_cur,PAF(0),PAF(1),PAF(2),PAF(3)); }
  asm volatile("s_waitcnt lgkmcnt(0)\n\ts_barrier":::"memory");
  if(nxt){DMA_K(0,0);DMA_V(0,0);DMA_K(1,SLOTB);DMA_K(2,2*SLOTB);}
  #undef PKW
  #undef PAF
  #undef VFR
  #undef PIN
  #undef MX3
  #undef GAPA
  #undef GAPB
  #undef EX
  #undef VRD
  #undef KRD
  #undef STEP
  #undef ENDW
  {auto rr=__builtin_amdgcn_permlane32_swap(__float_as_uint(l_reg),__float_as_uint(l_reg),false,false);l_reg=__uint_as_float(rr[0])+__uint_as_float(rr[1]);}
  if(hi==0)wsf[32+r32]=l_reg;asm volatile("s_waitcnt lgkmcnt(0)":::"memory");
  float rli[16];
  #pragma unroll
  for(int r=0;r<16;++r)rli[r]=__builtin_amdgcn_rcpf(wsf[32+crow(r,hi)]);
  bf16*Ow=O+(rowbase+q0+wid*QBLK)*DM+h*D;
  { bf16*stg=(bf16*)(shm+LDS_OST)+wid*2048;
    #pragma unroll
    for(int r=0;r<16;++r){const int orow=crow(r,hi);
      #pragma unroll
      for(int d0=0;d0<2;++d0)stg[orow*64+d0*32+r32]=__float2bfloat16(o[d0][r]*rli[r]);}
    asm volatile("s_waitcnt lgkmcnt(0)":::"memory");
    #pragma unroll
    for(int i=0;i<4;++i){const int row=i*8+(lane>>3),ch=lane&7; u32x4 v=*(const u32x4*)(stg+row*64+ch*8); const u32x4 g=sgv[i];
      #pragma unroll
      for(int e=0;e<4;++e){ const float lo=__uint_as_float(v[e]<<16)*__uint_as_float(g[e]<<16), hh=__uint_as_float(v[e]&0xffff0000u)*__uint_as_float(g[e]&0xffff0000u); v[e]=cvtpk_s(lo,hh); }
      ATTN_STORE16(Ow+(long)row*DM+ch*8,v);} }
  asm volatile("s_waitcnt lgkmcnt(0)":::"memory");
  #undef DMA_K
  #undef DMA_V
  #undef CMASK
  #undef ROT
}
constexpr int ATTN_LDS_BYTES=LDS_BYTES;
struct AttnTensors { const bf16* Q; const bf16* K; const bf16* V; const bf16* SG; bf16* O; const float* cumloc; const float* ctot; const float* qg; const float* kg; };
struct AttnUnit { int bh; int qb; };
struct StaticOrder {
  int vcu, G, nb;
  __device__ __forceinline__ explicit StaticOrder(int grid,int block,int nbatch):vcu((grid%8==0)?(block%8)*(grid/8)+block/8:block),G(grid),nb(nbatch){}
  __device__ __forceinline__ bool next(int i,AttnUnit&u)const{
    if(G==2*nb*NHEAD){ if(i>=4)return false; const int s=vcu&1; u.bh=vcu>>1; u.qb=(i==0)?s:(i==1)?7-s:(i==2)?3-s:4+s; return true; }
    const int id=vcu+i*G; if(id>=nb*NHEAD*NQB)return false; u.bh=id/NQB; u.qb=id%NQB; return true; }
  __device__ __forceinline__ void a_ready(const AttnUnit&)const{}
  __device__ __forceinline__ void done(const AttnUnit&)const{}
};
template<class Sched,int THRL=8> __device__ __forceinline__ void attn_phase(char*lds,const AttnTensors&T,const Sched&S,const int tid){
  AttnUnit u,un; int cur_bh=-1; bool pre=false; bool has=S.next(0,u);
  float bref; { float gq=fabsf(T.qg[tid&63]),gk=fabsf(T.kg[tid&63]);
    #pragma unroll
    for(int o=1;o<64;o<<=1){ gq=fmaxf(gq,__shfl_xor(gq,o)); gk=fmaxf(gk,__shfl_xor(gk,o)); }
    bref=8.0f*1.4426950408889634f*gq*gk+1.0f; }
  for(int i=0;has;++i){ S.a_ready(u); const bool hasn=S.next(i+1,un); const bool nxt=hasn&&un.bh==u.bh;
    if(u.bh!=cur_bh){ cur_bh=u.bh;
      int tq=tid; asm volatile("":"+v"(tq));
      const int b_=u.bh/NHEAD,h_=u.bh%NHEAD,l_=tq&31,c_=tq>>4;
      float v=T.ctot[(size_t)(b_*(SEQ/64)+l_)*16+h_];
      #pragma unroll
      for(int o=1;o<32;o<<=1){ const float nn=__shfl_up(v,o,32); if(l_>=o)v+=nn; }
      const float pre=__shfl(v,(c_+31)&31,32); const float base=(c_==0)?0.f:pre;
      const f32x4_t cl=*(const f32x4_t*)(T.cumloc+((size_t)u.bh)*SEQ+4*tq);
      { u32x4 w0,w1; unsigned h_,m_,l_;
        split3(-(cl[0]+base),h_,m_,l_); w0[0]=h_|(m_<<16); w0[1]=l_|0xBF800000u; split3(-(cl[1]+base),h_,m_,l_); w0[2]=h_|(m_<<16); w0[3]=l_|0xBF800000u;
        split3(-(cl[2]+base),h_,m_,l_); w1[0]=h_|(m_<<16); w1[1]=l_|0xBF800000u; split3(-(cl[3]+base),h_,m_,l_); w1[2]=h_|(m_<<16); w1[3]=l_|0xBF800000u;
        *(u32x4*)(lds+LDS_CK+32*tq)=w0; *(u32x4*)(lds+LDS_CK+32*tq+16)=w1; }
      asm volatile("s_waitcnt vmcnt(0) lgkmcnt(0)\n\ts_barrier":::"memory"); }
    attn_unit<THRL>(u.bh/NHEAD,u.bh%NHEAD,u.qb,T.Q,T.K,T.V,T.SG,T.O,lds,tid,pre,nxt,bref); S.done(u); pre=nxt; u=un; has=hasn; }
}
#undef SBAR
#undef WAIT_BAR
}
#define LAS __attribute__((address_space(3)))
typedef unsigned short bf16_t;
typedef short bf16x8_t __attribute__((ext_vector_type(8)));
typedef float f32x4 __attribute__((ext_vector_type(4)));
typedef float f32x2 __attribute__((ext_vector_type(2)));
typedef unsigned u32x4 __attribute__((ext_vector_type(4)));
constexpr int NWAVES = 8;
constexpr int RING_BYTES = 131072, LDS_BYTES = 147456, MISC_OFF = LDS_BYTES - 256;
static_assert(attn_body::LDS_BYTES <= RING_BYTES, "attention scratch must fit the ring region");
constexpr size_t MiB = 1u << 20;
constexpr size_t WS_P = 1 * MiB, WS_CUMLOC = 2 * MiB, WS_CTOT = 3 * MiB, WS_SSM = 4 * MiB, WS_W = 16 * MiB, WS_HB = 52 * MiB;
constexpr size_t WS_B1 = 84 * MiB, WS_B2 = 116 * MiB, WS_B3 = 148 * MiB, WS_B4 = 180 * MiB, WS_Y = 212 * MiB, WS_END = 244 * MiB;
constexpr int W_C0IN = 0, W_C0OUT = 3072, W_FIN = 4096, W_FF = 8192, W_FOUT = 8448, W_SIN = 9472, W_SGLU = 11520, W_SOUT = 12544, W_C1IN = 13568, W_C1OUT = 16640, W_ROWS = 17664;
static_assert(WS_W + (size_t)W_ROWS * 2048 <= WS_HB, "weights fit");

__device__ __forceinline__ unsigned f2bf_(float f) { unsigned u = __builtin_bit_cast(unsigned, f); return (u + 0x7fffu + ((u >> 16) & 1u)) >> 16; }
__device__ __forceinline__ unsigned pk2(float lo, float hi) { return f2bf_(lo) | (f2bf_(hi) << 16); }
__device__ __forceinline__ float wave_sum(float v) {
#pragma unroll
    for (int o = 1; o < 64; o <<= 1) v += __shfl_xor(v, o);
    return v;
}
#define GAS __attribute__((address_space(1)))
#define RLX_AGENT __ATOMIC_RELAXED, __HIP_MEMORY_SCOPE_AGENT
#define LDS_WAIT() asm volatile("s_waitcnt lgkmcnt(0)" ::: "memory")
#define VM_WAIT() asm volatile("s_waitcnt vmcnt(0)" ::: "memory")
#define XB_TMO      128
#define XB_XCNT(j)  (256  + 64 * (j))
#define XB_XSUB(j)  (1280 + 64 * (j))
#define XB_XGEN(j)  (2304 + 64 * (j))
#define XB_TOP      3328
#define XB_TOPGEN   3392
#define XCD_BAR_WORDS 3456
#define XB_SPIN_CAP (1u << 18)

__device__ __forceinline__ unsigned xb_ld(unsigned* p)              { return __hip_atomic_load(p, __ATOMIC_RELAXED, __HIP_MEMORY_SCOPE_AGENT); }
__device__ __forceinline__ unsigned xb_add(unsigned* p, unsigned v) { return __hip_atomic_fetch_add(p, v, __ATOMIC_RELAXED, __HIP_MEMORY_SCOPE_AGENT); }
__device__ __forceinline__ unsigned xb_xcc_id() { return (unsigned)__builtin_amdgcn_s_getreg((3 << 11) | 20) & 0xFu; }
#define XB_SPIN(cond, bar) do { unsigned _sp = 0; while (cond) { __builtin_amdgcn_s_sleep(1); \
    if ((++_sp & 255u) == 0u) { if (xb_ld(&(bar)[XB_TMO])) break; if (_sp > XB_SPIN_CAP) { atomicAdd(&(bar)[XB_TMO], 1u); break; } } } } while (0)

struct XcdBarrier {
    unsigned* bar; unsigned x; unsigned gsz;
    volatile LAS unsigned* st;
};

__device__ __forceinline__ XcdBarrier xcd_barrier_post(unsigned* bar, volatile LAS unsigned* st, const int tid, unsigned gsz) {
    XcdBarrier b; b.bar = bar; b.x = xb_xcc_id(); b.st = st; b.gsz = gsz;
    if (tid == 0) st[2] = xb_add(&bar[XB_XCNT(b.x)], 1u);
    return b;
}
__device__ __forceinline__ void xcd_barrier_complete(unsigned* bar, unsigned x, unsigned& nloc, unsigned& nx, const unsigned G, unsigned& regular) {
    unsigned sum, cnt, mine, sp = 0u, reg;
    for (;;) {
        sum = 0u; cnt = 0u; mine = 0u; reg = 1u;
#pragma unroll
        for (unsigned j = 0; j < 16; ++j) { const unsigned c = xb_ld(&bar[XB_XCNT(j)]); sum += c; cnt += (c > 0u) ? 1u : 0u; mine = (j == x) ? c : mine; reg &= (c == (j < 8u ? G / 8u : 0u)) ? 1u : 0u; }
        if (sum == G) break;
        __builtin_amdgcn_s_sleep(1);
        if ((++sp & 255u) == 0u) { if (xb_ld(&bar[XB_TMO])) break; if (sp > XB_SPIN_CAP) { atomicAdd(&bar[XB_TMO], 1u); break; } }
    }
    nloc = mine > 0u ? mine : 1u; nx = cnt > 0u ? cnt : 1u; regular = (sum == G && (G % 8u) == 0u) ? reg : 0u;
}

struct XbNoHook { __device__ __forceinline__ void operator()() const {} };
template <class Hook = XbNoHook>
__device__ __forceinline__ void xcd_barrier(const XcdBarrier& b, const int tid, const bool local = false, const Hook& hook = Hook()) {
    asm volatile("s_waitcnt vmcnt(0)" ::: "memory");
    __syncthreads();
    if (__builtin_amdgcn_readfirstlane(tid >> 6) != 0) hook();
    if (tid == 0) {
        unsigned* bar = b.bar;
        __builtin_amdgcn_s_waitcnt(0);
        unsigned nloc = b.st[0], nx = b.st[1];
        if (nloc == 0u) { unsigned regular; xcd_barrier_complete(bar, b.x, nloc, nx, b.gsz, regular); b.st[0] = nloc; b.st[1] = nx; b.st[3] = regular; }
        const unsigned old = xb_add(&bar[XB_XSUB(b.x)], 1u);
        const unsigned gen = old / nloc;
        if (local) {
            if (old + 1u == (gen + 1u) * nloc) xb_add(&bar[XB_XGEN(b.x)], 1u);
            else XB_SPIN((int)(xb_ld(&bar[XB_XGEN(b.x)]) - gen) <= 0, bar);
            __builtin_amdgcn_fence(__ATOMIC_ACQUIRE, "agent");
            asm volatile("s_waitcnt vmcnt(0)" ::: "memory");
        } else if (const unsigned nf = b.st[4]; (b.st[4] = nf + 1u), old + 1u == (gen + 1u) * nloc) {
            __builtin_amdgcn_fence(__ATOMIC_RELEASE, "agent");
            asm volatile("s_waitcnt vmcnt(0)" ::: "memory");
            const unsigned og = xb_add(&bar[XB_TOP], 1u);
            const unsigned tg = og / nx;
            if (og + 1u == (tg + 1u) * nx) xb_add(&bar[XB_TOPGEN], 1u);
            else XB_SPIN(xb_ld(&bar[XB_TOPGEN]) == tg, bar);
            __builtin_amdgcn_fence(__ATOMIC_ACQUIRE, "agent");
            xb_add(&bar[XB_XGEN(b.x)], 1u);
            asm volatile("s_waitcnt vmcnt(0)" ::: "memory");
        } else {
            XB_SPIN((int)(xb_ld(&bar[XB_TOPGEN]) - nf) <= 0, bar);
            __builtin_amdgcn_fence(__ATOMIC_ACQUIRE, "agent");
            asm volatile("s_waitcnt vmcnt(0)" ::: "memory");
        }
    }
    __syncthreads();
}

__device__ __forceinline__ int lane_id_fresh() { int r; asm volatile("v_mbcnt_lo_u32_b32 %0, -1, 0\n\tv_mbcnt_hi_u32_b32 %0, -1, %0" : "=v"(r)); return r; }
struct Args { const float* in[25]; float* out; unsigned char* ws; int ph_lo, ph_hi; };

__device__ __forceinline__ int dst_row32(int s, int mode) {
    if (mode == 1) { if (s < 1024) return 256 * (s >> 7) + (s & 127); if (s < 2048) { const int t = s - 1024; return 256 * (t >> 7) + 128 + (t & 127); } return s; }
    if (mode == 2) { const int sec = s >> 10, hd = (s & 1023) >> 6, bj = (s & 63) >> 5, e = s & 31; return 1024 * sec + 256 * (hd >> 2) + 128 * bj + 32 * (hd & 3) + e; }
    return s;
}
__device__ __forceinline__ void p0_transpose_item(const float* W, int ldw, int N, const float* gain, bf16_t* WT, int mode, int item, int lane) {
    const int nblk = N / 64, kb = item / nblk, nb = item % nblk, k0 = 64 * kb, n0 = 64 * nb, q = lane >> 4, nn = lane & 15;
    f32x4 v[16]; f32x4 gk[4];
    const float* src = W + (size_t)(k0 + 16 * q) * ldw + n0 + 4 * nn;
#pragma unroll
    for (int i = 0; i < 16; ++i) v[i] = __builtin_nontemporal_load((const f32x4*)(src + (size_t)i * ldw));
#pragma unroll
    for (int i = 0; i < 4; ++i) gk[i] = (f32x4){1.f, 1.f, 1.f, 1.f};
    if (gain) {
#pragma unroll
        for (int i = 0; i < 4; ++i) gk[i] = *(const f32x4*)(gain + k0 + 16 * q + 4 * i);
    }
#pragma unroll
    for (int i = 0; i < 16; ++i) v[i] = v[i] * gk[i >> 2][i & 3];
#pragma unroll
    for (int e = 0; e < 4; ++e) { const int n = 4 * nn + e, r = dst_row32(n0 + (n & 32), mode) + (n & 31); bf16_t* d = WT + (size_t)r * 1024 + k0 + 16 * q;
#pragma unroll
        for (int h = 0; h < 2; ++h) { u32x4 o; o.x = pk2(v[8 * h][e], v[8 * h + 1][e]); o.y = pk2(v[8 * h + 2][e], v[8 * h + 3][e]); o.z = pk2(v[8 * h + 4][e], v[8 * h + 5][e]); o.w = pk2(v[8 * h + 6][e], v[8 * h + 7][e]);
            *(u32x4*)(d + 8 * h) = o; } }
}
constexpr int P0_I3072 = 16 * 3072 / 64, P0_NITEMS = 2 * (16 * 3072 / 64) + 5 * (16 * 1024 / 64) + 16 * 4096 / 64 + 16 * 2048 / 64;
__device__ __forceinline__ void p0_prologue(const Args& a, LAS unsigned char* lds, int vcu, int G, const int tid, const int item_lo, const int item_hi, const bool do_wf, const int row_lo, const int row_hi) {
    const int lane = tid & 63, wave = __builtin_amdgcn_readfirstlane(tid >> 6);
    const int gw = vcu * NWAVES + wave, NGW = G * NWAVES;
    bf16_t* WB = (bf16_t*)(a.ws + WS_W);
    const float* ng = a.in[1];
    constexpr int I3072 = 16 * 3072 / 64, I1024 = 16 * 1024 / 64, I4096 = 16 * 4096 / 64, I2048 = 16 * 2048 / 64;
    const int NITEMS = item_hi - item_lo;
    const int nfull = NITEMS / NGW, nloop = nfull + ((NITEMS - nfull * NGW) + G * NWAVES - 1) / (G * NWAVES);
    for (int k = 0; k < nloop; ++k) {
        const int it = k < nfull ? k * NGW + gw : nfull * NGW + (k - nfull) * NGW + vcu + G * wave;
        if (it >= NITEMS) continue;
        int r = it + item_lo;
        if (r < I3072) { p0_transpose_item(a.in[2], 3072, 3072, ng, WB + (size_t)W_C0IN * 1024, 1, r, lane); continue; } r -= I3072;
        if (r < I1024) { p0_transpose_item(a.in[7], 1024, 1024, nullptr, WB + (size_t)W_C0OUT * 1024, 0, r, lane); continue; } r -= I1024;
        if (r < I4096) { p0_transpose_item(a.in[8], 4112, 4096, ng + 1024, WB + (size_t)W_FIN * 1024, 2, r, lane); continue; } r -= I4096;
        if (r < I1024) { p0_transpose_item(a.in[12], 1024, 1024, nullptr, WB + (size_t)W_FOUT * 1024, 0, r, lane); continue; } r -= I1024;
        if (r < I2048) { p0_transpose_item(a.in[13], 2048, 2048, ng + 2048, WB + (size_t)W_SIN * 1024, 0, r, lane); continue; } r -= I2048;
        if (r < I1024) { p0_transpose_item(a.in[22], 1024, 1024, nullptr, WB + (size_t)W_SGLU * 1024, 0, r, lane); continue; } r -= I1024;
        if (r < I1024) { p0_transpose_item(a.in[24], 1024, 1024, nullptr, WB + (size_t)W_SOUT * 1024, 0, r, lane); continue; } r -= I1024;
        if (r < I3072) { p0_transpose_item(a.in[2] + (size_t)1024 * 3072, 3072, 3072, ng + 3072, WB + (size_t)W_C1IN * 1024, 1, r, lane); continue; } r -= I3072;
        p0_transpose_item(a.in[7] + (size_t)1024 * 1024, 1024, 1024, nullptr, WB + (size_t)W_C1OUT * 1024, 0, r, lane);
    }
    if (do_wf) for (int e = vcu * 512 + tid; e < 16 * 1024; e += G * 512) { const int n = e >> 10, k = e & 1023; WB[(size_t)(W_FF + n) * 1024 + k] = (bf16_t)f2bf_(a.in[8][(size_t)k * 4112 + 4096 + n] * ng[1024 + k]); }
    bf16_t* hb = (bf16_t*)(a.ws + WS_HB); float* P = (float*)(a.ws + WS_P);
    for (int m0 = row_lo + 4 * gw; m0 < row_hi; m0 += 4 * NGW) {
        f32x4 v[4][4];
#pragma unroll
        for (int r = 0; r < 4; ++r)
#pragma unroll
            for (int j = 0; j < 4; ++j) v[r][j] = __builtin_nontemporal_load(((const f32x4*)(a.in[0] + (size_t)(m0 + r) * 1024)) + lane + 64 * j);
#pragma unroll
        for (int r = 0; r < 4; ++r) { float s = 0.f; unsigned long long* o8 = (unsigned long long*)(hb + (size_t)(m0 + r) * 1024) + lane;
#pragma unroll
            for (int j = 0; j < 4; ++j) { const f32x4 x = v[r][j]; s += (x[0] * x[0] + x[1] * x[1]) + (x[2] * x[2] + x[3] * x[3]);
                o8[64 * j] = (unsigned long long)pk2(x[0], x[1]) | ((unsigned long long)pk2(x[2], x[3]) << 32); }
            s = wave_sum(s);
            if (lane < 4) ((f32x4*)(P + (size_t)(m0 + r) * 16))[lane] = (f32x4){lane == 0 ? s : 0.f, 0.f, 0.f, 0.f}; }
    }
}
__device__ __forceinline__ void conv_phase(LAS unsigned char* lds, const bf16_t* U, const bf16_t* SG, const float* cw, const float* cb, const float* lg, const float* lb, bf16_t* Y, int vcu, int G, const int tid, const int mtok) {
    const int lane = tid & 63, wave = __builtin_amdgcn_readfirstlane(tid >> 6);
    f32x2 w[CONV_K];
#pragma unroll
    for (int j = 0; j < CONV_K; ++j) w[j] = *(const f32x2*)(cw + (size_t)j * 1024 + 2 * tid);
    const f32x2 bias = *(const f32x2*)(cb + 2 * tid);
    LAS float* tile = (LAS float*)lds;
    const int nunit = mtok / 32, per = (nunit % G == 0) ? nunit / G : 0;
    for (int ui = 0, unit = per ? vcu * per : vcu; unit < nunit && (per == 0 || ui < per); ++ui, unit = per ? unit + 1 : unit + G) {
        const int t0 = unit * 32, seq0 = t0 & ~(SEQ - 1);

        f32x2 out[32];
#pragma unroll
        for (int tt = 0; tt < 32; ++tt) out[tt] = bias;
#pragma unroll
        for (int i = 0; i < 62; ++i) {
            const int row = t0 - 30 + i, rowc = row < seq0 ? seq0 : row;
            const unsigned raw = *(const unsigned*)(U + (size_t)rowc * 1024 + 2 * tid);
            f32x2 uv; uv.x = __uint_as_float(raw << 16); uv.y = __uint_as_float(raw & 0xffff0000u);
            if (row < seq0) uv = (f32x2){0.f, 0.f};
#pragma unroll
            for (int tt = (i > 30 ? i - 30 : 0); tt <= (i < 31 ? i : 31); ++tt) out[tt] += w[i - tt] * uv;
        }
#pragma unroll
        for (int tt = 0; tt < 32; ++tt) *(LAS f32x2*)(tile + tt * 1024 + 2 * tid) = out[tt];
        __syncthreads();
        {
            u32x4 sgv[4][2]; f32x4 gg[4], bbv[4];
#pragma unroll
            for (int q = 0; q < 4; ++q)
#pragma unroll
                for (int hf = 0; hf < 2; ++hf) sgv[q][hf] = __builtin_nontemporal_load((const u32x4*)(SG + (size_t)(t0 + wave * 4 + q) * 1024 + 8 * lane + 512 * hf));
#pragma unroll
            for (int hf = 0; hf < 2; ++hf) { gg[2 * hf] = *(const f32x4*)(lg + 8 * lane + 512 * hf); gg[2 * hf + 1] = *(const f32x4*)(lg + 8 * lane + 512 * hf + 4);
                bbv[2 * hf] = *(const f32x4*)(lb + 8 * lane + 512 * hf); bbv[2 * hf + 1] = *(const f32x4*)(lb + 8 * lane + 512 * hf + 4); }
            f32x4 v[4][4]; float s1[4], s2[4];
#pragma unroll
            for (int q = 0; q < 4; ++q) { const LAS float* tr = tile + (wave * 4 + q) * 1024 + 8 * lane;
                v[q][0] = *(const LAS f32x4*)(tr); v[q][1] = *(const LAS f32x4*)(tr + 4); v[q][2] = *(const LAS f32x4*)(tr + 512); v[q][3] = *(const LAS f32x4*)(tr + 516);
                s1[q] = 0.f; s2[q] = 0.f;
#pragma unroll
                for (int j = 0; j < 4; ++j) { s1[q] += (v[q][j][0] + v[q][j][1]) + (v[q][j][2] + v[q][j][3]); s2[q] += (v[q][j][0] * v[q][j][0] + v[q][j][1] * v[q][j][1]) + (v[q][j][2] * v[q][j][2] + v[q][j][3] * v[q][j][3]); } }
#pragma unroll
            for (int o = 1; o < 64; o <<= 1)
#pragma unroll
                for (int q = 0; q < 4; ++q) { s1[q] += __shfl_xor(s1[q], o); s2[q] += __shfl_xor(s2[q], o); }
#pragma unroll
            for (int q = 0; q < 4; ++q) {
                const float mu = s1[q] * (1.0f / 1024.0f), var = fmaxf(s2[q] * (1.0f / 1024.0f) - mu * mu, 0.f), rstd = rsqrtf(var + LN_EPS);
                const size_t off = (size_t)(t0 + wave * 4 + q) * 1024 + 8 * lane;
#pragma unroll
                for (int hf = 0; hf < 2; ++hf) { const u32x4 sg = sgv[q][hf];
                    const f32x4 y0 = (v[q][2 * hf] - mu) * rstd * gg[2 * hf] + bbv[2 * hf], y1 = (v[q][2 * hf + 1] - mu) * rstd * gg[2 * hf + 1] + bbv[2 * hf + 1]; u32x4 o;
                    o.x = pg8::cvt_pk_bf16(pg8::silu(y0[0]) * pg8::bflo(sg.x), pg8::silu(y0[1]) * pg8::bfhi(sg.x));
                    o.y = pg8::cvt_pk_bf16(pg8::silu(y0[2]) * pg8::bflo(sg.y), pg8::silu(y0[3]) * pg8::bfhi(sg.y));
                    o.z = pg8::cvt_pk_bf16(pg8::silu(y1[0]) * pg8::bflo(sg.z), pg8::silu(y1[1]) * pg8::bfhi(sg.z));
                    o.w = pg8::cvt_pk_bf16(pg8::silu(y1[2]) * pg8::bflo(sg.w), pg8::silu(y1[3]) * pg8::bfhi(sg.w));
                    *(u32x4*)(Y + off + 512 * hf) = o; }
            }
        }
        __syncthreads();
    }
}
__device__ __forceinline__ void fcum_phase(LAS unsigned char* lds, const bf16_t* hb, const bf16_t* Wf, const float* P, const float* fbias, float* cumloc, float* ctot, int vcu, int G, const int tid, const int mtok) {
    const int lane = tid & 63, wave = __builtin_amdgcn_readfirstlane(tid >> 6);
    LAS float* part = (LAS float*)lds;
    LAS float* lf = part + 2 * 64 * 17;
    for (int ch = vcu; ch < mtok / 64; ch += G) {
        f32x4 pq[2][4];
#pragma unroll
        for (int e = 0; e < 2; ++e) { const f32x4* pp = (const f32x4*)(P + (size_t)(ch * 64 + ((tid + 512 * e) >> 4)) * 16); pq[e][0] = pp[0]; pq[e][1] = pp[1]; pq[e][2] = pp[2]; pq[e][3] = pp[3]; }
        {
            const int tg = wave & 3, kh = wave >> 2, tok0 = ch * 64 + tg * 16;
            const bf16_t* ap = hb + (size_t)(tok0 + (lane & 15)) * 1024 + kh * 512 + 8 * (lane >> 4);
            const bf16_t* bp = Wf + (size_t)(lane & 15) * 1024 + kh * 512 + 8 * (lane >> 4);
            bf16x8_t av[16], bv[16];
#pragma unroll
            for (int ks = 0; ks < 16; ++ks) { av[ks] = *(const bf16x8_t*)(ap + ks * 32); bv[ks] = *(const bf16x8_t*)(bp + ks * 32); }
            f32x4 acc = (f32x4){0.f, 0.f, 0.f, 0.f};
#pragma unroll
            for (int ks = 0; ks < 16; ++ks) acc = __builtin_amdgcn_mfma_f32_16x16x32_bf16(av[ks], bv[ks], acc, 0, 0, 0);
#pragma unroll
            for (int r = 0; r < 4; ++r) part[(kh * 64 + tg * 16 + 4 * (lane >> 4) + r) * 17 + (lane & 15)] = acc[r];
        }
        __syncthreads();
#pragma unroll
        for (int e = 0; e < 2; ++e) {
            const int idx = tid + 512 * e, tl = idx >> 4, h = idx & 15;
            const f32x4 p0 = pq[e][0], p1 = pq[e][1], p2 = pq[e][2], p3 = pq[e][3];
            const float ss = ((p0[0] + p0[1]) + (p0[2] + p0[3])) + ((p1[0] + p1[1]) + (p1[2] + p1[3])) + ((p2[0] + p2[1]) + (p2[2] + p2[3])) + ((p3[0] + p3[1]) + (p3[2] + p3[3]));
            const float x = (part[tl * 17 + h] + part[(64 + tl) * 17 + h]) * rsqrtf(ss * (1.0f / 1024.0f) + RMS_EPS) + fbias[h];
            lf[tl * 17 + h] = (fminf(x, 0.f) - log1pf(__expf(-fabsf(x)))) * LOG2E; }
        __syncthreads();
#pragma unroll
        for (int e = 0; e < 2; ++e) {
            const int h = 2 * wave + e; float c = lf[lane * 17 + h];
#pragma unroll
            for (int o = 1; o < 64; o <<= 1) { const float nn = __shfl_up(c, o); if (lane >= o) c += nn; }
            const int b = ch / (SEQ / 64), cc = ch % (SEQ / 64);
            cumloc[((size_t)(b * NHEADS + h)) * SEQ + cc * 64 + lane] = c;
            if (lane == 63) ctot[(size_t)ch * 16 + h] = c; }
        __syncthreads();
    }
}
constexpr int SSM_OFF_BM = 0, SSM_OFF_PW = 65536, SSM_OFF_KT = SSM_OFF_PW + 2560, SSM_OFF_CM = SSM_OFF_KT + 8704, SSM_GS = SSM_OFF_CM + 65536;
constexpr size_t WS_SSM_PN = 13 * MiB;
static_assert(WS_SSM + (size_t)NGRP * SSM_GS <= WS_SSM_PN && SSM_GS <= MISC_OFF, "ssm tables");

__device__ __forceinline__ f32x4 cmul2(const f32x4 a, const f32x4 x) { return (f32x4){a[0] * x[0] - a[1] * x[1], a[0] * x[1] + a[1] * x[0], a[2] * x[2] - a[3] * x[3], a[2] * x[3] + a[3] * x[2]}; }
template <int CTRL> __device__ __forceinline__ float dpp_f(float v) { return __builtin_bit_cast(float, __builtin_amdgcn_update_dpp(0, __builtin_bit_cast(int, v), CTRL, 0xf, 0xf, true)); }
template <int CTRL> __device__ __forceinline__ f32x4 dpp4(const f32x4 v) { return (f32x4){dpp_f<CTRL>(v[0]), dpp_f<CTRL>(v[1]), dpp_f<CTRL>(v[2]), dpp_f<CTRL>(v[3])}; }

__device__ __forceinline__ void ssm_tables(const Args& a, LAS unsigned char* lds, int vcu, int G, const int tid) {
    const float* log_dt = a.in[14]; const float* a_re = a.in[15]; const float* a_im = a.in[16]; const float* b_re = a.in[17]; const float* b_im = a.in[18];
    const float* c_re = a.in[19]; const float* c_im = a.in[20];
    LAS float* pw = (LAS float*)lds;
    LAS float* bb = pw + 17 * 64 * 2;
    LAS float* big = bb + 64 * 17 * 2;
    LAS float* cc = big + 21 * 64 * 2;
    LAS float* zz = cc + 16 * 65 * 2;
    for (int unit = vcu; unit < 4 * NGRP; unit += G) {
        const int g = unit >> 2, sub = unit & 3;
        __syncthreads();
        if (tid < 64) {
            const int p = tid; const double dt = exp((double)log_dt[g]);
            const float are = a_re[g * 64 + p], aim = a_im[g * 64 + p], x = are * (float)dt;
            double ang = (double)aim * dt; ang -= 6.283185307179586 * rint(ang * 0.15915494309189535);
            float sn, cs, sh, ch; sincosf((float)ang, &sn, &cs); sincosf(0.5f * (float)ang, &sh, &ch);
            const float em1 = expm1f(x), mag = em1 + 1.0f, abr = mag * cs, abi = mag * sn;
            const float nr = em1 * cs - 2.0f * sh * sh, ni = mag * sn, den = are * are + aim * aim;
            zz[p * 2] = (nr * are + ni * aim) / den; zz[p * 2 + 1] = (ni * are - nr * aim) / den;
            float pr = 1.0f, pi = 0.0f;
#pragma unroll
            for (int l = 0; l <= 16; ++l) { pw[(l * 64 + p) * 2] = pr; pw[(l * 64 + p) * 2 + 1] = pi; const float t = pr * abr - pi * abi; pi = pr * abi + pi * abr; pr = t; }
            float qr = pw[(16 * 64 + p) * 2], qi = pw[(16 * 64 + p) * 2 + 1]; const float ar16 = qr, ai16 = qi;
#pragma unroll
            for (int d = 0; d < 5; ++d) { big[(d * 64 + p) * 2] = qr; big[(d * 64 + p) * 2 + 1] = qi; const float t = qr * qr - qi * qi; qi = 2.0f * qr * qi; qr = t; }
            qr = 1.0f; qi = 0.0f;
#pragma unroll
            for (int n = 0; n < 16; ++n) { big[((5 + n) * 64 + p) * 2] = qr; big[((5 + n) * 64 + p) * 2 + 1] = qi; const float t = qr * ar16 - qi * ai16; qi = qr * ai16 + qi * ar16; qr = t; }
        } else {
            for (int job = tid - 64; job < 1024; job += 448) { const int c = job >> 6, p = job & 63; cc[(c * 65 + p) * 2] = c_re[(size_t)g * 1024 + job]; cc[(c * 65 + p) * 2 + 1] = c_im[(size_t)g * 1024 + job]; }
        }
        __syncthreads();
        for (int job = tid; job < 1024; job += 512) { const int p = job >> 4, c = job & 15; const float zr = zz[p * 2], zi = zz[p * 2 + 1];
            const float br = b_re[(size_t)g * 1024 + job], bi = b_im[(size_t)g * 1024 + job];
            bb[(p * 17 + c) * 2] = zr * br - zi * bi; bb[(p * 17 + c) * 2 + 1] = zr * bi + zi * br; }
        __syncthreads();
        unsigned char* gb = a.ws + WS_SSM + (size_t)g * SSM_GS;
        for (int job = tid; job < 1024; job += 512) {
            const int fl = job >> 6, l = job & 63, rt = 2 * sub + (fl >> 3), s = fl & 7, R = 16 * rt + (l & 15), p = R >> 1, part = R & 1, j = 2 * s + (l >> 5), c0 = 8 * ((l >> 4) & 1);
            const float pr = pw[((15 - j) * 64 + p) * 2], pi = pw[((15 - j) * 64 + p) * 2 + 1]; float v[8];
#pragma unroll
            for (int e = 0; e < 8; ++e) { const float xr = bb[(p * 17 + c0 + e) * 2], xi = bb[(p * 17 + c0 + e) * 2 + 1]; v[e] = part ? (pr * xi + pi * xr) : (pr * xr - pi * xi); }
            *(u32x4*)(gb + SSM_OFF_BM + ((rt * 8 + s) * 64 + l) * 16) = (u32x4){pk2(v[0], v[1]), pk2(v[2], v[3]), pk2(v[4], v[5]), pk2(v[6], v[7])}; }
        for (int job = tid; job < 1024; job += 512) {
            const int fl = job >> 6, l = job & 63, i = 4 * sub + (fl >> 2), s = fl & 3, c = l & 15, q = l >> 4; float v[8];
#pragma unroll
            for (int e = 0; e < 8; ++e) { const int R = 16 * (2 * s + (e >> 2)) + 4 * q + (e & 3), p = R >> 1, part = R & 1;
                const float cr = cc[(c * 65 + p) * 2], ci = cc[(c * 65 + p) * 2 + 1], pr = pw[((i + 1) * 64 + p) * 2], pi = pw[((i + 1) * 64 + p) * 2 + 1];
                v[e] = part ? -(cr * pi + ci * pr) : (cr * pr - ci * pi); }
            *(u32x4*)(gb + SSM_OFF_CM + ((i * 4 + s) * 64 + l) * 16) = (u32x4){pk2(v[0], v[1]), pk2(v[2], v[3]), pk2(v[4], v[5]), pk2(v[6], v[7])}; }
        for (int idx = sub + 4 * tid; idx < 17 * 256; idx += 2048) {
            const int lagi = idx >> 8, c = (idx >> 4) & 15, c2 = idx & 15; float acc = 0.f;
            if (lagi > 0) {
#pragma unroll 16
                for (int p = 0; p < 64; ++p) { const float cr = cc[(c * 65 + p) * 2], ci = cc[(c * 65 + p) * 2 + 1], pr = pw[((lagi - 1) * 64 + p) * 2], pi = pw[((lagi - 1) * 64 + p) * 2 + 1];
                    const float tr = cr * pr - ci * pi, ti = cr * pi + ci * pr; acc += tr * bb[(p * 17 + c2) * 2] - ti * bb[(p * 17 + c2) * 2 + 1]; }
            }
            *(bf16_t*)(gb + SSM_OFF_KT + idx * 2) = (bf16_t)f2bf_(acc); }
        if (sub == 0) for (int job = tid; job < 21 * 32; job += 512) {
            const int d = job >> 5, rt = (job >> 2) & 7, q = job & 3, p0 = 8 * rt + 2 * q;
            const f32x4 v = (f32x4){big[(d * 64 + p0) * 2], big[(d * 64 + p0) * 2 + 1], big[(d * 64 + p0 + 1) * 2], big[(d * 64 + p0 + 1) * 2 + 1]};
            if (d < 5) *(f32x4*)(gb + SSM_OFF_PW + ((d * 8 + rt) * 4 + q) * 16) = v;
            else *(f32x4*)(a.ws + WS_SSM_PN + ((((size_t)g * 8 + rt) * 16 + (d - 5)) * 4 + q) * 16) = v; }
    }
}
constexpr int SSM_OFF_EX = SSM_GS;
static_assert(SSM_OFF_EX + 8 * 128 * 4 <= MISC_OFF, "ssm exchange area");
__device__ __forceinline__ void ssm_phase(LAS unsigned char* lds, unsigned char* ws, const bf16_t* U, const float* dsk, bf16_t* GO, int vcu, int G, const int tid, const int nsub) {
    const int lane = tid & 63, wave = __builtin_amdgcn_readfirstlane(tid >> 6), n = lane & 15, q = lane >> 4;
    for (int unit = vcu; unit < nsub * NGRP; unit += G) {
        const int g = unit / nsub, sub = unit % nsub;
        __syncthreads();
        { const unsigned char* gb = ws + WS_SSM + (size_t)g * SSM_GS;
          constexpr int NFULL = SSM_GS / 8192, TAIL = SSM_GS - NFULL * 8192; u32x4 tv[NFULL + 1];
#pragma unroll
          for (int it = 0; it < NFULL; ++it) tv[it] = ((const u32x4*)(gb + it * 8192))[tid];
          tv[NFULL] = ((const u32x4*)(gb + NFULL * 8192))[tid < TAIL / 16 ? tid : 0];
#pragma unroll
          for (int it = 0; it < NFULL; ++it) ((LAS u32x4*)(lds + it * 8192))[tid] = tv[it];
          if (tid < TAIL / 16) ((LAS u32x4*)(lds + NFULL * 8192))[tid] = tv[NFULL]; }
        __syncthreads();
        const int pair = sub * 8 + wave, b = pair >> 2, seg = pair & 3;
        const LAS f32x4* PW = (const LAS f32x4*)(lds + SSM_OFF_PW);
        const f32x4* PN = (const f32x4*)(ws + WS_SSM_PN) + (size_t)g * 8 * 16 * 4;
#define A16(rt) (PW[(4 * 8 + (rt)) * 4 + QQ])
#define QQ q
        const int tokb = b * SEQ + seg * 512;
        const bf16_t* Ub = U + (size_t)tokb * 1024 + g * 16; bf16_t* Gb = GO + (size_t)tokb * 1024 + g * 16;
        unsigned uoff = (unsigned)((16 * n + (lane >> 5)) * 1024 + 8 * ((lane >> 4) & 1)), eoff = (unsigned)(16 * n * 1024 + 4 * q);
        f32x4 I0[8], I1[8];
        {
            bf16x8_t uf[8];
#pragma unroll
            for (int s = 0; s < 8; ++s) uf[s] = *(const bf16x8_t*)((Ub + (2 * s) * 1024) + uoff);
            bf16x8_t fa[2][8];
#pragma unroll
            for (int s = 0; s < 8; ++s) fa[0][s] = *(const LAS bf16x8_t*)(lds + SSM_OFF_BM + ((0 * 8 + s) * 64 + lane) * 16);
#pragma unroll
            for (int rt = 0; rt < 8; ++rt) { I0[rt] = (f32x4){0.f, 0.f, 0.f, 0.f};
                if (rt < 7) {
#pragma unroll
                    for (int s = 0; s < 8; ++s) fa[(rt + 1) & 1][s] = *(const LAS bf16x8_t*)(lds + SSM_OFF_BM + (((rt + 1) * 8 + s) * 64 + lane) * 16);
                }
                __builtin_amdgcn_sched_barrier(0);
#pragma unroll
                for (int s = 0; s < 8; ++s) I0[rt] = __builtin_amdgcn_mfma_f32_16x16x32_bf16(fa[rt & 1][s], uf[s], I0[rt], 0, 0, 0);
                __builtin_amdgcn_sched_barrier(0); }
#pragma unroll
            for (int s = 0; s < 8; ++s) uf[s] = *(const bf16x8_t*)((Ub + (256 + 2 * s) * 1024) + uoff);
#pragma unroll
            for (int s = 0; s < 8; ++s) fa[0][s] = *(const LAS bf16x8_t*)(lds + SSM_OFF_BM + ((0 * 8 + s) * 64 + lane) * 16);
#pragma unroll
            for (int rt = 0; rt < 8; ++rt) { I1[rt] = (f32x4){0.f, 0.f, 0.f, 0.f};
                if (rt < 7) {
#pragma unroll
                    for (int s = 0; s < 8; ++s) fa[(rt + 1) & 1][s] = *(const LAS bf16x8_t*)(lds + SSM_OFF_BM + (((rt + 1) * 8 + s) * 64 + lane) * 16);
                }
                __builtin_amdgcn_sched_barrier(0);
#pragma unroll
                for (int s = 0; s < 8; ++s) I1[rt] = __builtin_amdgcn_mfma_f32_16x16x32_bf16(fa[rt & 1][s], uf[s], I1[rt], 0, 0, 0);
                __builtin_amdgcn_sched_barrier(0); }
        }
#pragma unroll
        for (int rt = 0; rt < 8; ++rt) { const f32x4 an = PN[(rt * 16 + (15 - n)) * 4 + q];
            f32x4 t0 = cmul2(an, I0[rt]), t1 = cmul2(an, I1[rt]);
            t0 = t0 + dpp4<0x128>(t0); t0 = t0 + dpp4<0x124>(t0); t0 = t0 + dpp4<0x122>(t0); t0 = t0 + dpp4<0x121>(t0);
            t1 = t1 + dpp4<0x128>(t1); t1 = t1 + dpp4<0x124>(t1); t1 = t1 + dpp4<0x122>(t1); t1 = t1 + dpp4<0x121>(t1);
            const f32x4 e = cmul2(A16(rt), t0) + t1;
            if (n == 0) *(LAS f32x4*)(lds + SSM_OFF_EX + wave * 512 + (rt * 4 + q) * 16) = e; }
        __syncthreads();
#undef QQ
#define QQ qb_
        int tqb = tid; asm volatile("" : "+v"(tqb));
        const int laneb = tqb & 63, nb_ = laneb & 15, qb_ = laneb >> 4;
        unsigned uoffb = (unsigned)((16 * nb_ + (laneb >> 5)) * 1024 + 8 * ((laneb >> 4) & 1)), eoffb = (unsigned)(16 * nb_ * 1024 + 4 * qb_);
        f32x4 carry[8];
#pragma unroll
        for (int rt = 0; rt < 8; ++rt) carry[rt] = (f32x4){0.f, 0.f, 0.f, 0.f};
        for (int m = 0; m < seg; ++m) {
#pragma unroll
            for (int rt = 0; rt < 8; ++rt) { const f32x4 a16 = A16(rt); const f32x4 a32 = cmul2(a16, a16); const f32x4 e = *(const LAS f32x4*)(lds + SSM_OFF_EX + (wave - seg + m) * 512 + (rt * 4 + qb_) * 16);
                carry[rt] = cmul2(a32, carry[rt]) + e; }
        }
        __syncthreads();
        const f32x4 dv = *(const f32x4*)(dsk + g * 16 + 4 * qb_);
#pragma unroll
        for (int rt = 0; rt < 8; ++rt) *(LAS f32x4*)(lds + SSM_OFF_BM + wave * 8192 + (rt * 64 + laneb) * 16) = I1[rt];
#pragma unroll
        for (int batch = 0; batch < 2; ++batch) {
            f32x4 (&I)[8] = I0;
            asm volatile("" : "+v"(uoffb), "+v"(eoffb));
            if (batch == 1) {
#pragma unroll
                for (int rt = 0; rt < 8; ++rt) { I0[rt] = *(const LAS f32x4*)(lds + SSM_OFF_BM + wave * 8192 + (rt * 64 + laneb) * 16); carry[rt] = *(const LAS f32x4*)(lds + SSM_OFF_EX + wave * 512 + (rt * 4 + qb_) * 16); }
            }
#pragma unroll
            for (int rt = 0; rt < 8; ++rt) I[rt] = I[rt] + cmul2(PW[(0 * 8 + rt) * 4 + qb_], dpp4<0x111>(I[rt]));
#pragma unroll
            for (int rt = 0; rt < 8; ++rt) I[rt] = I[rt] + cmul2(PW[(1 * 8 + rt) * 4 + qb_], dpp4<0x112>(I[rt]));
#pragma unroll
            for (int rt = 0; rt < 8; ++rt) I[rt] = I[rt] + cmul2(PW[(2 * 8 + rt) * 4 + qb_], dpp4<0x114>(I[rt]));
#pragma unroll
            for (int rt = 0; rt < 8; ++rt) I[rt] = I[rt] + cmul2(PW[(3 * 8 + rt) * 4 + qb_], dpp4<0x118>(I[rt]));
            bf16x8_t sf[4];
#pragma unroll
            for (int s = 0; s < 4; ++s) {
                const f32x4 p0 = dpp4<0x111>(I[2 * s]) + cmul2(PN[((2 * s) * 16 + nb_) * 4 + qb_], carry[2 * s]);
                const f32x4 p1 = dpp4<0x111>(I[2 * s + 1]) + cmul2(PN[((2 * s + 1) * 16 + nb_) * 4 + qb_], carry[2 * s + 1]);
                const u32x4 w = (u32x4){pg8::cvt_pk_bf16(p0[0], p0[1]), pg8::cvt_pk_bf16(p0[2], p0[3]), pg8::cvt_pk_bf16(p1[0], p1[1]), pg8::cvt_pk_bf16(p1[2], p1[3])};
                sf[s] = __builtin_bit_cast(bf16x8_t, w);
            }
            if (batch == 0) {
#pragma unroll
                for (int rt = 0; rt < 8; ++rt) { const f32x4 last = (f32x4){__shfl(I[rt][0], 15, 16), __shfl(I[rt][1], 15, 16), __shfl(I[rt][2], 15, 16), __shfl(I[rt][3], 15, 16)};
                    const f32x4 cn = cmul2(A16(rt), carry[rt]) + last; if (nb_ == 0) *(LAS f32x4*)(lds + SSM_OFF_EX + wave * 512 + (rt * 4 + qb_) * 16) = cn; }
            }
            bf16x8_t uf[8];
#pragma unroll
            for (int s = 0; s < 8; ++s) uf[s] = *(const bf16x8_t*)((Ub + (batch * 256 + 2 * s) * 1024) + uoffb);
            uint2 uwv[16]; bf16x8_t fc[4], kt[16];
#define SSM_LDC(ii) do { _Pragma("unroll") for (int s = 0; s < 4; ++s) fc[s] = *(const LAS bf16x8_t*)(lds + SSM_OFF_CM + (((ii) * 4 + s) * 64 + laneb) * 16); } while (0)
#define SSM_LDK(f) (*(const LAS bf16x8_t*)(lds + SSM_OFF_KT + (((f) + 1 - (laneb >> 5)) * 256 + (laneb & 15) * 16 + 8 * ((laneb >> 4) & 1)) * 2))
#pragma unroll
            for (int i = 0; i < 4; ++i) uwv[i] = *(const uint2*)((Ub + (batch * 256 + i) * 1024) + eoffb);
            SSM_LDC(0); kt[0] = SSM_LDK(0);
#pragma unroll
            for (int i = 0; i < 16; ++i) {
                __builtin_amdgcn_sched_barrier(0);
                f32x4 acc = (f32x4){0.f, 0.f, 0.f, 0.f};
#pragma unroll
                for (int s = 0; s < 4; ++s) acc = __builtin_amdgcn_mfma_f32_16x16x32_bf16(fc[s], sf[s], acc, 0, 0, 0);
                __builtin_amdgcn_sched_barrier(0);
                if (i + 1 < 16) { SSM_LDC(i + 1); kt[i + 1] = SSM_LDK(i + 1); }
                if (i + 4 < 16) uwv[i + 4] = *(const uint2*)((Ub + (batch * 256 + i + 4) * 1024) + eoffb);
                __builtin_amdgcn_sched_barrier(0);
#pragma unroll
                for (int s = 0; s <= i / 2; ++s) acc = __builtin_amdgcn_mfma_f32_16x16x32_bf16(kt[i - 2 * s], uf[s], acc, 0, 0, 0);
                const uint2 uw = uwv[i];
                const float y[4] = {acc[0] + dv[0] * pg8::bflo(uw.x), acc[1] + dv[1] * pg8::bfhi(uw.x), acc[2] + dv[2] * pg8::bflo(uw.y), acc[3] + dv[3] * pg8::bfhi(uw.y)};
                float ge[4];
#pragma unroll
                for (int r = 0; r < 4; ++r) ge[r] = y[r] * pg8::sigm(1.5957691216057308f * (y[r] + 0.044715f * y[r] * y[r] * y[r]));
                *(uint2*)((Gb + (batch * 256 + i) * 1024) + eoffb) = make_uint2(pg8::cvt_pk_bf16(ge[0], ge[1]), pg8::cvt_pk_bf16(ge[2], ge[3]));
                __builtin_amdgcn_sched_barrier(0);
            }
#undef SSM_LDC
#undef SSM_LDK
        }
#undef A16
#undef QQ
    }
}

template <class Epi> __device__ __forceinline__ void run_gemm(LAS unsigned char* lds, const bf16_t* A, const bf16_t* Bt, int N, const Epi& E, int G, const int tid, const int mtok, const int lb, const bool bpre = false) {
    pg8::Gemm g{A, Bt, mtok, N, 1024}; pg8::StaticOrder S; S.init(mtok, N, G, lb);
    pg8::gemm_phase<Epi, pg8::StaticOrder, true, true>(lds, g, S, E, tid, bpre);
}
__global__ void __launch_bounds__(NWAVES * 64, 2) mega_fwd(Args args) {
    extern __shared__ __attribute__((aligned(16))) unsigned char lds_raw[];
    LAS unsigned char* lds = (LAS unsigned char*)lds_raw;
    const int G = gridDim.x, bx = blockIdx.x, vcu = (G % 8 == 0) ? (bx % 8) * (G / 8) + bx / 8 : bx;
    const int wave = __builtin_amdgcn_readfirstlane((int)threadIdx.x >> 6);
#define TID() (wave * 64 + lane_id_fresh())
    const int NH = (G == 256) ? 2 : 1, hh = NH == 2 ? (bx >> 7) & 1 : 0, lb = NH == 2 ? (bx & 127) : bx, GL = G / NH;
    const int vcl = (GL % 8 == 0) ? (lb % 8) * (GL / 8) + lb / 8 : lb, ML = MTOK / NH, BL = BATCH / NH;
    unsigned char* ws = args.ws;
    bf16_t* WB = (bf16_t*)(ws + WS_W);
    const size_t ro = (size_t)hh * ML;
    bf16_t* HB = (bf16_t*)(ws + WS_HB) + ro * 1024;
    bf16_t* B1 = (bf16_t*)(ws + WS_B1) + ro * 1024; bf16_t* B2 = (bf16_t*)(ws + WS_B2) + ro * 1024; bf16_t* B3 = (bf16_t*)(ws + WS_B3) + ro * 1024; bf16_t* B4 = (bf16_t*)(ws + WS_B4) + ro * 1024; bf16_t* YB = (bf16_t*)(ws + WS_Y) + ro * 1024;
    float* P = (float*)(ws + WS_P) + ro * 16; float* cumloc = (float*)(ws + WS_CUMLOC) + (size_t)hh * BL * NHEADS * SEQ; float* ctot = (float*)(ws + WS_CTOT) + (size_t)hh * (ML / 64) * 16;
    float* outp = args.out + ro * 1024;
    const int lo = args.ph_lo, hi = args.ph_hi;
#define IN(k) (lo <= (k) && (k) < hi)
    { const int t_ = TID(); if (t_ < 64) ((LAS unsigned*)(lds + MISC_OFF))[t_] = 0u; __syncthreads(); }
    XcdBarrier bar; bar.bar = (unsigned*)ws + hh * 4096; bar.x = 0; bar.st = nullptr; bar.gsz = 0;
    if (hi - lo > 1) bar = xcd_barrier_post((unsigned*)ws + hh * 4096, (volatile LAS unsigned*)(lds + MISC_OFF + 32), TID(), (unsigned)GL);
    if (lo < 0) cg::this_grid().sync();
#define SEAM(k) do { if (IN(k) && IN((k) + 1)) xcd_barrier(bar, TID()); } while (0)
#define SEAM_L(k) do { if (IN(k) && IN((k) + 1)) xcd_barrier(bar, TID(), affine); } while (0)
#define SEAM_B(k, loc, wrow, n) do { if (IN(k) && IN((k) + 1)) { const bf16_t* bt_ = WB + (size_t)(wrow) * 1024; const int n_ = (n); \
        xcd_barrier(bar, TID(), (loc), [&]() { pg8::gemm_prefetch_b<true>(lds, bt_, ML, n_, 1024, GL, lb2, TID()); }); } } while (0)
#define BPRE(k) (IN(k) && IN((k) + 1))
    unsigned* const flg = (unsigned*)ws + 3 * 4096;
#define FLAG_WAIT(w) do { if (TID() == 0) { XB_SPIN(xb_ld(flg + (w)) == 0u, bar.bar); } } while (0)
#define FLAG_SET(w) do { if (lb == 0 && TID() == 0) __hip_atomic_store(flg + (w), 1u, __ATOMIC_RELAXED, __HIP_MEMORY_SCOPE_AGENT); } while (0)
    if (IN(0)) {
        if (NH == 2) { if (hh == 0) p0_prologue(args, lds, vcl, GL, TID(), 0, P0_I3072, false, 0, ML);
                       else { ssm_tables(args, lds, vcl, GL, TID()); p0_prologue(args, lds, vcl, GL, TID(), P0_I3072, P0_NITEMS, true, ML, 2 * ML); } }
        else { p0_prologue(args, lds, vcu, G, TID(), 0, P0_NITEMS, true, 0, MTOK); ssm_tables(args, lds, vcu, G, TID()); }
    }
    if (IN(0) && IN(1)) { if (NH == 2 && hh == 1) FLAG_WAIT(0); xcd_barrier(bar, TID()); if (NH == 2) FLAG_SET(64 * hh); }
    bool affine = false; int lb2 = lb, vcl2 = vcl;
    if (IN(0) && IN(1) && NH == 2) {
        volatile LAS unsigned* st_ = (volatile LAS unsigned*)(lds + MISC_OFF + 32);
        const unsigned reg_ = __builtin_amdgcn_readfirstlane(st_[3]), rank_ = __builtin_amdgcn_readfirstlane(st_[2]);
        if (reg_ != 0u && rank_ < (unsigned)(GL / 8) && bar.x < 8u) { affine = true; lb2 = (int)(rank_ * 8u + bar.x); vcl2 = (lb2 % 8) * (GL / 8) + lb2 / 8; }
    }
    if (IN(1)) { pg8::EpiConvIn E{P, B1, B2}; run_gemm(lds, HB, WB + (size_t)W_C0IN * 1024, 3072, E, GL, TID(), ML, lb2); } SEAM(1);
    if (IN(2)) { conv_phase(lds, B1, B2, args.in[3], args.in[4], args.in[5], args.in[6], YB, vcl2, GL, TID(), ML); } if (NH == 2 && hh == 0 && IN(2) && IN(3)) FLAG_WAIT(64); SEAM_B(2, affine, W_C0OUT, 1024);
    if (IN(3)) { pg8::EpiOut E{HB, P, outp, 0}; run_gemm(lds, YB, WB + (size_t)W_C0OUT * 1024, 1024, E, GL, TID(), ML, lb2, BPRE(2)); } SEAM_B(3, affine, W_FIN, 4096);
    if (IN(4)) { pg8::EpiFoxIn E{P, B1, B3, B4, B2, args.in[10], args.in[11]}; run_gemm(lds, HB, WB + (size_t)W_FIN * 1024, 4096, E, GL, TID(), ML, lb2, BPRE(3));
                 fcum_phase(lds, HB, WB + (size_t)W_FF * 1024, P, args.in[9], cumloc, ctot, vcl2, GL, TID(), ML); } SEAM(4);
    if (IN(5)) { const attn_body::AttnTensors AT{(const attn_body::bf16*)B1, (const attn_body::bf16*)B3, (const attn_body::bf16*)B4, (const attn_body::bf16*)B2, (attn_body::bf16*)YB, cumloc, ctot, args.in[10], args.in[11]};
                 const attn_body::StaticOrder S(GL, lb2, BL); attn_body::attn_phase<attn_body::StaticOrder>((char*)lds_raw, AT, S, TID()); } SEAM_B(5, false, W_FOUT, 1024);
    if (IN(6)) { pg8::EpiOut E{HB, P, outp, 0}; run_gemm(lds, YB, WB + (size_t)W_FOUT * 1024, 1024, E, GL, TID(), ML, lb2, BPRE(5)); } SEAM_B(6, affine, W_SIN, 2048);
    if (IN(7)) { pg8::EpiSsmIn E{P, B1, B2}; run_gemm(lds, HB, WB + (size_t)W_SIN * 1024, 2048, E, GL, TID(), ML, lb2, BPRE(6)); } SEAM(7);
    if (IN(8)) { ssm_phase(lds, ws, B1, args.in[21], B3, vcl2, GL, TID(), BL * 4 / NWAVES); } SEAM_B(8, false, W_SGLU, 1024);
    if (IN(10)) { pg8::EpiGlu E{B3, B2, args.in[23], YB}; run_gemm(lds, B3, WB + (size_t)W_SGLU * 1024, 1024, E, GL, TID(), ML, lb2, BPRE(8)); } SEAM_B(10, affine, W_SOUT, 1024);
    if (IN(11)) { pg8::EpiOut E{HB, P, outp, 0}; run_gemm(lds, YB, WB + (size_t)W_SOUT * 1024, 1024, E, GL, TID(), ML, lb2, BPRE(10)); } SEAM_B(11, affine, W_C1IN, 3072);
    if (IN(12)) { pg8::EpiConvIn E{P, B1, B2}; run_gemm(lds, HB, WB + (size_t)W_C1IN * 1024, 3072, E, GL, TID(), ML, lb2, BPRE(11)); } SEAM(12);
    if (IN(13)) { conv_phase(lds, B1, B2, args.in[3] + (size_t)CONV_K * 1024, args.in[4] + 1024, args.in[5] + 1024, args.in[6] + 1024, YB, vcl2, GL, TID(), ML); } SEAM_B(13, affine, W_C1OUT, 1024);
    if (IN(14)) { pg8::EpiOut E{HB, P, outp, 1}; run_gemm(lds, YB, WB + (size_t)W_C1OUT * 1024, 1024, E, GL, TID(), ML, lb2, BPRE(13)); }
#undef IN
#undef SEAM
#undef SEAM_L
#undef SEAM_B
#undef BPRE
}

#ifndef MK_ONE_LAUNCH
#define MK_ONE_LAUNCH 1
#endif
constexpr int N_PHASES = 15;
extern "C" void kernel_launch(void* const* d_in, const int* in_sizes, int n_in, void* d_out, int out_size, void* d_ws, size_t ws_size, hipStream_t stream) {
    static int grid = 0;
    if (grid == 0) {
        if (n_in != 25 || out_size != MTOK * DMODEL || ws_size < WS_END) { fprintf(stderr, "kernel_launch: unexpected shapes (n_in %d, out %d, ws %zu)\n", n_in, out_size, ws_size); grid = -1; return; }
        int dev = 0, cus = 0, per_cu = 0;
        if (hipGetDevice(&dev) != hipSuccess || hipDeviceGetAttribute(&cus, hipDeviceAttributeMultiprocessorCount, dev) != hipSuccess) { grid = -1; return; }
        if (hipFuncSetAttribute((const void*)mega_fwd, hipFuncAttributeMaxDynamicSharedMemorySize, LDS_BYTES) != hipSuccess) { fprintf(stderr, "kernel_launch: hipFuncSetAttribute failed\n"); grid = -1; return; }
        if (hipOccupancyMaxActiveBlocksPerMultiprocessor(&per_cu, (const void*)mega_fwd, NWAVES * 64, LDS_BYTES) != hipSuccess || per_cu < 1) { fprintf(stderr, "kernel_launch: occupancy query says %d blocks per CU\n", per_cu); grid = -1; (void)hipGetLastError(); return; }
        grid = cus;
    }
    if (grid < 0) return;
    if (hipMemsetAsync(d_ws, 0, 65536, stream) != hipSuccess) { fprintf(stderr, "kernel_launch: memset failed\n"); return; }
    Args a{};
    for (int i = 0; i < 25; ++i) a.in[i] = (const float*)d_in[i];
    a.out = (float*)d_out; a.ws = (unsigned char*)d_ws;
#if MK_ONE_LAUNCH
    a.ph_lo = 0; a.ph_hi = N_PHASES;
    void* kargs[] = {&a};
    const hipError_t e = hipLaunchCooperativeKernel((const void*)mega_fwd, dim3(grid), dim3(NWAVES * 64), kargs, LDS_BYTES, stream);
    if (e != hipSuccess) fprintf(stderr, "kernel_launch: cooperative launch failed: %s (grid %d)\n", hipGetErrorString(e), grid);
#else
    for (int p = 0; p < N_PHASES; ++p) { a.ph_lo = p; a.ph_hi = p + 1; hipLaunchKernelGGL(mega_fwd, dim3(grid), dim3(NWAVES * 64), LDS_BYTES, stream, a); }
#endif
}
```
